# Optimizing an MI355X kernel written in HIP

```python
import math
import jax
import jax.numpy as jnp
from jax import lax
import numpy as np

D_MODEL = 2048
BATCH = 16
SEQ = 256
DEPTH = 2
DEC_BATCH = 4
DEC_SEQ = 1024
PAST_LEN = 512

GRID_W = 64
ROPE_BASE = 10000.0
NORM_EPS = 1e-6
GN_EPS = 64e-5
Q_BLOCK = 128

A_HEADS = 8
A_QK_DIM = 64
A_V_DIM = 2 * A_QK_DIM
B_HEADS = 8
B_NOPE = 128
B_ROPE = 64
B_V = 128
B_Q_LORA = 512
B_KV_LORA = 256
AB_WIDTH = A_HEADS * A_V_DIM + B_HEADS * B_V
L0_IN = 2 * A_HEADS * 2 * A_QK_DIM + A_HEADS * A_V_DIM + B_Q_LORA + B_KV_LORA + B_ROPE + AB_WIDTH
C_HEAD = 64
C_HEADS = D_MODEL // C_HEAD
C_WIDTH = C_HEADS * C_HEAD
C_DECAY_LORA = 96
C_ICLR_LORA = 96
L1_IN = 4 * C_WIDTH + 2 * C_DECAY_LORA + 2 * C_ICLR_LORA

kernel_name = 'hybrid_diffusion_diffattn_mla_rwkv7_step'


def rmsnorm(x, g, eps=NORM_EPS):
    xf = x.astype(jnp.float32)
    y = xf * lax.rsqrt(jnp.mean(xf * xf, axis=-1, keepdims=True) + eps)
    return (y * g.astype(jnp.float32)).astype(x.dtype)


def adaln(cond, w, b):
    m = (jax.nn.silu(cond) @ w + b)[:, None, :]
    return jnp.split(m, 3, axis=-1)


def rope_1d(x, pos):
    half = x.shape[-1] // 2
    freqs = ROPE_BASE ** (-jnp.arange(half, dtype=jnp.float32) / half)
    ang = pos.astype(jnp.float32)[:, None] * freqs
    cos = jnp.cos(ang)[None, :, None, :]
    sin = jnp.sin(ang)[None, :, None, :]
    xf = x.astype(jnp.float32)
    x1, x2 = xf[..., :half], xf[..., half:]
    return jnp.concatenate([x1 * cos - x2 * sin, x1 * sin + x2 * cos], axis=-1).astype(x.dtype)


def rope_2d(x):
    t_len = x.shape[1]
    n_rows = t_len // GRID_W
    row = jnp.repeat(jnp.arange(n_rows), GRID_W)
    col = jnp.tile(jnp.arange(GRID_W), n_rows)
    half = x.shape[-1] // 2
    return jnp.concatenate([rope_1d(x[..., :half], row), rope_1d(x[..., half:], col)], axis=-1)


def map_query_blocks(fn, *qs):
    bsz, t_len = qs[0].shape[:2]
    blk = min(Q_BLOCK, t_len)
    n_blk = t_len // blk
    blocks = tuple(jnp.moveaxis(q.reshape((bsz, n_blk, blk) + q.shape[2:]), 1, 0) for q in qs)
    out = lax.map(lambda qb: fn(*qb), blocks)
    out = jnp.moveaxis(out, 0, 1)
    return out.reshape((bsz, t_len) + out.shape[3:])


def mixer_ab(h, params, ctx, layer):
    w_in, w_out, diff_lambda, subln_g, q_norm_g, w_uq, kv_norm_g, w_ukv = params
    f32 = jnp.float32
    bsz, t_len, _ = h.shape
    sizes = (A_HEADS * 2 * A_QK_DIM, A_HEADS * 2 * A_QK_DIM, A_HEADS * A_V_DIM,
             B_Q_LORA, B_KV_LORA, B_ROPE, AB_WIDTH)
    a_q, a_k, a_v, cq, ckv, kpe, gate = jnp.split(h @ w_in, np.cumsum(sizes)[:-1].tolist(), axis=-1)
    a_q = a_q.reshape(bsz, t_len, A_HEADS * 2, A_QK_DIM)
    a_k = a_k.reshape(bsz, t_len, A_HEADS * 2, A_QK_DIM)
    a_v = a_v.reshape(bsz, t_len, A_HEADS, A_V_DIM)
    q_b = (rmsnorm(cq, q_norm_g) @ w_uq).reshape(bsz, t_len, B_HEADS, B_NOPE + B_ROPE)
    q_nope, q_pe = q_b[..., :B_NOPE], q_b[..., B_NOPE:]
    ckv = rmsnorm(ckv, kv_norm_g)
    kpe = kpe[:, :, None, :]
    if ctx is None:
        new = (a_k.reshape(bsz, t_len, A_HEADS, 2, A_QK_DIM), a_v, ckv, kpe[:, :, 0])
        a_q = a_q.reshape(bsz, t_len, A_HEADS, 2, A_QK_DIM)
        k_all, v_all, ckv_all, kpe_all = new
    else:
        k_ctx, v_ctx, ckv_ctx, kpe_ctx = ctx
        a_q = rope_2d(a_q).reshape(bsz, t_len, A_HEADS, 2, A_QK_DIM)
        a_k = rope_2d(a_k).reshape(bsz, t_len, A_HEADS, 2, A_QK_DIM)
        q_pe = rope_2d(q_pe)
        kpe = rope_2d(kpe)[:, :, 0]
        k_all = jnp.concatenate([a_k, k_ctx.astype(a_k.dtype)], axis=1)
        v_all = jnp.concatenate([a_v, v_ctx.astype(a_v.dtype)], axis=1)
        ckv_all = jnp.concatenate([ckv, ckv_ctx.astype(ckv.dtype)], axis=1)
        kpe_all = jnp.concatenate([kpe, kpe_ctx.astype(kpe.dtype)], axis=1)
        new = None

    lam_init = 0.8 - 0.6 * math.exp(-0.3 * layer)
    lp = diff_lambda.astype(f32)
    lam = jnp.exp(jnp.sum(lp[0] * lp[1])) - jnp.exp(jnp.sum(lp[2] * lp[3])) + lam_init
    v_all32 = v_all.astype(f32)

    def diff_block(q):
        s = jnp.einsum('bqhcd,bkhcd->bhcqk', q, k_all, preferred_element_type=f32) * (A_QK_DIM ** -0.5)
        p = jax.nn.softmax(s, axis=-1)
        return jnp.einsum('bhqk,bkhe->bqhe', p[:, :, 0] - lam * p[:, :, 1], v_all32)

    o_a = map_query_blocks(diff_block, a_q)
    o_a = rmsnorm(o_a, subln_g) * (1.0 - lam_init)

    kv_b = (ckv_all @ w_ukv).reshape(bsz, -1, B_HEADS, B_NOPE + B_V)
    k_nope, v_b = kv_b[..., :B_NOPE], kv_b[..., B_NOPE:].astype(f32)

    def mla_block(qn, qp):
        s = (jnp.einsum('bqhd,bkhd->bhqk', qn, k_nope, preferred_element_type=f32)
             + jnp.einsum('bqhd,bkd->bhqk', qp, kpe_all, preferred_element_type=f32)) * ((B_NOPE + B_ROPE) ** -0.5)
        p = jax.nn.softmax(s, axis=-1)
        return jnp.einsum('bhqk,bkhd->bqhd', p, v_b)

    o_b = map_query_blocks(mla_block, q_nope, q_pe)
    y = jnp.concatenate([o_a.reshape(bsz, t_len, -1), o_b.reshape(bsz, t_len, -1)], axis=-1).astype(h.dtype)
    return (y * jax.nn.silu(gate)) @ w_out, new


def token_shift_bidir(x, mu):
    prev = jnp.pad(x[:, :-1], ((0, 0), (1, 0), (0, 0)))
    nxt = jnp.pad(x[:, 1:], ((0, 0), (0, 1), (0, 0)))
    return x + mu[0] * (prev - x) + mu[1] * (nxt - x)


def wkv7_scan(s0, r, decay, k, v, kk, a, reverse):
    def step(s, inp):
        r_t, w_t, k_t, v_t, kk_t, a_t = inp
        sa = jnp.einsum('bhij,bhj->bhi', s, -kk_t)
        s = s * w_t[:, :, None, :] + sa[..., None] * (kk_t * a_t)[:, :, None, :] + v_t[..., None] * k_t[:, :, None, :]
        return s, jnp.einsum('bhij,bhj->bhi', s, r_t)
    xs = tuple(jnp.moveaxis(t, 1, 0) for t in (r, decay, k, v, kk, a))
    s_fin, ys = lax.scan(step, s0, xs, reverse=reverse)
    return s_fin, jnp.moveaxis(ys, 0, 1)


def mixer_rwkv(h, params, ctx, layer):
    w_in, w_out, mu, w0, w2, a0, a2, k_k, k_a, r_k, ln_w, ln_b = params
    f32 = jnp.float32
    bsz, t_len, _ = h.shape
    proj = token_shift_bidir(h @ w_in, mu)
    sizes = (C_WIDTH, C_WIDTH, C_WIDTH, C_WIDTH, 2 * C_DECAY_LORA, 2 * C_ICLR_LORA)
    r, k, v, gate, wd, ad = jnp.split(proj, np.cumsum(sizes)[:-1].tolist(), axis=-1)

    def heads(t):
        return t.astype(f32).reshape(bsz, t_len, C_HEADS, C_HEAD)

    r, k, v = heads(r), heads(k), heads(v)
    kk = k * k_k.astype(f32)
    kk = kk * lax.rsqrt(jnp.maximum(jnp.sum(kk * kk, axis=-1, keepdims=True), 1e-12))
    wd = jnp.tanh(wd.astype(f32).reshape(bsz, t_len, 2, C_DECAY_LORA))
    ad = ad.astype(f32).reshape(bsz, t_len, 2, C_ICLR_LORA)
    w_log = -jax.nn.softplus(-(w0.astype(f32) + jnp.einsum('btzr,zrd->btzd', wd, w2.astype(f32)))) - 0.5
    decay = jnp.exp(-jnp.exp(w_log)).reshape(bsz, t_len, 2, C_HEADS, C_HEAD)
    iclr = jax.nn.sigmoid(a0.astype(f32) + jnp.einsum('btzr,zrd->btzd', ad, a2.astype(f32)))
    iclr = iclr.reshape(bsz, t_len, 2, C_HEADS, C_HEAD)
    if ctx is None:
        zero = jnp.zeros((bsz, C_HEADS, C_HEAD, C_HEAD), f32)
        s_init = (zero, zero)
    else:
        s_init = (ctx[0].astype(f32), ctx[1].astype(f32))
    outs = []
    finals = []
    for z in range(2):
        a_z = iclr[:, :, z]
        k_z = k * (1.0 + (a_z - 1.0) * k_a.astype(f32))
        s_fin, y = wkv7_scan(s_init[z], r, decay[:, :, z], k_z, v, kk, a_z, z == 1)
        mean = jnp.mean(y, axis=-1, keepdims=True)
        var = jnp.mean(jnp.square(y - mean), axis=-1, keepdims=True)
        y = (y - mean) * lax.rsqrt(var + GN_EPS) * ln_w.astype(f32) + ln_b.astype(f32)
        bonus = jnp.sum(r * k_z * r_k.astype(f32), axis=-1, keepdims=True) * v
        outs.append(y + bonus)
        finals.append(s_fin)
    y = (outs[0] + outs[1]).reshape(bsz, t_len, C_WIDTH).astype(h.dtype) * jax.nn.silu(gate)
    new = (finals[0], finals[1]) if ctx is None else None
    return y @ w_out, new


def setup_inputs(seed: int = 0) -> dict:
    key = jax.random.key(seed)
    ks = iter(jax.random.split(key, 34))

    def nrm(shape, scale=1.0):
        return jax.random.normal(next(ks), shape, jnp.float32) * scale

    def unif(shape, lo, hi):
        return jax.random.uniform(next(ks), shape, jnp.float32, lo, hi)

    d = D_MODEL
    return {
        'x_prompt': nrm((BATCH, SEQ, d)),
        'x_sample': nrm((DEC_BATCH, DEC_SEQ, d)),
        'cache_l0_a_k': nrm((DEC_BATCH, PAST_LEN, A_HEADS, 2, A_QK_DIM)),
        'cache_l0_a_v': nrm((DEC_BATCH, PAST_LEN, A_HEADS, A_V_DIM)),
        'cache_l0_mla_ckv': nrm((DEC_BATCH, PAST_LEN, B_KV_LORA)),
        'cache_l0_mla_kpe': nrm((DEC_BATCH, PAST_LEN, B_ROPE)),
        'state_l1_fwd': nrm((DEC_BATCH, C_HEADS, C_HEAD, C_HEAD), 0.5),
        'state_l1_bwd': nrm((DEC_BATCH, C_HEADS, C_HEAD, C_HEAD), 0.5),
        'c': nrm((DEC_BATCH, d)),
        'c_ctx': nrm((d,)),
        'mod_w': nrm((DEPTH, d, 3 * d), d ** -0.5),
        'mod_b': nrm((DEPTH, 3 * d), 0.01),
        'norm_g': 1.0 + nrm((DEPTH, d), 0.02),
        'final_norm_g': 1.0 + nrm((d,), 0.02),
        'l0_w_in': nrm((d, L0_IN), d ** -0.5),
        'l0_w_out': nrm((AB_WIDTH, d), AB_WIDTH ** -0.5),
        'l0_diff_lambda': nrm((4, A_QK_DIM), 0.1),
        'l0_subln_g': 1.0 + nrm((A_V_DIM,), 0.02),
        'l0_q_norm_g': 1.0 + nrm((B_Q_LORA,), 0.02),
        'l0_w_uq': nrm((B_Q_LORA, B_HEADS * (B_NOPE + B_ROPE)), B_Q_LORA ** -0.5),
        'l0_kv_norm_g': 1.0 + nrm((B_KV_LORA,), 0.02),
        'l0_w_ukv': nrm((B_KV_LORA, B_HEADS * (B_NOPE + B_V)), B_KV_LORA ** -0.5),
        'l1_w_in': nrm((d, L1_IN), d ** -0.5),
        'l1_w_out': nrm((C_WIDTH, d), C_WIDTH ** -0.5),
        'l1_mu': unif((2, L1_IN), 0.0, 0.5),
        'l1_w0': unif((2, C_WIDTH), -6.0, -1.0),
        'l1_w2': nrm((2, C_DECAY_LORA, C_WIDTH), 0.1 * C_DECAY_LORA ** -0.5),
        'l1_a0': nrm((2, C_WIDTH), 0.1),
        'l1_a2': nrm((2, C_ICLR_LORA, C_WIDTH), 0.5 * C_ICLR_LORA ** -0.5),
        'l1_k_k': 0.85 + nrm((C_HEADS, C_HEAD), 0.02),
        'l1_k_a': 1.0 + nrm((C_HEADS, C_HEAD), 0.02),
        'l1_r_k': nrm((C_HEADS, C_HEAD), 0.1),
        'l1_ln_w': 1.0 + nrm((C_HEADS, C_HEAD), 0.02),
        'l1_ln_b': nrm((C_HEADS, C_HEAD), 0.01),
    }


def reference(x_prompt, x_sample, cache_l0_a_k, cache_l0_a_v, cache_l0_mla_ckv, cache_l0_mla_kpe,
              state_l1_fwd, state_l1_bwd, c, c_ctx, mod_w, mod_b, norm_g, final_norm_g,
              l0_w_in, l0_w_out, l0_diff_lambda, l0_subln_g, l0_q_norm_g, l0_w_uq, l0_kv_norm_g, l0_w_ukv,
              l1_w_in, l1_w_out, l1_mu, l1_w0, l1_w2, l1_a0, l1_a2, l1_k_k, l1_k_a, l1_r_k, l1_ln_w, l1_ln_b):
    layer_params = (
        (l0_w_in, l0_w_out, l0_diff_lambda, l0_subln_g, l0_q_norm_g, l0_w_uq, l0_kv_norm_g, l0_w_ukv),
        (l1_w_in, l1_w_out, l1_mu, l1_w0, l1_w2, l1_a0, l1_a2, l1_k_k, l1_k_a, l1_r_k, l1_ln_w, l1_ln_b),
    )
    caches = (
        (cache_l0_a_k, cache_l0_a_v, cache_l0_mla_ckv, cache_l0_mla_kpe),
        (state_l1_fwd, state_l1_bwd),
    )
    xp, xs = x_prompt, x_sample
    new_states = []
    for layer in range(DEPTH):
        mixer = mixer_ab if layer % 2 == 0 else mixer_rwkv
        shift_p, scale_p, gate_p = adaln(c_ctx[None, :], mod_w[layer], mod_b[layer])
        shift_s, scale_s, gate_s = adaln(c, mod_w[layer], mod_b[layer])
        hp = rmsnorm(xp, norm_g[layer]) * (1.0 + scale_p) + shift_p
        hs = rmsnorm(xs, norm_g[layer]) * (1.0 + scale_s) + shift_s
        op, new = mixer(hp, layer_params[layer], None, layer)
        os_, _ = mixer(hs, layer_params[layer], caches[layer], layer)
        xp = xp + gate_p * op
        xs = xs + gate_s * os_
        new_states.append(new)
    y_prompt = rmsnorm(xp, final_norm_g)
    y_sample = rmsnorm(xs, final_norm_g)
    new_l0_a_k, new_l0_a_v, new_l0_mla_ckv, new_l0_mla_kpe = new_states[0]
    new_l1_state_fwd, new_l1_state_bwd = new_states[1]
    return (y_prompt, y_sample, new_l0_a_k, new_l0_a_v, new_l0_mla_ckv, new_l0_mla_kpe, new_l1_state_fwd, new_l1_state_bwd)
```

```cpp
#include <hip/hip_runtime.h>
#include <hip/hip_cooperative_groups.h>
#include <cstdio>
namespace cg = cooperative_groups;

#define DI __device__ __forceinline__
#define LAS __attribute__((address_space(3)))
typedef unsigned short bf16_t;
typedef short bf16x8 __attribute__((ext_vector_type(8)));
typedef short s16x4 __attribute__((ext_vector_type(4)));
typedef float f32x4 __attribute__((ext_vector_type(4)));
typedef float f32x2 __attribute__((ext_vector_type(2)));
typedef unsigned u32x4 __attribute__((ext_vector_type(4)));
typedef unsigned u32x2 __attribute__((ext_vector_type(2)));
typedef __bf16 nbf2 __attribute__((ext_vector_type(2)));

extern __shared__ __attribute__((aligned(16))) unsigned char dyn_lds[];
constexpr int LDS_BYTES = 131072;
constexpr int NTHREADS = 512;

constexpr size_t SZ_H    = (size_t)8192 * 2048 * 2;
constexpr size_t OFF_WOT1 = 0;
constexpr size_t OFF_WT0  = OFF_WOT1 + (size_t)2048 * 2048 * 2;
constexpr size_t OFF_WT1  = OFF_WT0 + (size_t)6144 * 2048 * 2;
constexpr size_t OFF_WOT0 = OFF_WT1 + (size_t)8704 * 2048 * 2;
constexpr size_t OFF_WUQ  = OFF_WOT0 + (size_t)2048 * 2048 * 2;
constexpr size_t OFF_WUKV = OFF_WUQ + (size_t)1536 * 512 * 2;
constexpr size_t OFF_W2T  = OFF_WUKV + (size_t)2048 * 256 * 2;
constexpr size_t OFF_A2T  = OFF_W2T + (size_t)2 * 2048 * 128 * 2;
constexpr size_t END_W    = OFF_A2T + (size_t)2 * 2048 * 128 * 2;
constexpr size_t OFF_YZ   = OFF_WT0;
static_assert(OFF_YZ + 2 * SZ_H <= END_W, "yz alias");
constexpr size_t OFF_MOD  = END_W;
constexpr size_t OFF_ROPE = OFF_MOD + (size_t)2 * 5 * 6144 * 4;
constexpr size_t OFF_BN   = OFF_ROPE + 64 * 16 * 8;
constexpr size_t OFF_H    = OFF_BN + (size_t)2 * 8192 * 32 * 4;
constexpr size_t OFF_C    = OFF_H + SZ_H;
constexpr size_t SZ_C     = (size_t)8192 * 8576 * 2;
constexpr size_t OFF_QD   = OFF_C;
constexpr size_t OFF_KD   = OFF_QD + (size_t)8192 * 1024 * 2;
constexpr size_t OFF_VD   = OFF_KD + (size_t)10240 * 1024 * 2;
constexpr size_t OFF_CQR  = OFF_VD + (size_t)10240 * 1024 * 2;
constexpr size_t OFF_CKVR = OFF_CQR + (size_t)8192 * 512 * 2;
constexpr size_t OFF_KPE  = OFF_CKVR + (size_t)8192 * 256 * 4;
constexpr size_t OFF_SG0  = OFF_KPE + (size_t)10240 * 64 * 2;
static_assert(OFF_SG0 + SZ_H <= OFF_C + SZ_C, "region C");
constexpr size_t OFF_E    = OFF_C + SZ_C;
constexpr size_t OFF_PART = OFF_E;
constexpr size_t OFF_AZ   = OFF_E;
constexpr size_t OFF_EZ   = OFF_E + 2 * SZ_H;
constexpr size_t SZ_E     = 4 * SZ_H;
constexpr size_t OFF_CQN  = OFF_E;
constexpr size_t OFF_CKVA = OFF_CQN + (size_t)8192 * 512 * 2;
constexpr size_t OFF_QB   = OFF_CKVA + (size_t)10240 * 256 * 2;
constexpr size_t OFF_KVB  = OFF_QB + (size_t)8192 * 1536 * 2;
static_assert(OFF_KVB + (size_t)10240 * 2048 * 2 <= OFF_E + SZ_E, "region E");
constexpr size_t OFF_BAR = OFF_E + SZ_E;
constexpr size_t WS_NEEDED = OFF_BAR + 16384;
constexpr size_t OFF_WDT = OFF_H;
constexpr size_t OFF_ADT = OFF_H + (size_t)2 * 8192 * 128 * 2;

constexpr size_t OUT_Y = 0, OUT_AK = 16777216, OUT_AV = 20971520, OUT_CKV = 25165824, OUT_KPE = 26214400, OUT_SF = 26476544, OUT_SB = 28573696;

struct Params {
    const float* in[34];
    float* out;
    unsigned char* ws;
};
struct KArgs { const void* a[36]; };

DI unsigned pk2(float a, float b) { f32x2 v = {a, b}; nbf2 r = __builtin_convertvector(v, nbf2); return __builtin_bit_cast(unsigned, r); }
DI float bflo(unsigned u) { return __uint_as_float(u << 16); }
DI float bfhi(unsigned u) { return __uint_as_float(u & 0xffff0000u); }
DI void st_bf4(bf16_t* p, f32x4 v) { u32x2 r = {pk2(v[0], v[1]), pk2(v[2], v[3])}; *(u32x2*)p = r; }
DI void st_f4(float* p, f32x4 v) { *(f32x4*)p = v; }
DI f32x4 ld_f4(const float* p) { return *(const f32x4*)p; }
DI f32x4 bf4_to_f4(u32x2 u) { f32x4 r = {bflo(u[0]), bfhi(u[0]), bflo(u[1]), bfhi(u[1])}; return r; }
DI float dpp_xor1(float x) { return __int_as_float(__builtin_amdgcn_mov_dpp(__float_as_int(x), 0xB1, 0xF, 0xF, true)); }
DI float dpp_xor2(float x) { return __int_as_float(__builtin_amdgcn_mov_dpp(__float_as_int(x), 0x4E, 0xF, 0xF, true)); }
DI float dpp_hmirror(float x) { return __int_as_float(__builtin_amdgcn_mov_dpp(__float_as_int(x), 0x141, 0xF, 0xF, true)); }
DI float dpp_mirror(float x) { return __int_as_float(__builtin_amdgcn_mov_dpp(__float_as_int(x), 0x140, 0xF, 0xF, true)); }
DI float shx(float x, int m, int lane) { return __int_as_float(__builtin_amdgcn_ds_bpermute((lane ^ m) << 2, __float_as_int(x))); }
DI float wave_sum(float x, int lane) {
    x += dpp_xor1(x); x += dpp_xor2(x); x += dpp_hmirror(x); x += dpp_mirror(x); x += shx(x, 16, lane); x += shx(x, 32, lane); return x;
}
DI float sum16d(float x) { x += dpp_xor1(x); x += dpp_xor2(x); x += dpp_hmirror(x); x += dpp_mirror(x); return x; }
DI float sigmoidf_(float x) { return __builtin_amdgcn_rcpf(1.f + __expf(-x)); }
DI int otid_(int wv) { int l; asm volatile("v_mbcnt_lo_u32_b32 %0, -1, 0\n\tv_mbcnt_hi_u32_b32 %0, -1, %0" : "=v"(l)); return (wv << 6) | l; }
#define otid() otid_(wv__)
DI int kvrow_of(int row) { return row < 4096 ? row : 4096 + ((row - 4096) >> 10) * 1536 + ((row - 4096) & 1023); }
DI int cond_of(int row) { return row < 4096 ? 0 : 1 + ((row - 4096) >> 10); }

constexpr int HTB = 128 * 64 * 2;
DI int lds_byte(int r, int c) { const int st = (r >> 4) * 2 + (c >> 5), rr = r & 15, cc = c & 31, ob = rr * 64 + cc * 2; return st * 1024 + (ob ^ (((ob >> 9) & 1) << 5)); }
DI void stage_rc(int b, int& R, int& C) { const int st = b / 1024, sb = b % 1024, swz = sb ^ (((sb >> 9) & 1) << 5); R = (st >> 1) * 16 + swz / 64; C = (st & 1) * 32 + (swz % 64) / 2; }

#define G_SA(b, h) (((b) * 2 + (h)) * HTB)
#define G_SB(b, h) ((4 + (b) * 2 + (h)) * HTB)
#define G_STAGE(bufoff, gbase) do { _Pragma("unroll") for (int _i = 0; _i < 2; ++_i) \
    __builtin_amdgcn_global_load_lds((const unsigned*)((const char*)(gbase) + voff[_i]), (LAS unsigned*)(lds + (bufoff) + ldsw + _i * 8192), 16, 0, 0); } while (0)
#define G_LDA(dst, b, h) do { _Pragma("unroll") for (int m = 0; m < 4; ++m) _Pragma("unroll") for (int k = 0; k < 2; ++k) dst[m][k] = *(const LAS bf16x8*)(lds + G_SA(b, h) + aoff + m * 2048 + k * 1024); } while (0)
#define G_LDB(dst, b, h) do { _Pragma("unroll") for (int n = 0; n < 2; ++n) _Pragma("unroll") for (int k = 0; k < 2; ++k) dst[n][k] = *(const LAS bf16x8*)(lds + G_SB(b, h) + boff + n * 2048 + k * 1024); } while (0)
#define G_MMA(ai, bj, At_, Bt_) do { __builtin_amdgcn_s_setprio(1); _Pragma("unroll") for (int m = 0; m < 4; ++m) _Pragma("unroll") for (int n = 0; n < 2; ++n) _Pragma("unroll") for (int k = 0; k < 2; ++k) \
    acc[ai][bj][m][n] = __builtin_amdgcn_mfma_f32_16x16x32_bf16(Bt_[n][k], At_[m][k], acc[ai][bj][m][n], 0, 0, 0); __builtin_amdgcn_s_setprio(0); } while (0)
#define G_WAIT_V(n) asm volatile("s_waitcnt vmcnt(" #n ")" ::: "memory")
#define G_WAIT_L(n) asm volatile("s_waitcnt lgkmcnt(" #n ")" ::: "memory")
#define G_BAR __builtin_amdgcn_s_barrier()
#define G_SCHED __builtin_amdgcn_sched_barrier(0)

template <class Epi>
DI void gemm_phase(LAS unsigned char* lds, const bf16_t* A, const bf16_t* Bt, int M, int N, int K, const Epi& E, const int wv__, int pitch = 0, int nsplit = 1, int wgoff = 0) {
    if (pitch == 0) pitch = K;
    const int tid = otid(), wid = __builtin_amdgcn_readfirstlane(tid >> 6), lane = tid & 63, wr = wid >> 2, wc = wid & 3, fr = lane & 15, fq = lane >> 4;
    const int nt = K / 64, nM = M / 256, nN = N / 256, ntiles = nM * nN * nsplit;
    unsigned voff[2];
#pragma unroll
    for (int i = 0; i < 2; ++i) { int R, C; stage_rc(tid * 16 + i * 8192, R, C); voff[i] = (unsigned)(R * pitch + C) * 2u; }
    const size_t kstep = 128, hstep = (size_t)128 * pitch * 2;
    const unsigned ldsw = (unsigned)wid * 1024u;
    const int aoff = lds_byte(wr * 64 + fr, fq * 8), boff = lds_byte(wc * 32 + fr, fq * 8);
    int tile = (int)blockIdx.x - wgoff;
    if (tile < 0 || tile >= ntiles) return;
    const char* cA; const char* cB; int pm, pnq;
#define G_TILE_PTRS(tl) do { const int ks_ = (tl) % nsplit, t2_ = (tl) / nsplit; pm = t2_ % nM; const int pn_ = t2_ / nM; pnq = pn_ + ks_ * nN; \
        cA = (const char*)A + (size_t)pm * 2 * hstep + (size_t)ks_ * K * 2; cB = (const char*)Bt + (size_t)pn_ * 2 * hstep + (size_t)ks_ * K * 2; } while (0)
    G_TILE_PTRS(tile);
    G_STAGE(G_SB(0, 0), cB); G_STAGE(G_SA(0, 0), cA); G_STAGE(G_SB(0, 1), cB + hstep); G_STAGE(G_SA(0, 1), cA + hstep);
    for (;;) {
        const int pm_cur = pm, pnq_cur = pnq;
        f32x4 acc[2][2][4][2];
#pragma unroll
        for (int a = 0; a < 2; ++a)
#pragma unroll
            for (int b = 0; b < 2; ++b)
#pragma unroll
                for (int m = 0; m < 4; ++m)
#pragma unroll
                    for (int n = 0; n < 2; ++n) acc[a][b][m][n] = (f32x4){0.f, 0.f, 0.f, 0.f};
        bf16x8 At[4][2], B0[2][2], B1[2][2];
        if (wr == 1) G_BAR;
        G_WAIT_V(4); G_BAR;
        G_STAGE(G_SB(1, 0), cB + kstep); G_STAGE(G_SA(1, 0), cA + kstep); G_STAGE(G_SB(1, 1), cB + hstep + kstep);
        G_WAIT_V(6); G_BAR;
        for (int t = 0; t < nt - 2; t += 2) {
            const char* a1 = cA + (size_t)(t + 1) * kstep;
            const char* a2 = cA + (size_t)(t + 2) * kstep; const char* b2 = cB + (size_t)(t + 2) * kstep;
            const char* a3 = a2 + kstep; const char* b3 = b2 + kstep;
            G_LDB(B0, 0, 0); G_SCHED; G_LDA(At, 0, 0); G_STAGE(G_SA(1, 1), a1 + hstep);
            G_WAIT_L(8); G_BAR; G_WAIT_L(0); G_MMA(0, 0, At, B0); G_BAR; G_SCHED;
            G_LDB(B1, 0, 1); G_STAGE(G_SB(0, 0), b2);
            G_BAR; G_WAIT_L(0); G_MMA(0, 1, At, B1); G_BAR;
            G_LDA(At, 0, 1); G_STAGE(G_SA(0, 0), a2);
            G_BAR; G_WAIT_L(0); G_MMA(1, 0, At, B0); G_BAR; G_SCHED;
            G_STAGE(G_SB(0, 1), b2 + hstep);
            G_WAIT_V(6); G_BAR; G_MMA(1, 1, At, B1); G_BAR;
            G_LDB(B0, 1, 0); G_SCHED; G_LDA(At, 1, 0); G_STAGE(G_SA(0, 1), a2 + hstep);
            G_WAIT_L(8); G_BAR; G_WAIT_L(0); G_MMA(0, 0, At, B0); G_BAR; G_SCHED;
            G_LDB(B1, 1, 1); G_STAGE(G_SB(1, 0), b3);
            G_BAR; G_WAIT_L(0); G_MMA(0, 1, At, B1); G_BAR;
            G_LDA(At, 1, 1); G_STAGE(G_SA(1, 0), a3);
            G_BAR; G_WAIT_L(0); G_MMA(1, 0, At, B0); G_BAR; G_SCHED;
            G_STAGE(G_SB(1, 1), b3 + hstep);
            G_WAIT_V(6); G_BAR; G_MMA(1, 1, At, B1); G_BAR;
        }
        {
            const char* a1 = cA + (size_t)(nt - 1) * kstep;
            G_LDB(B0, 0, 0); G_LDA(At, 0, 0); G_STAGE(G_SA(1, 1), a1 + hstep);
            G_BAR; G_WAIT_L(0); G_MMA(0, 0, At, B0); G_BAR;
            G_LDB(B1, 0, 1); G_BAR; G_WAIT_L(0); G_MMA(0, 1, At, B1); G_BAR;
            G_LDA(At, 0, 1); G_WAIT_V(4); G_BAR; G_WAIT_L(0); G_MMA(1, 0, At, B0); G_MMA(1, 1, At, B1); G_BAR;
        }
        {
            G_LDB(B0, 1, 0); G_LDA(At, 1, 0); G_WAIT_V(2); G_BAR; G_WAIT_L(0); G_MMA(0, 0, At, B0); G_BAR;
            G_LDB(B1, 1, 1); G_WAIT_V(0); G_BAR; G_WAIT_L(0); G_MMA(0, 1, At, B1); G_BAR;
            G_LDA(At, 1, 1); G_BAR; G_WAIT_L(0); G_MMA(1, 0, At, B0); G_MMA(1, 1, At, B1); G_BAR;
        }
        if (wr == 0) G_BAR;
        const int next = tile + (int)gridDim.x;
        if (next < ntiles) { G_TILE_PTRS(next); G_STAGE(G_SB(0, 0), cB); G_STAGE(G_SA(0, 0), cA); G_STAGE(G_SB(0, 1), cB + hstep); G_STAGE(G_SA(0, 1), cA + hstep); }
        E.run(acc, pm_cur, pnq_cur, wr, wc, fr, fq);
        if (next >= ntiles) break;
        tile = next;
    }
#undef G_TILE_PTRS
}

typedef f32x4 acc_t[2][2][4][2];
#define EPI_LOOP(...) _Pragma("unroll") for (int ai = 0; ai < 2; ++ai) _Pragma("unroll") for (int m = 0; m < 4; ++m) { const int row = pm * 256 + ai * 128 + wr * 64 + m * 16 + fr; \
    _Pragma("unroll") for (int bj = 0; bj < 2; ++bj) { const int col0 = pn * 256 + bj * 128 + wc * 32 + fq * 4; f32x4 v0 = acc[ai][bj][m][0], v1 = acc[ai][bj][m][1]; __VA_ARGS__ } }
struct RopeRegs { float fr[4]; };
DI void rope_preload(RopeRegs& R, int fq) {
#pragma unroll
    for (int j = 0; j < 4; ++j) R.fr[j] = __builtin_amdgcn_exp2f(-(float)(fq * 4 + j) * (13.287712379549449f / 16.f)) * 0.15915494309189535f;
}
DI void rope_rot(const RopeRegs& R, int pos, f32x4& a, f32x4& b) {
    const float pf = (float)pos;
#pragma unroll
    for (int j = 0; j < 4; ++j) {
        const float rev = pf * R.fr[j];
        const float c = __builtin_amdgcn_cosf(rev), sn = __builtin_amdgcn_sinf(rev);
        const float x1 = a[j], x2 = b[j]; a[j] = x1 * c - x2 * sn; b[j] = x1 * sn + x2 * c;
    }
}
struct Epi0 {
    bf16_t *QD, *KD, *VD, *CQR, *KPE, *SG; float *CKVR, *oak, *oav, *okpe; const f32x2* rope;
    DI void run(const acc_t& acc, int pm, int pn, int wr, int wc, int fr, int fq) const {
        const bool samp = pm >= 16;
        const int cb = pn * 256;
        const bool ropey = samp && (cb < 2048 || cb == 3840);
        RopeRegs RR; rope_preload(RR, fq); (void)ropey;
        const int prow0 = (((pm * 256) & 1023) >> 6) + wr;
        EPI_LOOP(
            const int kvr = kvrow_of(row);
            if (col0 < 2048 || (col0 >= 3840 && col0 < 3904)) {
                f32x4 r0 = v0, r1 = v1;
                if (samp) rope_rot(RR, ((col0 >> 5) & 1) ? (m * 16 + fr) : (prow0 + 2 * ai), r0, r1);
                if (col0 < 1024) { bf16_t* q = QD + (size_t)row * 1024 + col0; st_bf4(q, r0); st_bf4(q + 16, r1); }
                else if (col0 < 2048) {
                    const int c = col0 - 1024; bf16_t* q = KD + (size_t)kvr * 1024 + c; st_bf4(q, r0); st_bf4(q + 16, r1);
                    if (!samp) { float* o = oak + (size_t)row * 1024 + c; st_f4(o, v0); st_f4(o + 16, v1); }
                } else {
                    const int c = col0 - 3840; bf16_t* q = KPE + (size_t)kvr * 64 + c; st_bf4(q, r0); st_bf4(q + 16, r1);
                    if (!samp) { float* o = okpe + (size_t)row * 64 + c; st_f4(o, v0); st_f4(o + 16, v1); }
                }
            } else if (col0 < 3072) {
                const int c = col0 - 2048; bf16_t* q = VD + (size_t)kvr * 1024 + c; st_bf4(q, v0); st_bf4(q + 16, v1);
                if (!samp) { float* o = oav + (size_t)row * 1024 + c; st_f4(o, v0); st_f4(o + 16, v1); }
            } else if (col0 < 3584) {
                bf16_t* q = CQR + (size_t)row * 512 + (col0 - 3072); st_bf4(q, v0); st_bf4(q + 16, v1);
            } else if (col0 < 3840) {
                float* o = CKVR + (size_t)row * 256 + (col0 - 3584); st_f4(o, v0); st_f4(o + 16, v1);
            } else if (col0 < 5952) {
                f32x4 s0, s1;
                _Pragma("unroll") for (int j = 0; j < 4; ++j) { s0[j] = v0[j] * sigmoidf_(v0[j]); s1[j] = v1[j] * sigmoidf_(v1[j]); }
                bf16_t* q = SG + (size_t)row * 2048 + (col0 - 3904); st_bf4(q, s0); st_bf4(q + 16, s1);
            }
        )
    }
};
struct EpiQ {
    bf16_t* QB; const f32x2* rope;
    DI void run(const acc_t& acc, int pm, int pn, int wr, int wc, int fr, int fq) const {
        const bool samp = pm >= 16;
        RopeRegs RR; rope_preload(RR, fq);
        const int prow0 = (((pm * 256) & 1023) >> 6) + wr;
        EPI_LOOP(
            const int hh = col0 / 192; const int w = col0 - hh * 192;
            if (samp && w >= 128) rope_rot(RR, (((w - 128) >> 5) & 1) ? (m * 16 + fr) : (prow0 + 2 * ai), v0, v1);
            bf16_t* q = QB + (size_t)row * 1536 + col0; st_bf4(q, v0); st_bf4(q + 16, v1);
        )
    }
};
struct EpiBf {
    bf16_t* O; int ldc; int ncols;
    DI void run(const acc_t& acc, int pm, int pn, int wr, int wc, int fr, int fq) const {
        EPI_LOOP(
            if (col0 < ncols) { bf16_t* q = O + (size_t)row * ldc + col0; st_bf4(q, v0); st_bf4(q + 16, v1); }
        )
    }
};
struct EpiOut {
    const float* xp; const float* xs; float* xo; const float* modg;
    DI void run(const acc_t& acc, int pm, int pn, int wr, int wc, int fr, int fq) const {
        const int brow = pm * 256, cbase = pn * 256 + wc * 32 + fq * 4;
        const float* g = modg + cond_of(brow) * 6144 + cbase;
        f32x4 gg[2][2];
#pragma unroll
        for (int bj = 0; bj < 2; ++bj) { gg[bj][0] = ld_f4(g + bj * 128); gg[bj][1] = ld_f4(g + bj * 128 + 16); }
        const float* xi = (brow < 4096 ? xp + (size_t)brow * 2048 : xs + (size_t)(brow - 4096) * 2048) + (size_t)(wr * 64 + fr) * 2048 + cbase;
        float* xob = xo + (size_t)(brow + wr * 64 + fr) * 2048 + cbase;
        f32x4 xv[4][2][2][2];
#define EO_LOAD(b) _Pragma("unroll") for (int mm = 0; mm < 2; ++mm) _Pragma("unroll") for (int bj = 0; bj < 2; ++bj) { \
            const float* q = xi + (size_t)(((b) >> 1) * 128 + (((b) & 1) * 2 + mm) * 16) * 2048 + bj * 128; xv[b][mm][bj][0] = ld_f4(q); xv[b][mm][bj][1] = ld_f4(q + 16); }
#define EO_STORE(b) _Pragma("unroll") for (int mm = 0; mm < 2; ++mm) _Pragma("unroll") for (int bj = 0; bj < 2; ++bj) { \
            float* o = xob + (size_t)(((b) >> 1) * 128 + (((b) & 1) * 2 + mm) * 16) * 2048 + bj * 128; \
            st_f4(o, xv[b][mm][bj][0] + gg[bj][0] * acc[(b) >> 1][bj][((b) & 1) * 2 + mm][0]); st_f4(o + 16, xv[b][mm][bj][1] + gg[bj][1] * acc[(b) >> 1][bj][((b) & 1) * 2 + mm][1]); }
        EO_LOAD(0) EO_LOAD(1) EO_STORE(0) EO_LOAD(2) EO_STORE(1) EO_LOAD(3) EO_STORE(2) EO_STORE(3)
#undef EO_LOAD
#undef EO_STORE
    }
};
struct EpiGate {
    bf16_t* O; const float* modg;
    DI void run(const acc_t& acc, int pm, int pn, int wr, int wc, int fr, int fq) const {
        const float* g = modg + cond_of(pm * 256) * 6144 + pn * 256 + wc * 32 + fq * 4;
        f32x4 gg[2][2];
#pragma unroll
        for (int bj = 0; bj < 2; ++bj) { gg[bj][0] = ld_f4(g + bj * 128); gg[bj][1] = ld_f4(g + bj * 128 + 16); }
        EPI_LOOP(
            bf16_t* q = O + (size_t)row * 2048 + col0; st_bf4(q, gg[bj][0] * v0); st_bf4(q + 16, gg[bj][1] * v1);
        )
    }
};
typedef _Float16 h16x2 __attribute__((ext_vector_type(2)));
DI unsigned pkh2(float a, float b) { f32x2 v = {a, b}; h16x2 r = __builtin_convertvector(v, h16x2); return __builtin_bit_cast(unsigned, r); }
DI float h2f_(unsigned short h) { return (float)__builtin_bit_cast(_Float16, h); }
DI f32x4 h4_to_f4(u32x2 u) { const unsigned u0 = u[0], u1 = u[1]; f32x4 r = {h2f_((unsigned short)(u0 & 0xffffu)), h2f_((unsigned short)(u0 >> 16)), h2f_((unsigned short)(u1 & 0xffffu)), h2f_((unsigned short)(u1 >> 16))}; return r; }
template <int CTRL> DI float dpp_rowshift0(float x) { return __int_as_float(__builtin_amdgcn_update_dpp(0, __float_as_int(x), CTRL, 0xF, 0xF, true)); }
struct EpiDecay {
    bf16_t* O; const float* bias; int rev;
    DI void run(const acc_t& acc, int pm, int pn, int wr, int wc, int fr, int fq) const {
        const float* bp = bias + pn * 256 + wc * 32 + fq * 4;
        f32x4 bb[2][2];
#pragma unroll
        for (int bj = 0; bj < 2; ++bj) { bb[bj][0] = ld_f4(bp + bj * 128); bb[bj][1] = ld_f4(bp + bj * 128 + 16); }
        EPI_LOOP(
            f32x4 r0; f32x4 r1;
            _Pragma("unroll") for (int j = 0; j < 4; ++j) {
                float a = 0.6065306597126334f * sigmoidf_(bb[bj][0][j] + v0[j]); float b = 0.6065306597126334f * sigmoidf_(bb[bj][1][j] + v1[j]);
                if (rev) {
                    a += dpp_rowshift0<0x101>(a); a += dpp_rowshift0<0x102>(a); a += dpp_rowshift0<0x104>(a); a += dpp_rowshift0<0x108>(a);
                    b += dpp_rowshift0<0x101>(b); b += dpp_rowshift0<0x102>(b); b += dpp_rowshift0<0x104>(b); b += dpp_rowshift0<0x108>(b);
                } else {
                    a += dpp_rowshift0<0x111>(a); a += dpp_rowshift0<0x112>(a); a += dpp_rowshift0<0x114>(a); a += dpp_rowshift0<0x118>(a);
                    b += dpp_rowshift0<0x111>(b); b += dpp_rowshift0<0x112>(b); b += dpp_rowshift0<0x114>(b); b += dpp_rowshift0<0x118>(b);
                }
                r0[j] = a; r1[j] = b;
            }
            bf16_t* q = O + (size_t)row * 2048 + col0;
            { u32x2 u = {pkh2(r0[0], r0[1]), pkh2(r0[2], r0[3])}; *(u32x2*)q = u; }
            { u32x2 u = {pkh2(r1[0], r1[1]), pkh2(r1[2], r1[3])}; *(u32x2*)(q + 16) = u; }
        )
    }
};
struct EpiLora {
    bf16_t* O; const float* bias; float mul;
    DI void run(const acc_t& acc, int pm, int pn, int wr, int wc, int fr, int fq) const {
        const float* bp = bias + pn * 256 + wc * 32 + fq * 4;
        f32x4 bb[2][2];
#pragma unroll
        for (int bj = 0; bj < 2; ++bj) { bb[bj][0] = ld_f4(bp + bj * 128); bb[bj][1] = ld_f4(bp + bj * 128 + 16); }
        EPI_LOOP(
            f32x4 r0, r1;
            _Pragma("unroll") for (int j = 0; j < 4; ++j) { r0[j] = mul * sigmoidf_(bb[bj][0][j] + v0[j]); r1[j] = mul * sigmoidf_(bb[bj][1][j] + v1[j]); }
            bf16_t* q = O + (size_t)row * 2048 + col0; st_bf4(q, r0); st_bf4(q + 16, r1);
        )
    }
};

DI void transpose_tile(LAS float* tl, const float* src, int K, int N, bf16_t* dst, int Kpad, int kt, int ntile, const int wv__) {
    const int tid = otid(), k0 = kt * 64, n0 = ntile * 256;
    const int kr = tid >> 6, nc = (tid & 63) * 4;
    f32x4 v[8];
#pragma unroll
    for (int i = 0; i < 8; ++i) {
        const int k = k0 + kr + i * 8;
        v[i] = (f32x4){0.f, 0.f, 0.f, 0.f};
        if (k < K && n0 + nc < N) v[i] = ld_f4(src + (size_t)k * N + n0 + nc);
    }
#pragma unroll
    for (int i = 0; i < 8; ++i) {
        LAS float* t = tl + (kr + i * 8) * 257 + nc;
        t[0] = v[i][0]; t[1] = v[i][1]; t[2] = v[i][2]; t[3] = v[i][3];
    }
    __syncthreads();
    const int kc = (tid & 7) * 8;
#pragma unroll
    for (int i = 0; i < 4; ++i) {
        const int n = (tid >> 3) + i * 64;
        float e[8];
#pragma unroll
        for (int j = 0; j < 8; ++j) e[j] = tl[(kc + j) * 257 + n];
        u32x4 o = {pk2(e[0], e[1]), pk2(e[2], e[3]), pk2(e[4], e[5]), pk2(e[6], e[7])};
        *(u32x4*)(dst + (size_t)(n0 + n) * Kpad + k0 + kc) = o;
    }
    __syncthreads();
}
DI void cvt_cache(const float* src, bf16_t* dst, int W, int item, const int wv__) {
    const size_t e = (size_t)item * 4096 + otid() * 8;
    const int srow = (int)(e / W), c = (int)(e % W);
    const int b = srow >> 9, s = srow & 511;
    const int drow = 4096 + b * 1536 + 1024 + s;
    const f32x4 a = ld_f4(src + e), bb = ld_f4(src + e + 4);
    u32x4 o = {pk2(a[0], a[1]), pk2(a[2], a[3]), pk2(bb[0], bb[1]), pk2(bb[2], bb[3])};
    *(u32x4*)(dst + (size_t)drow * W + c) = o;
}
DI void mod_job(const Params& p, LAS unsigned char* lds, int item, const int wv__) {
    LAS float* sl = (LAS float*)lds;
    LAS float* red = sl + 5 * 2048;
    const int tid = otid();
    const float* cc = p.in[8]; const float* cctx = p.in[9];
    for (int i = tid; i < 5 * 2048; i += NTHREADS) { const int cnd = i >> 11, k = i & 2047; const float c = cnd == 0 ? cctx[k] : cc[(cnd - 1) * 2048 + k]; sl[i] = c * sigmoidf_(c); }
    __syncthreads();
    const int l = item / 192, n0 = (item % 192) * 32;
    const int kg = tid >> 3, cl = (tid & 7) * 4;
    const float* W = p.in[10] + (size_t)l * 2048 * 6144 + n0 + cl;
    f32x4 acc[5];
#pragma unroll
    for (int c = 0; c < 5; ++c) acc[c] = (f32x4){0.f, 0.f, 0.f, 0.f};
#pragma unroll 8
    for (int pass = 0; pass < 32; ++pass) {
        const int k = pass * 64 + kg;
        const f32x4 w = ld_f4(W + (size_t)k * 6144);
#pragma unroll
        for (int c = 0; c < 5; ++c) acc[c] += sl[c * 2048 + k] * w;
    }
#pragma unroll
    for (int c = 0; c < 5; ++c)
#pragma unroll
        for (int j = 0; j < 4; ++j) red[kg * 160 + c * 32 + cl + j] = acc[c][j];
    __syncthreads();
    if (tid < 160) {
        float s = 0.f;
        for (int g = 0; g < 64; ++g) s += red[g * 160 + tid];
        const int cnd = tid >> 5, c = tid & 31;
        float* mod = (float*)(p.ws + OFF_MOD);
        mod[(size_t)(l * 5 + cnd) * 6144 + n0 + c] = s + p.in[11][l * 6144 + n0 + c];
    }
    __syncthreads();
}
DI void prep_phase(const Params& p, LAS unsigned char* lds, const int wv__) {
    constexpr int J_MOD = 384;
    constexpr int J_T0 = 32 * 24, J_T1 = 32 * 34, J_TO = 32 * 8, J_TUQ = 8 * 6, J_TUKV = 4 * 8, J_TL = 2 * 8;
    constexpr int J_CK = 512, J_CV = 512, J_CC = 128, J_CP = 32;
    constexpr int TOTAL = J_MOD + J_T0 + J_T1 + 2 * J_TO + J_TUQ + J_TUKV + 4 * J_TL + J_CK + J_CV + J_CC + J_CP + 1;
    LAS float* tl = (LAS float*)lds;
    for (int job = blockIdx.x; job < TOTAL + 384; job += gridDim.x) {
        int j = job;
        if (gridDim.x == 256) {
            if (job >= 512 && job < 1280) { if ((job & 255) < 128) continue; j = job - (((job - 512) >> 8) * 128 + 128); }
            else if (job >= 1280) j = job - 384;
        } else if (job >= TOTAL) continue;
        if (j < J_MOD) { mod_job(p, lds, j, wv__); continue; } j -= J_MOD;
        if (j < J_T0) { transpose_tile(tl, p.in[14], 2048, 5952, (bf16_t*)(p.ws + OFF_WT0), 2048, j % 32, j / 32, wv__); continue; } j -= J_T0;
        if (j < J_T1) { transpose_tile(tl, p.in[22], 2048, 8576, (bf16_t*)(p.ws + OFF_WT1), 2048, j % 32, j / 32, wv__); continue; } j -= J_T1;
        if (j < J_TO) { transpose_tile(tl, p.in[15], 2048, 2048, (bf16_t*)(p.ws + OFF_WOT0), 2048, j % 32, j / 32, wv__); continue; } j -= J_TO;
        if (j < J_TO) { transpose_tile(tl, p.in[23], 2048, 2048, (bf16_t*)(p.ws + OFF_WOT1), 2048, j % 32, j / 32, wv__); continue; } j -= J_TO;
        if (j < J_TUQ) { transpose_tile(tl, p.in[19], 512, 1536, (bf16_t*)(p.ws + OFF_WUQ), 512, j % 8, j / 8, wv__); continue; } j -= J_TUQ;
        if (j < J_TUKV) { transpose_tile(tl, p.in[21], 256, 2048, (bf16_t*)(p.ws + OFF_WUKV), 256, j % 4, j / 4, wv__); continue; } j -= J_TUKV;
        if (j < 4 * J_TL) {
            const int which = j / J_TL, jj = j % J_TL, z = which & 1;
            const float* src = (which < 2 ? p.in[26] : p.in[28]) + (size_t)z * 96 * 2048;
            bf16_t* dst = (bf16_t*)(p.ws + (which < 2 ? OFF_W2T : OFF_A2T)) + (size_t)z * 2048 * 128;
            transpose_tile(tl, src, 96, 2048, dst, 128, jj % 2, jj / 2, wv__); continue;
        } j -= 4 * J_TL;
        if (j < J_CK) { cvt_cache(p.in[2], (bf16_t*)(p.ws + OFF_KD), 1024, j, wv__); continue; } j -= J_CK;
        if (j < J_CV) { cvt_cache(p.in[3], (bf16_t*)(p.ws + OFF_VD), 1024, j, wv__); continue; } j -= J_CV;
        if (j < J_CC) { cvt_cache(p.in[4], (bf16_t*)(p.ws + OFF_CKVA), 256, j, wv__); continue; } j -= J_CC;
        if (j < J_CP) { cvt_cache(p.in[5], (bf16_t*)(p.ws + OFF_KPE), 64, j, wv__); continue; } j -= J_CP;
        {
            f32x2* tab = (f32x2*)(p.ws + OFF_ROPE);
            for (int i = otid(); i < 1024; i += NTHREADS) {
                const int pos = i >> 4, fi = i & 15;
                const float f = powf(10000.f, -(float)fi / 16.f);
                const float ang = (float)pos * f;
                f32x2 t = {cosf(ang), sinf(ang)};
                tab[i] = t;
            }
        }
    }
}

DI void norm_mod_phase(const float* xp, const float* xs, const float* g, const float* modl, bf16_t* H, const int wv__) {
    const int tid_ = otid(), lane = tid_ & 63, wg = blockIdx.x * 8 + (tid_ >> 6), nw = gridDim.x * 8;
    for (int row = wg; row < 8192; row += nw) {
        const float* x = row < 4096 ? xp + (size_t)row * 2048 : xs + (size_t)(row - 4096) * 2048;
        const float* md = modl + cond_of(row) * 6144;
        f32x4 v[8]; float ss = 0.f;
#pragma unroll
        for (int i = 0; i < 8; ++i) { v[i] = ld_f4(x + i * 256 + lane * 4); ss += v[i][0] * v[i][0] + v[i][1] * v[i][1] + v[i][2] * v[i][2] + v[i][3] * v[i][3]; }
        f32x4 gs[8], sh[8];
#pragma unroll
        for (int i = 0; i < 8; ++i) { const int c = i * 256 + lane * 4; gs[i] = ld_f4(g + c) * (1.f + ld_f4(md + 2048 + c)); sh[i] = ld_f4(md + c); }
        ss = wave_sum(ss, lane);
        const float rstd = rsqrtf(ss * (1.f / 2048.f) + 1e-6f);
#pragma unroll
        for (int i = 0; i < 8; ++i) {
            const int c = i * 256 + lane * 4;
            const f32x4 h = v[i] * rstd * gs[i] + sh[i];
            st_bf4(H + (size_t)row * 2048 + c, h);
        }
    }
}
DI void final_norm_phase(float* x, const bf16_t* O2, const float* g, const int wv__) {
    const int tid_ = otid(), lane = tid_ & 63, wg = blockIdx.x * 8 + (tid_ >> 6), nw = gridDim.x * 8;
    for (int row = wg; row < 8192; row += nw) {
        float* xr = x + (size_t)row * 2048;
        f32x4 v[8]; float ss = 0.f;
#pragma unroll
        for (int i = 0; i < 8; ++i) { v[i] = ld_f4(xr + i * 256 + lane * 4) + bf4_to_f4(*(const u32x2*)(O2 + (size_t)row * 2048 + i * 256 + lane * 4)); ss += v[i][0] * v[i][0] + v[i][1] * v[i][1] + v[i][2] * v[i][2] + v[i][3] * v[i][3]; }
        ss = wave_sum(ss, lane);
        const float rstd = rsqrtf(ss * (1.f / 2048.f) + 1e-6f);
#pragma unroll
        for (int i = 0; i < 8; ++i) { const int c = i * 256 + lane * 4; st_f4(xr + c, v[i] * rstd * ld_f4(g + c)); }
    }
}
DI void lat_norm_phase(const Params& p, const int wv__) {
    const int tid_ = otid(), lane = tid_ & 63, wg = blockIdx.x * 8 + (tid_ >> 6), nw = gridDim.x * 8;
    const bf16_t* CQR = (const bf16_t*)(p.ws + OFF_CQR); const float* CKVR = (const float*)(p.ws + OFF_CKVR);
    bf16_t* CQN = (bf16_t*)(p.ws + OFF_CQN); bf16_t* CKVA = (bf16_t*)(p.ws + OFF_CKVA);
    const float* qg = p.in[18]; const float* kg = p.in[20];
    for (int row = wg; row < 8192; row += nw) {
        const u32x4 u = *(const u32x4*)(CQR + (size_t)row * 512 + lane * 8);
        float q[8] = {bflo(u[0]), bfhi(u[0]), bflo(u[1]), bfhi(u[1]), bflo(u[2]), bfhi(u[2]), bflo(u[3]), bfhi(u[3])};
        float ss = 0.f;
#pragma unroll
        for (int i = 0; i < 8; ++i) ss += q[i] * q[i];
        ss = wave_sum(ss, lane);
        float rstd = rsqrtf(ss * (1.f / 512.f) + 1e-6f);
        const f32x4 g0 = ld_f4(qg + lane * 8), g1 = ld_f4(qg + lane * 8 + 4);
        u32x4 o = {pk2(q[0] * rstd * g0[0], q[1] * rstd * g0[1]), pk2(q[2] * rstd * g0[2], q[3] * rstd * g0[3]),
                   pk2(q[4] * rstd * g1[0], q[5] * rstd * g1[1]), pk2(q[6] * rstd * g1[2], q[7] * rstd * g1[3])};
        *(u32x4*)(CQN + (size_t)row * 512 + lane * 8) = o;
        const f32x4 kv = ld_f4(CKVR + (size_t)row * 256 + lane * 4);
        float s2 = kv[0] * kv[0] + kv[1] * kv[1] + kv[2] * kv[2] + kv[3] * kv[3];
        s2 = wave_sum(s2, lane);
        rstd = rsqrtf(s2 * (1.f / 256.f) + 1e-6f);
        const f32x4 r = kv * rstd * ld_f4(kg + lane * 4);
        if (row < 4096) st_f4(p.out + OUT_CKV + (size_t)row * 256 + lane * 4, r);
        st_bf4(CKVA + (size_t)kvrow_of(row) * 256 + lane * 4, r);
    }
}

template <int TYPE>
DI void attn_unit(const Params& p, LAS unsigned char* lds, int samp, int b, int h, int qb, float lam, const int wv__) {
    constexpr int NC = TYPE == 0 ? 2 : 1, KS = TYPE == 0 ? 2 : 6, KDIM = TYPE == 0 ? 128 : 192;
    constexpr int KP = KDIM * 2 + 16, VP = 288, CPK = KDIM / 8, NKC = 64 * CPK / NTHREADS;
    LAS unsigned char* Ks = lds; LAS unsigned char* Vs = lds + 64 * KP;
    const int tid = otid(), wid = tid >> 6, lane = tid & 63, fr = lane & 15, fq = lane >> 4;
    const int row0 = samp ? 4096 + b * 1024 + qb * 128 : b * 256 + qb * 128, qrow = row0 + wid * 16 + fr;
    const int kv0 = samp ? 4096 + b * 1536 : b * 256, ntile = samp ? 24 : 4;
    const bf16_t* QD = (const bf16_t*)(p.ws + OFF_QD); const bf16_t* KD = (const bf16_t*)(p.ws + OFF_KD); const bf16_t* VD = (const bf16_t*)(p.ws + OFF_VD);
    const bf16_t* QB = (const bf16_t*)(p.ws + OFF_QB); const bf16_t* KVB = (const bf16_t*)(p.ws + OFF_KVB); const bf16_t* KPE = (const bf16_t*)(p.ws + OFF_KPE);
    bf16x8 qf[NC * KS];
#pragma unroll
    for (int i = 0; i < NC * KS; ++i)
        qf[i] = TYPE == 0 ? *(const bf16x8*)(QD + (size_t)qrow * 1024 + h * 128 + i * 32 + fq * 8) : *(const bf16x8*)(QB + (size_t)qrow * 1536 + h * 192 + i * 32 + fq * 8);
    f32x4 o[NC][8];
    float mrun[NC], lrun[NC];
#pragma unroll
    for (int c = 0; c < NC; ++c) { mrun[c] = -1e30f; lrun[c] = 0.f;
#pragma unroll
        for (int v = 0; v < 8; ++v) o[c][v] = (f32x4){0.f, 0.f, 0.f, 0.f}; }
    const float sl2 = (TYPE == 0 ? 0.125f : 0.07216878364870322f) * 1.4426950408889634f;
    u32x4 kreg[NKC], vreg[2];
    auto prefetch = [&](int t) {
#pragma unroll
        for (int i = 0; i < NKC; ++i) {
            const int q = tid + i * NTHREADS, key = q / CPK, ch = q % CPK; const size_t r = (size_t)(kv0 + t * 64 + key);
            const bf16_t* src;
            if (TYPE == 0) src = KD + r * 1024 + h * 128 + ch * 8;
            else src = ch < 16 ? KVB + r * 2048 + h * 256 + ch * 8 : KPE + r * 64 + (ch - 16) * 8;
            kreg[i] = *(const u32x4*)src;
        }
#pragma unroll
        for (int i = 0; i < 2; ++i) {
            const int q = tid + i * NTHREADS, key = q >> 4, ch = q & 15; const size_t r = (size_t)(kv0 + t * 64 + key);
            const bf16_t* src = TYPE == 0 ? VD + r * 1024 + h * 128 + ch * 8 : KVB + r * 2048 + h * 256 + 128 + ch * 8;
            vreg[i] = *(const u32x4*)src;
        }
    };
    constexpr int BUFB = 64 * KP + 64 * VP;
    auto lds_write = [&](int buf) {
        LAS unsigned char* Kb = lds + buf * BUFB; LAS unsigned char* Vb = Kb + 64 * KP;
#pragma unroll
        for (int i = 0; i < NKC; ++i) { const int q = tid + i * NTHREADS, key = q / CPK, ch = q % CPK; *(LAS u32x4*)(Kb + key * KP + ch * 16) = kreg[i]; }
#pragma unroll
        for (int i = 0; i < 2; ++i) { const int q = tid + i * NTHREADS, key = q >> 4, ch = q & 15; *(LAS u32x4*)(Vb + key * VP + ch * 16) = vreg[i]; }
    };
    prefetch(0);
    lds_write(0);
    if (ntile > 1) prefetch(1);
    __syncthreads();
    const int qq = (lane & 15) >> 2, pp = lane & 3;
    for (int t = 0; t < ntile; ++t) {
        if (t + 1 < ntile) lds_write((t + 1) & 1);
        if (t + 2 < ntile) prefetch(t + 2);
        LAS unsigned char* Kc = lds + (t & 1) * BUFB; LAS unsigned char* Vc = Kc + 64 * KP;
        f32x4 s[NC][4];
#pragma unroll
        for (int c = 0; c < NC; ++c)
#pragma unroll
            for (int nt = 0; nt < 4; ++nt) {
                s[c][nt] = (f32x4){0.f, 0.f, 0.f, 0.f};
#pragma unroll
                for (int ks = 0; ks < KS; ++ks) {
                    const bf16x8 kf = *(const LAS bf16x8*)(Kc + (nt * 16 + fr) * KP + (c * KS + ks) * 64 + fq * 16);
                    s[c][nt] = __builtin_amdgcn_mfma_f32_16x16x32_bf16(kf, qf[c * KS + ks], s[c][nt], 0, 0, 0);
                }
                if (nt & 1) __builtin_amdgcn_sched_barrier(0);
            }
        __builtin_amdgcn_sched_barrier(0);
        bf16x8 pb[NC][2];
#pragma unroll
        for (int c = 0; c < NC; ++c) {
            float mx = -1e30f;
#pragma unroll
            for (int nt = 0; nt < 4; ++nt)
#pragma unroll
                for (int j = 0; j < 4; ++j) mx = fmaxf(mx, s[c][nt][j]);
            mx = fmaxf(mx, shx(mx, 16, lane)); mx = fmaxf(mx, shx(mx, 32, lane));
            const float mnew = fmaxf(mrun[c], mx);
            const float alpha = __builtin_amdgcn_exp2f((mrun[c] - mnew) * sl2);
            mrun[c] = mnew;
            const float nm = -mnew * sl2;
            float ls = 0.f;
#pragma unroll
            for (int nt = 0; nt < 4; ++nt)
#pragma unroll
                for (int j = 0; j < 4; ++j) { const float e = __builtin_amdgcn_exp2f(fmaf(s[c][nt][j], sl2, nm)); s[c][nt][j] = e; ls += e; }
            lrun[c] = lrun[c] * alpha + ls;
            if (__builtin_amdgcn_ballot_w64(alpha != 1.f) != 0ull) {
#pragma unroll
                for (int v = 0; v < 8; ++v) o[c][v] *= alpha;
            }
#pragma unroll
            for (int s2 = 0; s2 < 2; ++s2) {
                u32x4 u = {pk2(s[c][2 * s2][0], s[c][2 * s2][1]), pk2(s[c][2 * s2][2], s[c][2 * s2][3]), pk2(s[c][2 * s2 + 1][0], s[c][2 * s2 + 1][1]), pk2(s[c][2 * s2 + 1][2], s[c][2 * s2 + 1][3])};
                pb[c][s2] = __builtin_bit_cast(bf16x8, u);
            }
        }
#pragma unroll
        for (int s2 = 0; s2 < 2; ++s2)
#pragma unroll
            for (int v = 0; v < 8; ++v) {
                LAS unsigned char* a0 = Vc + (32 * s2 + 4 * fq + qq) * VP + v * 32 + 8 * pp;
                const s16x4 lo = __builtin_amdgcn_ds_read_tr16_b64_v4i16((LAS s16x4*)a0);
                const s16x4 hi = __builtin_amdgcn_ds_read_tr16_b64_v4i16((LAS s16x4*)(a0 + 16 * VP));
                const bf16x8 va = __builtin_shufflevector(lo, hi, 0, 1, 2, 3, 4, 5, 6, 7);
#pragma unroll
                for (int c = 0; c < NC; ++c) o[c][v] = __builtin_amdgcn_mfma_f32_16x16x32_bf16(va, pb[c][s2], o[c][v], 0, 0, 0);
                if ((v & 1) == 1) __builtin_amdgcn_sched_barrier(0);
            }
        __syncthreads();
    }
    float linv[NC];
#pragma unroll
    for (int c = 0; c < NC; ++c) { float l = lrun[c]; l += shx(l, 16, lane); l += shx(l, 32, lane); linv[c] = 1.f / l; }
    const bf16_t* SG = (const bf16_t*)(p.ws + OFF_SG0);
    bf16_t* Y = (bf16_t*)(p.ws + OFF_H);
    if (TYPE == 0) {
        float ss = 0.f;
#pragma unroll
        for (int v = 0; v < 8; ++v)
#pragma unroll
            for (int j = 0; j < 4; ++j) { const float x = o[0][v][j] * linv[0] - lam * o[NC - 1][v][j] * linv[NC - 1]; o[0][v][j] = x; ss += x * x; }
        ss += shx(ss, 16, lane); ss += shx(ss, 32, lane);
        const float rstd = rsqrtf(ss * (1.f / 128.f) + 1e-6f) * 0.8f;
        const float* sg = p.in[17];
#pragma unroll
        for (int v = 0; v < 8; ++v) {
            const int d = v * 16 + fq * 4;
            const f32x4 g = ld_f4(sg + d);
            const f32x4 gt = bf4_to_f4(*(const u32x2*)(SG + (size_t)qrow * 2048 + h * 128 + d));
            st_bf4(Y + (size_t)qrow * 2048 + h * 128 + d, o[0][v] * rstd * g * gt);
        }
    } else {
#pragma unroll
        for (int v = 0; v < 8; ++v) {
            const int d = v * 16 + fq * 4;
            const f32x4 gt = bf4_to_f4(*(const u32x2*)(SG + (size_t)qrow * 2048 + 1024 + h * 128 + d));
            st_bf4(Y + (size_t)qrow * 2048 + 1024 + h * 128 + d, o[0][v] * linv[0] * gt);
        }
    }
}
DI void attn_phase(const Params& p, LAS unsigned char* lds, const int wv__) {
    const float* lp = p.in[16];
    const int lane = otid() & 63;
    const float s01 = wave_sum(lp[lane] * lp[64 + lane], lane), s23 = wave_sum(lp[128 + lane] * lp[192 + lane], lane);
    const float lam = __expf(s01) - __expf(s23) + 0.2f;
    for (int u = blockIdx.x; u < 1024; u += gridDim.x) {
        const int grp = u >> 8, i = u & 255;
        if (grp == 0) attn_unit<0>(p, lds, 1, i >> 6, (i >> 3) & 7, i & 7, lam, wv__);
        else if (grp == 1) attn_unit<1>(p, lds, 1, i >> 6, (i >> 3) & 7, i & 7, lam, wv__);
        else if (grp == 2) attn_unit<0>(p, lds, 0, i >> 4, (i >> 1) & 7, i & 1, lam, wv__);
        else attn_unit<1>(p, lds, 0, i >> 4, (i >> 1) & 7, i & 1, lam, wv__);
    }
}

DI f32x4 tshift(f32x4 x, f32x4 pv, f32x4 nx, f32x4 m0, f32x4 m1) { return x + m0 * (pv - x) + m1 * (nx - x); }
DI void seq_pos(int row, int& t, int& T) { if (row < 4096) { t = row & 255; T = 256; } else { t = (row - 4096) & 1023; T = 1024; } }

DI void lora_in_phase(const Params& p, const int wv__) {
    const int tid_ = otid(), lane = tid_ & 63, wg = blockIdx.x * 8 + (tid_ >> 6), nw = gridDim.x * 8;
    const bf16_t* PART = (const bf16_t*)(p.ws + OFF_PART);
    const float* mu = p.in[24];
    const int o = lane * 8, arr = o >> 7, idx = o & 127;
    bf16_t* dstb = (bf16_t*)(p.ws + (arr < 2 ? OFF_WDT : OFF_ADT)) + (size_t)(arr & 1) * 8192 * 128 + idx;
    for (int row = wg; row < 8192; row += nw) {
        u32x4 res = {0u, 0u, 0u, 0u};
        if (idx < 96) {
            int t, T; seq_pos(row, t, T);
            const int col = 8192 + arr * 96 + idx;
            const bf16_t* c = PART + (size_t)row * 2048 + arr * 96 + idx;
            float xc[8], xp[8], xn[8];
#pragma unroll
            for (int e = 0; e < 8; ++e) { xc[e] = 0.f; xp[e] = 0.f; xn[e] = 0.f; }
#pragma unroll
            for (int ks = 0; ks < 4; ++ks) {
                const u32x4 uc = *(const u32x4*)(c + ks * 512);
#pragma unroll
                for (int e = 0; e < 4; ++e) { xc[2 * e] += bflo(uc[e]); xc[2 * e + 1] += bfhi(uc[e]); }
                if (t > 0) { const u32x4 up = *(const u32x4*)(c + ks * 512 - 2048);
#pragma unroll
                    for (int e = 0; e < 4; ++e) { xp[2 * e] += bflo(up[e]); xp[2 * e + 1] += bfhi(up[e]); } }
                if (t < T - 1) { const u32x4 un = *(const u32x4*)(c + ks * 512 + 2048);
#pragma unroll
                    for (int e = 0; e < 4; ++e) { xn[2 * e] += bflo(un[e]); xn[2 * e + 1] += bfhi(un[e]); } }
            }
            float r[8];
#pragma unroll
            for (int e = 0; e < 4; ++e) {
                const f32x2 m0 = *(const f32x2*)(mu + col + 2 * e), m1 = *(const f32x2*)(mu + 8576 + col + 2 * e);
                r[2 * e] = xc[2 * e] + m0[0] * (xp[2 * e] - xc[2 * e]) + m1[0] * (xn[2 * e] - xc[2 * e]);
                r[2 * e + 1] = xc[2 * e + 1] + m0[1] * (xp[2 * e + 1] - xc[2 * e + 1]) + m1[1] * (xn[2 * e + 1] - xc[2 * e + 1]);
            }
            if (arr < 2) {
#pragma unroll
                for (int e = 0; e < 8; ++e) r[e] = tanhf(r[e]);
            }
            res = (u32x4){pk2(r[0], r[1]), pk2(r[2], r[3]), pk2(r[4], r[5]), pk2(r[6], r[7])};
        }
        *(u32x4*)(dstb + (size_t)row * 128) = res;
    }
}

struct StageRegs { u32x2 raw[9], ra, re, rep; int row; };
DI void scan_stage_load(StageRegs& R, const bf16_t* C1, const bf16_t* AZ, const bf16_t* EZ, const float* mu, const float* kkw, const float* kaw, const float* rkw,
                        int row, int t, int T, int h, int z, int c4, bool first  ) {
    (void)mu; (void)kkw; (void)kaw; (void)rkw;
    R.row = row;
    const bf16_t* c = C1 + (size_t)row * 8576 + h * 64 + c4;
    const u32x2 zero = {0u, 0u};
#pragma unroll
    for (int g = 0; g < 3; ++g) {
        R.raw[g * 3 + 1] = *(const u32x2*)(c + g * 2048);
        R.raw[g * 3 + 0] = t > 0 ? *(const u32x2*)(c + g * 2048 - 8576) : zero;
        R.raw[g * 3 + 2] = t < T - 1 ? *(const u32x2*)(c + g * 2048 + 8576) : zero;
    }
    R.ra = *(const u32x2*)(AZ + ((size_t)z * 8192 + row) * 2048 + h * 64 + c4);
    R.re = *(const u32x2*)(EZ + ((size_t)z * 8192 + row) * 2048 + h * 64 + c4);
    R.rep = first ? zero : *(const u32x2*)(EZ + ((size_t)z * 8192 + row + (z ? 1 : -1)) * 2048 + h * 64 + c4);
}
DI void scan_stage_store(const StageRegs& R, LAS float* sb, float* BN, bool lead, int h, int z, const LAS float* pt, bool wlast, LAS float* plast  ) {
    f32x4 x[3];
#pragma unroll
    for (int g = 0; g < 3; ++g) x[g] = tshift(bf4_to_f4(R.raw[g * 3 + 1]), bf4_to_f4(R.raw[g * 3 + 0]), bf4_to_f4(R.raw[g * 3 + 2]), *(const LAS f32x4*)(pt + (2 * g) * 64), *(const LAS f32x4*)(pt + (2 * g + 1) * 64));
    const f32x4 a = bf4_to_f4(R.ra), cs = h4_to_f4(R.re), cp = h4_to_f4(R.rep);
    const f32x4 kkr = x[1] * *(const LAS f32x4*)(pt + 6 * 64);
    float ss = kkr[0] * kkr[0] + kkr[1] * kkr[1] + kkr[2] * kkr[2] + kkr[3] * kkr[3];
    ss = sum16d(ss);
    const f32x4 kk = kkr * rsqrtf(fmaxf(ss, 1e-12f));
    const f32x4 kz = x[1] * (1.f + (a - 1.f) * *(const LAS f32x4*)(pt + 7 * 64));
    const f32x4 kka = kk * a;
    f32x4 pc, ip, pp;
#pragma unroll
    for (int j = 0; j < 4; ++j) { pc[j] = __expf(-cs[j]); ip[j] = __expf(cs[j]); pp[j] = __expf(-cp[j]); }
    const f32x4 rk = *(const LAS f32x4*)(pt + 8 * 64);
    float bn = x[0][0] * kz[0] * rk[0] + x[0][1] * kz[1] * rk[1] + x[0][2] * kz[2] * rk[2] + x[0][3] * kz[3] * rk[3];
    bn = sum16d(bn);
    if (lead) BN[((size_t)z * 8192 + R.row) * 32 + h] = bn;
    *(LAS f32x4*)(sb) = x[0] * pc; *(LAS f32x4*)(sb + 64) = kka * ip; *(LAS f32x4*)(sb + 128) = kz * ip; *(LAS f32x4*)(sb + 192) = -kk * pp; *(LAS f32x4*)(sb + 320) = x[2];
    if (wlast) *(LAS f32x4*)plast = pc;
}

DI void scan_phase(const Params& p, LAS unsigned char* lds, const int wv__) {
    const int tid = otid(), wid = __builtin_amdgcn_readfirstlane(tid >> 6), lane = tid & 63, half = wid >> 2, ht = tid & 255;
    const bf16_t* C1 = (const bf16_t*)(p.ws + OFF_C);
    const bf16_t* AZ = (const bf16_t*)(p.ws + OFF_AZ); const bf16_t* EZ = (const bf16_t*)(p.ws + OFF_EZ);
    bf16_t* YZ = (bf16_t*)(p.ws + OFF_YZ); float* BN = (float*)(p.ws + OFF_BN);
    const float* mu = p.in[24];
    LAS float* lf = (LAS float*)lds;
    for (int u = blockIdx.x; u < 256; u += gridDim.x) {
        if (half == 0) {
            const int rg = ht >> 3, cg8 = ht & 7, stt = ht >> 4, c4 = (ht & 15) * 4;
            const int b = u >> 6, h = (u >> 1) & 31, z = u & 1, T = 1024, rowbase = 4096 + b * 1024;
            LAS float* base = lf;
            LAS unsigned* ybase = (LAS unsigned*)(lf + 24576);
            f32x2 S[2][4];
            {
                const float* st = (z ? p.in[7] : p.in[6]) + (((size_t)b * 32 + h) * 64 + 2 * rg) * 64 + cg8 * 8;
#pragma unroll
                for (int rr = 0; rr < 2; ++rr) { const f32x4 v0 = ld_f4(st + rr * 64), v1 = ld_f4(st + rr * 64 + 4);
                    S[rr][0] = (f32x2){v0[0], v0[1]}; S[rr][1] = (f32x2){v0[2], v0[3]}; S[rr][2] = (f32x2){v1[0], v1[1]}; S[rr][3] = (f32x2){v1[2], v1[3]}; }
            }
            LAS float* ptab = lf + 26112;
            {
                if (ht < 16) {
                    const int hc = h * 64 + c4;
#pragma unroll
                    for (int g = 0; g < 3; ++g) { *(LAS f32x4*)(ptab + (2 * g) * 64 + c4) = ld_f4(mu + g * 2048 + hc); *(LAS f32x4*)(ptab + (2 * g + 1) * 64 + c4) = ld_f4(mu + 8576 + g * 2048 + hc); }
                    *(LAS f32x4*)(ptab + 6 * 64 + c4) = ld_f4(p.in[29] + hc); *(LAS f32x4*)(ptab + 7 * 64 + c4) = ld_f4(p.in[30] + hc); *(LAS f32x4*)(ptab + 8 * 64 + c4) = ld_f4(p.in[31] + hc);
                }
                __syncthreads();
            }
            StageRegs R;
            auto sload = [&](int ci, bool prm) { (void)prm; const int step = ci * 16 + stt, t = z ? T - 1 - step : step; scan_stage_load(R, C1, AZ, EZ, mu, p.in[29], p.in[30], p.in[31], rowbase + t, t, T, h, z, c4, stt == 0); };
            auto sstore = [&](int ci) { scan_stage_store(R, base + ((ci & 1) * 16 + stt) * 384 + c4, BN, (ht & 15) == 0, h, z, ptab + c4, stt == 15, base + (ci & 1) * 16 * 384 + 256 + c4); };
            auto flush = [&](int ci) {
                const LAS unsigned* yb = ybase + (ci & 1) * (16 * 32);
                const int fs = ht >> 4, fr4 = (ht & 15) * 2;
                const u32x2 yv = *(const LAS u32x2*)(yb + fs * 32 + fr4);
                const int step = ci * 16 + fs, t = z ? T - 1 - step : step;
                *(u32x2*)(YZ + ((size_t)z * 8192 + rowbase + t) * 2048 + h * 64 + fr4 * 2) = yv;
            };
            sload(0, true); sstore(0);
            __syncthreads();
            for (int ci = 0; ci < 64; ++ci) {
                if (ci > 0) flush(ci - 1);
                if (ci + 1 < 64) sload(ci + 1, false);
                const LAS float* cb = base + (ci & 1) * 16 * 384;
                LAS unsigned* ybuf = ybase + (ci & 1) * (16 * 32);
                f32x4 cur[8], nxt[8]; f32x2 vcur, vnxt;
                {
                    const LAS float* sb = cb + cg8 * 8;
#pragma unroll
                    for (int q = 0; q < 4; ++q) { cur[2 * q] = *(const LAS f32x4*)(sb + q * 64); cur[2 * q + 1] = *(const LAS f32x4*)(sb + q * 64 + 4); }
                    vcur = *(const LAS f32x2*)(cb + 320 + 2 * rg);
                }
#pragma unroll
                for (int s = 0; s < 16; ++s) {
                    if (s < 15) {
                        const LAS float* sb = cb + (s + 1) * 384 + cg8 * 8;
#pragma unroll
                        for (int q = 0; q < 4; ++q) { nxt[2 * q] = *(const LAS f32x4*)(sb + q * 64); nxt[2 * q + 1] = *(const LAS f32x4*)(sb + q * 64 + 4); }
                        vnxt = *(const LAS f32x2*)(cb + (s + 1) * 384 + 320 + 2 * rg);
                    }
                    f32x2 dp[4], bp[4], cp[4], ap[4];
#pragma unroll
                    for (int q = 0; q < 2; ++q) {
                        dp[2 * q] = (f32x2){cur[q][0], cur[q][1]}; dp[2 * q + 1] = (f32x2){cur[q][2], cur[q][3]};
                        bp[2 * q] = (f32x2){cur[2 + q][0], cur[2 + q][1]}; bp[2 * q + 1] = (f32x2){cur[2 + q][2], cur[2 + q][3]};
                        cp[2 * q] = (f32x2){cur[4 + q][0], cur[4 + q][1]}; cp[2 * q + 1] = (f32x2){cur[4 + q][2], cur[4 + q][3]};
                        ap[2 * q] = (f32x2){cur[6 + q][0], cur[6 + q][1]}; ap[2 * q + 1] = (f32x2){cur[6 + q][2], cur[6 + q][3]};
                    }
                    float sa[2], yy[2];
#pragma unroll
                    for (int rr = 0; rr < 2; ++rr) {
                        f32x2 a2 = S[rr][0] * ap[0] + S[rr][1] * ap[1];
                        f32x2 b2 = S[rr][2] * ap[2] + S[rr][3] * ap[3];
                        a2 += b2;
                        float x = a2[0] + a2[1];
                        x += dpp_xor1(x); x += dpp_xor2(x); x += dpp_hmirror(x);
                        sa[rr] = x;
                    }
#pragma unroll
                    for (int rr = 0; rr < 2; ++rr) {
                        const f32x2 sa2 = {sa[rr], sa[rr]}, v2 = {vcur[rr], vcur[rr]};
                        f32x2 y2 = {0.f, 0.f}, y3 = {0.f, 0.f};
#pragma unroll
                        for (int q = 0; q < 4; ++q) {
                            S[rr][q] = sa2 * bp[q] + (v2 * cp[q] + S[rr][q]);
                            if (q & 1) y3 += S[rr][q] * dp[q]; else y2 += S[rr][q] * dp[q];
                        }
                        y2 += y3;
                        float x = y2[0] + y2[1];
                        x += dpp_xor1(x); x += dpp_xor2(x); x += dpp_hmirror(x);
                        yy[rr] = x;
                    }
                    ybuf[s * 32 + rg] = pk2(yy[0], yy[1]);
                    if (s < 15) {
#pragma unroll
                        for (int q = 0; q < 8; ++q) cur[q] = nxt[q];
                        vcur = vnxt;
                    }
                }
                {
                    const f32x4 p0 = *(const LAS f32x4*)(cb + 256 + cg8 * 8), p1 = *(const LAS f32x4*)(cb + 256 + cg8 * 8 + 4);
                    const f32x2 pl[4] = {(f32x2){p0[0], p0[1]}, (f32x2){p0[2], p0[3]}, (f32x2){p1[0], p1[1]}, (f32x2){p1[2], p1[3]}};
#pragma unroll
                    for (int rr = 0; rr < 2; ++rr)
#pragma unroll
                        for (int q = 0; q < 4; ++q) S[rr][q] *= pl[q];
                }
                if (ci + 1 < 64) sstore(ci + 1);
                __syncthreads();
            }
            flush(63);
            __syncthreads();
        } else {
            const int pw = wid - 4, pu = 4 * u + pw;
            const int b = pu >> 6, h = (pu >> 1) & 31, z = pu & 1, T = 256, rowbase = b * 256;
            const int rg = lane >> 2, cg = lane & 3, stt = lane >> 4, c4 = (lane & 15) * 4;
            LAS float* base = lf + 12288 + pw * (2 * 4 * 384);
            LAS unsigned* ybuf = (LAS unsigned*)(lf + 25600) + pw * (4 * 32);
            f32x2 S[4][8];
#pragma unroll
            for (int rr = 0; rr < 4; ++rr)
#pragma unroll
                for (int q = 0; q < 8; ++q) S[rr][q] = (f32x2){0.f, 0.f};
            LAS float* ptab = lf + 26688 + pw * 576;
            {
                if (lane < 16) {
                    const int hc = h * 64 + c4;
#pragma unroll
                    for (int g = 0; g < 3; ++g) { *(LAS f32x4*)(ptab + (2 * g) * 64 + c4) = ld_f4(mu + g * 2048 + hc); *(LAS f32x4*)(ptab + (2 * g + 1) * 64 + c4) = ld_f4(mu + 8576 + g * 2048 + hc); }
                    *(LAS f32x4*)(ptab + 6 * 64 + c4) = ld_f4(p.in[29] + hc); *(LAS f32x4*)(ptab + 7 * 64 + c4) = ld_f4(p.in[30] + hc); *(LAS f32x4*)(ptab + 8 * 64 + c4) = ld_f4(p.in[31] + hc);
                }
                __syncthreads();
            }
            StageRegs R;
            auto sload = [&](int it, bool prm) { (void)prm; const int step = it * 4 + stt, t = z ? T - 1 - step : step; scan_stage_load(R, C1, AZ, EZ, mu, p.in[29], p.in[30], p.in[31], rowbase + t, t, T, h, z, c4, (step & 15) == 0); };
            auto sstore = [&](int it) { scan_stage_store(R, base + ((it & 1) * 4 + stt) * 384 + c4, BN, (lane & 15) == 0, h, z, ptab + c4, (it & 3) == 3 && stt == 3, base + (it & 1) * 4 * 384 + 256 + c4); };
            sload(0, true); sstore(0);
            __syncthreads();
            for (int it = 0; it < 64; ++it) {
                if (it + 1 < 64) sload(it + 1, false);
                const LAS float* cb = base + (it & 1) * 4 * 384;
#pragma unroll 1
                for (int s = 0; s < 4; ++s) {
                    const LAS float* sb = cb + s * 384 + cg * 16;
                    f32x2 dp[8], bp[8], cp[8], ap[8];
#pragma unroll
                    for (int q = 0; q < 4; ++q) {
                        const f32x4 a4 = *(const LAS f32x4*)(sb + 192 + q * 4);
                        ap[2 * q] = (f32x2){a4[0], a4[1]}; ap[2 * q + 1] = (f32x2){a4[2], a4[3]};
                    }
                    const f32x4 vv = *(const LAS f32x4*)(cb + s * 384 + 320 + 4 * rg);
                    float yy[4], sav[4];
#pragma unroll
                    for (int rr = 0; rr < 4; ++rr) {
                        f32x2 a2 = S[rr][0] * ap[0] + S[rr][1] * ap[1];
                        f32x2 b2 = S[rr][2] * ap[2] + S[rr][3] * ap[3];
                        a2 += S[rr][4] * ap[4] + S[rr][5] * ap[5];
                        b2 += S[rr][6] * ap[6] + S[rr][7] * ap[7];
                        a2 += b2;
                        float sa = a2[0] + a2[1];
                        sa += dpp_xor1(sa); sa += dpp_xor2(sa);
                        sav[rr] = sa;
                    }
                    __builtin_amdgcn_sched_barrier(0);
#pragma unroll
                    for (int q = 0; q < 4; ++q) {
                        const f32x4 a0 = *(const LAS f32x4*)(sb + q * 4), a1 = *(const LAS f32x4*)(sb + 64 + q * 4), a2 = *(const LAS f32x4*)(sb + 128 + q * 4);
                        dp[2 * q] = (f32x2){a0[0], a0[1]}; dp[2 * q + 1] = (f32x2){a0[2], a0[3]};
                        bp[2 * q] = (f32x2){a1[0], a1[1]}; bp[2 * q + 1] = (f32x2){a1[2], a1[3]};
                        cp[2 * q] = (f32x2){a2[0], a2[1]}; cp[2 * q + 1] = (f32x2){a2[2], a2[3]};
                    }
#pragma unroll
                    for (int rr = 0; rr < 4; ++rr) {
                        const f32x2 sa2 = {sav[rr], sav[rr]}, v2 = {vv[rr], vv[rr]};
                        f32x2 y2 = {0.f, 0.f}, y3 = {0.f, 0.f};
#pragma unroll
                        for (int q = 0; q < 8; ++q) {
                            S[rr][q] = sa2 * bp[q] + (v2 * cp[q] + S[rr][q]);
                            if (q & 1) y3 += S[rr][q] * dp[q]; else y2 += S[rr][q] * dp[q];
                        }
                        y2 += y3;
                        float x = y2[0] + y2[1];
                        x += dpp_xor1(x); x += dpp_xor2(x);
                        yy[rr] = x;
                    }
                    const u32x2 yo = {pk2(yy[0], yy[1]), pk2(yy[2], yy[3])};
                    *(LAS u32x2*)(ybuf + s * 32 + rg * 2) = yo;
                }
                {
                    const int fs = lane >> 4, fr4 = (lane & 15) * 2;
                    const u32x2 yv = *(const LAS u32x2*)(ybuf + fs * 32 + fr4);
                    const int step = it * 4 + fs, t = z ? T - 1 - step : step;
                    *(u32x2*)(YZ + ((size_t)z * 8192 + rowbase + t) * 2048 + h * 64 + fr4 * 2) = yv;
                }
                if ((it & 3) == 3) {
#pragma unroll
                    for (int q = 0; q < 4; ++q) {
                        const f32x4 pv = *(const LAS f32x4*)(cb + 256 + cg * 16 + q * 4);
                        const f32x2 pa = {pv[0], pv[1]}, pb2 = {pv[2], pv[3]};
#pragma unroll
                        for (int rr = 0; rr < 4; ++rr) { S[rr][2 * q] *= pa; S[rr][2 * q + 1] *= pb2; }
                    }
                }
                if (it + 1 < 64) sstore(it + 1);
                __syncthreads();
            }
            {
                float* st = p.out + (z ? OUT_SB : OUT_SF) + (((size_t)b * 32 + h) * 64 + 4 * rg) * 64 + cg * 16;
#pragma unroll
                for (int rr = 0; rr < 4; ++rr)
#pragma unroll
                    for (int q = 0; q < 4; ++q) { const f32x4 v = {S[rr][2 * q][0], S[rr][2 * q][1], S[rr][2 * q + 1][0], S[rr][2 * q + 1][1]}; st_f4(st + rr * 64 + q * 4, v); }
            }
            __syncthreads();
        }
    }
}

DI void post_phase(const Params& p, const int wv__) {
    const int tid_ = otid(), lane = tid_ & 63, wg = blockIdx.x * 8 + (tid_ >> 6), nw = gridDim.x * 8;
    const bf16_t* C1 = (const bf16_t*)(p.ws + OFF_C);
    const bf16_t* YZ = (const bf16_t*)(p.ws + OFF_YZ); const float* BN = (const float*)(p.ws + OFF_BN);
    bf16_t* Y1 = (bf16_t*)(p.ws + OFF_H);
    const float* mu = p.in[24]; const float* lnw = p.in[32]; const float* lnb = p.in[33];
    const int cb = wg & 7, c = cb * 256 + lane * 4, hd = c >> 6;
    const f32x4 mv0 = ld_f4(mu + 4096 + c), mv1 = ld_f4(mu + 8576 + 4096 + c), mg0 = ld_f4(mu + 6144 + c), mg1 = ld_f4(mu + 8576 + 6144 + c);
    const f32x4 w4 = ld_f4(lnw + c), b4 = ld_f4(lnb + c);
#pragma unroll 4
    for (int row = wg >> 3; row < 8192; row += nw >> 3) {
        int t, T; seq_pos(row, t, T);
        const bf16_t* cr = C1 + (size_t)row * 8576;
        const bool hp = t > 0, hn = t < T - 1;
        const f32x4 ya = bf4_to_f4(*(const u32x2*)(YZ + (size_t)row * 2048 + c));
        const f32x4 yb = bf4_to_f4(*(const u32x2*)(YZ + ((size_t)8192 + row) * 2048 + c));
        const u32x2 zero = {0u, 0u};
        const u32x2 vc = *(const u32x2*)(cr + 4096 + c), gc = *(const u32x2*)(cr + 6144 + c);
        const u32x2 vp = hp ? *(const u32x2*)(cr - 8576 + 4096 + c) : zero, gp = hp ? *(const u32x2*)(cr - 8576 + 6144 + c) : zero;
        const u32x2 vn = hn ? *(const u32x2*)(cr + 8576 + 4096 + c) : zero, gn = hn ? *(const u32x2*)(cr + 8576 + 6144 + c) : zero;
        const float bna = BN[(size_t)row * 32 + hd], bnb = BN[((size_t)8192 + row) * 32 + hd];
        const float ma = sum16d(ya[0] + ya[1] + ya[2] + ya[3]) * (1.f / 64.f), mb = sum16d(yb[0] + yb[1] + yb[2] + yb[3]) * (1.f / 64.f);
        const f32x4 da = ya - ma, db = yb - mb;
        const float va = sum16d(da[0] * da[0] + da[1] * da[1] + da[2] * da[2] + da[3] * da[3]) * (1.f / 64.f);
        const float vb = sum16d(db[0] * db[0] + db[1] * db[1] + db[2] * db[2] + db[3] * db[3]) * (1.f / 64.f);
        const float rsa = rsqrtf(va + 64e-5f), rsb = rsqrtf(vb + 64e-5f);
        const f32x4 v = tshift(bf4_to_f4(vc), bf4_to_f4(vp), bf4_to_f4(vn), mv0, mv1);
        const f32x4 g = tshift(bf4_to_f4(gc), bf4_to_f4(gp), bf4_to_f4(gn), mg0, mg1);
        f32x4 res = (da * rsa + db * rsb) * w4 + 2.f * b4 + (bna + bnb) * v;
#pragma unroll
        for (int j = 0; j < 4; ++j) res[j] *= g[j] * sigmoidf_(g[j]);
        st_bf4(Y1 + (size_t)row * 2048 + c, res);
    }
}

#define XB_TMO      128
#define XB_XCNT(j)  (256  + 64 * (j))
#define XB_XSUB(j)  (1280 + 64 * (j))
#define XB_XGEN(j)  (2304 + 64 * (j))
#define XB_TOP      3328
#define XB_TOPGEN   3392
#define XCD_BAR_WORDS 3456
#define XB_SPIN_CAP (1u << 18)
DI unsigned xb_ld(unsigned* p)              { return __hip_atomic_load(p, __ATOMIC_RELAXED, __HIP_MEMORY_SCOPE_AGENT); }
DI unsigned xb_add(unsigned* p, unsigned v) { return __hip_atomic_fetch_add(p, v, __ATOMIC_RELAXED, __HIP_MEMORY_SCOPE_AGENT); }
DI unsigned xb_xcc_id() { return (unsigned)__builtin_amdgcn_s_getreg((3 << 11) | 20) & 0xFu; }
#define XB_SPIN(cond, bar) do { unsigned _sp = 0; while (cond) { __builtin_amdgcn_s_sleep(1); \
    if ((++_sp & 255u) == 0u) { if (xb_ld(&(bar)[XB_TMO])) break; if (_sp > XB_SPIN_CAP) { atomicAdd(&(bar)[XB_TMO], 1u); break; } } } } while (0)
struct XcdBarrier { unsigned* bar; unsigned x; volatile LAS unsigned* st; };
DI int ltid_(int wv) { return (wv << 6) | (int)__builtin_amdgcn_mbcnt_hi(~0u, __builtin_amdgcn_mbcnt_lo(~0u, 0u)); }
DI XcdBarrier xcd_barrier_post(unsigned* bar, volatile LAS unsigned* st, const int wv__) {
    XcdBarrier b; b.bar = bar; b.x = xb_xcc_id(); b.st = st;
    if (otid() == 0) (void)xb_add(&bar[XB_XCNT(b.x)], 1u);
    return b;
}
DI void xcd_barrier_complete(unsigned* bar, unsigned x, unsigned& nloc, unsigned& nx) {
    const unsigned G = gridDim.x * gridDim.y * gridDim.z;
    unsigned sum, cnt, mine, sp = 0u;
    for (;;) {
        sum = 0u; cnt = 0u; mine = 0u;
#pragma unroll
        for (unsigned j = 0; j < 16; ++j) { const unsigned c = xb_ld(&bar[XB_XCNT(j)]); sum += c; cnt += (c > 0u) ? 1u : 0u; mine = (j == x) ? c : mine; }
        if (sum == G) break;
        __builtin_amdgcn_s_sleep(1);
        if ((++sp & 255u) == 0u) { if (xb_ld(&bar[XB_TMO])) break; if (sp > XB_SPIN_CAP) { atomicAdd(&bar[XB_TMO], 1u); break; } }
    }
    nloc = mine > 0u ? mine : 1u; nx = cnt > 0u ? cnt : 1u;
}
DI void xcd_barrier(const XcdBarrier& b, const int wv__) {
    asm volatile("s_waitcnt vmcnt(0)" ::: "memory");
    __syncthreads();
    if (otid() == 0) {
        unsigned* bar = b.bar;
        __builtin_amdgcn_s_waitcnt(0);
        unsigned nloc = b.st[0], nx = b.st[1];
        if (nloc == 0u) { xcd_barrier_complete(bar, b.x, nloc, nx); b.st[0] = nloc; b.st[1] = nx; }
        const unsigned old = xb_add(&bar[XB_XSUB(b.x)], 1u);
        const unsigned gen = old / nloc;
        if (old + 1u == (gen + 1u) * nloc) {
            __builtin_amdgcn_fence(__ATOMIC_RELEASE, "agent");
            asm volatile("s_waitcnt vmcnt(0)" ::: "memory");
            const unsigned og = xb_add(&bar[XB_TOP], 1u);
            const unsigned tg = og / nx;
            if (og + 1u == (tg + 1u) * nx) xb_add(&bar[XB_TOPGEN], 1u);
            else XB_SPIN(xb_ld(&bar[XB_TOPGEN]) == tg, bar);
            __builtin_amdgcn_fence(__ATOMIC_ACQUIRE, "agent");
            xb_add(&bar[XB_XGEN(b.x)], 1u);
            asm volatile("s_waitcnt vmcnt(0)" ::: "memory");
        } else {
            XB_SPIN(xb_ld(&bar[XB_XGEN(b.x)]) == gen, bar);
            __builtin_amdgcn_fence(__ATOMIC_ACQUIRE, "agent");
            asm volatile("s_waitcnt vmcnt(0)" ::: "memory");
        }
    }
    __syncthreads();
}

constexpr int NPHASE = 15;
#ifndef PHASE_MASK
#define PHASE_MASK 0x7fff
#endif
#ifndef PH_ORDER
#define PH_ORDER 0xEDCBA9876543210ull
#define PH_COUNT 15
#endif
#define PH_ON(n) (((PHASE_MASK) >> (n)) & 1)
__global__ void __launch_bounds__(NTHREADS) mega(KArgs ka, int ph_lo, int ph_hi) {
    cg::grid_group grid = cg::this_grid();
    const int wv__ = __builtin_amdgcn_readfirstlane((int)(threadIdx.x >> 6));
    LAS unsigned char* lds = (LAS unsigned char*)dyn_lds;
    __shared__ uint4 xb_words;
    if (otid() == 0) xb_words = make_uint4(0u, 0u, 0u, 0u);
    XcdBarrier xb; xb.bar = nullptr; xb.x = 0u; xb.st = (volatile LAS unsigned*)&xb_words;
    typedef void* vptr_t;
    const __attribute__((address_space(4))) vptr_t* kat = (const __attribute__((address_space(4))) vptr_t*)__builtin_amdgcn_kernarg_segment_ptr();
    for (int si = ph_lo; si < ph_hi; ++si) {
        const int ph = (int)((PH_ORDER >> (4 * si)) & 15ull);
        if (si == ph_lo) {
            unsigned* bar = (unsigned*)((unsigned char*)kat[35] + OFF_BAR);
            if (blockIdx.x == 0) { const int t0 = otid();
#pragma unroll 1
                for (int i = t0; i < XCD_BAR_WORDS; i += NTHREADS) bar[i] = 0u; }
            __syncthreads();
        } else if (si == ph_lo + 1) {
            grid.sync();
            xb = xcd_barrier_post((unsigned*)((unsigned char*)kat[35] + OFF_BAR), (volatile LAS unsigned*)&xb_words, wv__);
        } else xcd_barrier(xb, wv__);
        int oz = 0; asm volatile("" : "+s"(oz));
        Params p;
        p.in[0] = (const float*)kat[0 + oz];
        p.in[1] = (const float*)kat[1 + oz];
        p.in[2] = (const float*)kat[2 + oz];
        p.in[3] = (const float*)kat[3 + oz];
        p.in[4] = (const float*)kat[4 + oz];
        p.in[5] = (const float*)kat[5 + oz];
        p.in[6] = (const float*)kat[6 + oz];
        p.in[7] = (const float*)kat[7 + oz];
        p.in[8] = (const float*)kat[8 + oz];
        p.in[9] = (const float*)kat[9 + oz];
        p.in[10] = (const float*)kat[10 + oz];
        p.in[11] = (const float*)kat[11 + oz];
        p.in[12] = (const float*)kat[12 + oz];
        p.in[13] = (const float*)kat[13 + oz];
        p.in[14] = (const float*)kat[14 + oz];
        p.in[15] = (const float*)kat[15 + oz];
        p.in[16] = (const float*)kat[16 + oz];
        p.in[17] = (const float*)kat[17 + oz];
        p.in[18] = (const float*)kat[18 + oz];
        p.in[19] = (const float*)kat[19 + oz];
        p.in[20] = (const float*)kat[20 + oz];
        p.in[21] = (const float*)kat[21 + oz];
        p.in[22] = (const float*)kat[22 + oz];
        p.in[23] = (const float*)kat[23 + oz];
        p.in[24] = (const float*)kat[24 + oz];
        p.in[25] = (const float*)kat[25 + oz];
        p.in[26] = (const float*)kat[26 + oz];
        p.in[27] = (const float*)kat[27 + oz];
        p.in[28] = (const float*)kat[28 + oz];
        p.in[29] = (const float*)kat[29 + oz];
        p.in[30] = (const float*)kat[30 + oz];
        p.in[31] = (const float*)kat[31 + oz];
        p.in[32] = (const float*)kat[32 + oz];
        p.in[33] = (const float*)kat[33 + oz];
        p.out = (float*)kat[34 + oz]; p.ws = (unsigned char*)kat[35 + oz];
        unsigned char* ws = p.ws;
        float* mod = (float*)(ws + OFF_MOD);
        const f32x2* rope = (const f32x2*)(ws + OFF_ROPE);
        switch (ph) {
        case 0: if (PH_ON(0)) prep_phase(p, lds, wv__); break;
        case 1: if (PH_ON(1)) norm_mod_phase(p.in[0], p.in[1], p.in[12], mod, (bf16_t*)(ws + OFF_H), wv__); break;
        case 2: if (PH_ON(2)) {
            Epi0 e; e.QD = (bf16_t*)(ws + OFF_QD); e.KD = (bf16_t*)(ws + OFF_KD); e.VD = (bf16_t*)(ws + OFF_VD); e.CQR = (bf16_t*)(ws + OFF_CQR); e.KPE = (bf16_t*)(ws + OFF_KPE);
            e.SG = (bf16_t*)(ws + OFF_SG0); e.CKVR = (float*)(ws + OFF_CKVR); e.oak = p.out + OUT_AK; e.oav = p.out + OUT_AV; e.okpe = p.out + OUT_KPE; e.rope = rope;
            gemm_phase(lds, (const bf16_t*)(ws + OFF_H), (const bf16_t*)(ws + OFF_WT0), 8192, 6144, 2048, e, wv__);
        } break;
        case 3: if (PH_ON(3)) lat_norm_phase(p, wv__); break;
        case 4: if (PH_ON(4)) {
            EpiBf ek; ek.O = (bf16_t*)(ws + OFF_KVB); ek.ldc = 2048; ek.ncols = 2048;
            gemm_phase(lds, (const bf16_t*)(ws + OFF_CKVA), (const bf16_t*)(ws + OFF_WUKV), 10240, 2048, 256, ek, wv__);
            EpiQ eq; eq.QB = (bf16_t*)(ws + OFF_QB); eq.rope = rope;
            gemm_phase(lds, (const bf16_t*)(ws + OFF_CQN), (const bf16_t*)(ws + OFF_WUQ), 8192, 1536, 512, eq, wv__, 0, 1, gridDim.x == 256 ? 64 : 0);
        } break;
        case 5: if (PH_ON(5)) attn_phase(p, lds, wv__); break;
        case 6: if (PH_ON(6)) {
            EpiOut e; e.xp = p.in[0]; e.xs = p.in[1]; e.xo = p.out + OUT_Y; e.modg = mod + 4096;
            gemm_phase(lds, (const bf16_t*)(ws + OFF_H), (const bf16_t*)(ws + OFF_WOT0), 8192, 2048, 2048, e, wv__);
        } break;
        case 7: if (PH_ON(7)) norm_mod_phase(p.out + OUT_Y, p.out + OUT_Y + (size_t)4096 * 2048, p.in[12] + 2048, mod + 5 * 6144, (bf16_t*)(ws + OFF_H), wv__); break;
        case 8: if (PH_ON(8)) {
            EpiBf e; e.O = (bf16_t*)(ws + OFF_C); e.ldc = 8576; e.ncols = 8192;
            gemm_phase(lds, (const bf16_t*)(ws + OFF_H), (const bf16_t*)(ws + OFF_WT1), 8192, 8192, 2048, e, wv__);
            EpiBf e2; e2.O = (bf16_t*)(ws + OFF_PART); e2.ldc = 2048; e2.ncols = 2048;
            gemm_phase(lds, (const bf16_t*)(ws + OFF_H), (const bf16_t*)(ws + OFF_WT1) + (size_t)8192 * 2048, 8192, 512, 512, e2, wv__, 2048, 4);
        } break;
        case 9: if (PH_ON(9)) lora_in_phase(p, wv__); break;
        case 10: if (PH_ON(10)) {
#pragma unroll 1
            for (int z = 0; z < 2; ++z) {
                EpiDecay ew; ew.O = (bf16_t*)(ws + OFF_EZ) + (size_t)z * 8192 * 2048; ew.bias = p.in[25] + z * 2048; ew.rev = z;
                gemm_phase(lds, (const bf16_t*)(ws + OFF_WDT) + (size_t)z * 8192 * 128, (const bf16_t*)(ws + OFF_W2T) + (size_t)z * 2048 * 128, 8192, 2048, 128, ew, wv__);
                EpiLora ea; ea.O = (bf16_t*)(ws + OFF_AZ) + (size_t)z * 8192 * 2048; ea.bias = p.in[27] + z * 2048; ea.mul = 1.f;
                gemm_phase(lds, (const bf16_t*)(ws + OFF_ADT) + (size_t)z * 8192 * 128, (const bf16_t*)(ws + OFF_A2T) + (size_t)z * 2048 * 128, 8192, 2048, 128, ea, wv__);
            }
        } break;
        case 11: if (PH_ON(11)) scan_phase(p, lds, wv__); break;
        case 12: if (PH_ON(12)) post_phase(p, wv__); break;
        case 13: if (PH_ON(13)) {
            EpiGate e; e.O = (bf16_t*)(ws + OFF_C); e.modg = mod + 5 * 6144 + 4096;
            gemm_phase(lds, (const bf16_t*)(ws + OFF_H), (const bf16_t*)(ws + OFF_WOT1), 8192, 2048, 2048, e, wv__);
        } break;
        case 14: if (PH_ON(14)) final_norm_phase(p.out + OUT_Y, (const bf16_t*)(ws + OFF_C), p.in[13], wv__); break;
        }
    }
}

extern "C" void kernel_launch(void* const* d_in, const int* in_sizes, int n_in, void* d_out, int out_size, void* d_ws, size_t ws_size, hipStream_t stream) {
    static int grid_blocks = 0;
    if (!grid_blocks) {
        hipFuncSetAttribute((const void*)mega, hipFuncAttributeMaxDynamicSharedMemorySize, LDS_BYTES);
        int dev = 0, cus = 0, per_cu = 0;
        hipGetDevice(&dev);
        hipDeviceGetAttribute(&cus, hipDeviceAttributeMultiprocessorCount, dev);
        hipOccupancyMaxActiveBlocksPerMultiprocessor(&per_cu, mega, NTHREADS, LDS_BYTES);
        if (per_cu < 1) per_cu = 1;
        grid_blocks = cus * per_cu;
        if (grid_blocks > 256) grid_blocks = 256;
    }
    KArgs p{};
    for (int i = 0; i < 34; ++i) p.a[i] = d_in[i];
    p.a[34] = d_out;
    p.a[35] = d_ws;
    int lo = 0, hi = PH_COUNT;
    void* args[] = {&p, &lo, &hi};
    hipError_t e = hipLaunchCooperativeKernel((const void*)mega, dim3(grid_blocks), dim3(NTHREADS), args, LDS_BYTES, stream);
    if (e != hipSuccess) fprintf(stderr, "cooperative launch failed: %s (grid %d, ws %zu need %zu)\n", hipGetErrorString(e), grid_blocks, ws_size, (size_t)WS_NEEDED);
}
```

```cpp
#include <hip/hip_runtime.h>
#include <hip/hip_cooperative_groups.h>
#include <cstdio>
namespace cg = cooperative_groups;

#define DI __device__ __forceinline__
#define LAS __attribute__((address_space(3)))
typedef unsigned short bf16_t;
typedef short bf16x8 __attribute__((ext_vector_type(8)));
typedef short s16x4 __attribute__((ext_vector_type(4)));
typedef float f32x4 __attribute__((ext_vector_type(4)));
typedef float f32x2 __attribute__((ext_vector_type(2)));
typedef unsigned u32x4 __attribute__((ext_vector_type(4)));
typedef unsigned u32x2 __attribute__((ext_vector_type(2)));
typedef __bf16 nbf2 __attribute__((ext_vector_type(2)));

extern __shared__ __attribute__((aligned(16))) unsigned char dyn_lds[];
constexpr int LDS_BYTES = 131072;
constexpr int NTHREADS = 512;

constexpr size_t SZ_H    = (size_t)8192 * 2048 * 2;
constexpr size_t OFF_WOT1 = 0;
constexpr size_t OFF_WT0  = OFF_WOT1 + (size_t)2048 * 2048 * 2;
constexpr size_t OFF_WT1  = OFF_WT0 + (size_t)6144 * 2048 * 2;
constexpr size_t OFF_WOT0 = OFF_WT1 + (size_t)8704 * 2048 * 2;
constexpr size_t OFF_WUQ  = OFF_WOT0 + (size_t)2048 * 2048 * 2;
constexpr size_t OFF_WUKV = OFF_WUQ + (size_t)1536 * 512 * 2;
constexpr size_t OFF_W2T  = OFF_WUKV + (size_t)2048 * 256 * 2;
constexpr size_t OFF_A2T  = OFF_W2T + (size_t)2 * 2048 * 128 * 2;
constexpr size_t END_W    = OFF_A2T + (size_t)2 * 2048 * 128 * 2;
constexpr size_t OFF_YZ   = OFF_WT0;
static_assert(OFF_YZ + 2 * SZ_H <= END_W, "yz alias");
constexpr size_t OFF_MOD  = END_W;
constexpr size_t OFF_ROPE = OFF_MOD + (size_t)2 * 5 * 6144 * 4;
constexpr size_t OFF_BN   = OFF_ROPE + 64 * 16 * 8;
constexpr size_t OFF_H    = OFF_BN + (size_t)2 * 8192 * 32 * 4;
constexpr size_t OFF_C    = OFF_H + SZ_H;
constexpr size_t SZ_C     = (size_t)8192 * 8576 * 2;
constexpr size_t OFF_QD   = OFF_C;
constexpr size_t OFF_KD   = OFF_QD + (size_t)8192 * 1024 * 2;
constexpr size_t OFF_VD   = OFF_KD + (size_t)10240 * 1024 * 2;
constexpr size_t OFF_CQR  = OFF_VD + (size_t)10240 * 1024 * 2;
constexpr size_t OFF_CKVR = OFF_CQR + (size_t)8192 * 512 * 2;
constexpr size_t OFF_KPE  = OFF_CKVR + (size_t)8192 * 256 * 4;
constexpr size_t OFF_SG0  = OFF_KPE + (size_t)10240 * 64 * 2;
static_assert(OFF_SG0 + SZ_H <= OFF_C + SZ_C, "region C");
constexpr size_t OFF_E    = OFF_C + SZ_C;
constexpr size_t OFF_PART = OFF_E;
constexpr size_t OFF_AZ   = OFF_E;
constexpr size_t OFF_EZ   = OFF_E + 2 * SZ_H;
constexpr size_t SZ_E     = 4 * SZ_H;
constexpr size_t OFF_CQN  = OFF_E;
constexpr size_t OFF_CKVA = OFF_CQN + (size_t)8192 * 512 * 2;
constexpr size_t OFF_QB   = OFF_CKVA + (size_t)10240 * 256 * 2;
constexpr size_t OFF_KVB  = OFF_QB + (size_t)8192 * 1536 * 2;
static_assert(OFF_KVB + (size_t)10240 * 2048 * 2 <= OFF_E + SZ_E, "region E");
constexpr size_t OFF_BAR = OFF_E + SZ_E;
constexpr size_t WS_NEEDED = OFF_BAR + 16384;
constexpr size_t OFF_WDT = OFF_H;
constexpr size_t OFF_ADT = OFF_H + (size_t)2 * 8192 * 128 * 2;

constexpr size_t OUT_Y = 0, OUT_AK = 16777216, OUT_AV = 20971520, OUT_CKV = 25165824, OUT_KPE = 26214400, OUT_SF = 26476544, OUT_SB = 28573696;

struct Params {
    const float* in[34];
    float* out;
    unsigned char* ws;
};
struct KArgs { const void* a[36]; };

DI unsigned pk2(float a, float b) { f32x2 v = {a, b}; nbf2 r = __builtin_convertvector(v, nbf2); return __builtin_bit_cast(unsigned, r); }
DI float bflo(unsigned u) { return __uint_as_float(u << 16); }
DI float bfhi(unsigned u) { return __uint_as_float(u & 0xffff0000u); }
DI void st_bf4(bf16_t* p, f32x4 v) { u32x2 r = {pk2(v[0], v[1]), pk2(v[2], v[3])}; *(u32x2*)p = r; }
DI void st_f4(float* p, f32x4 v) { *(f32x4*)p = v; }
DI f32x4 ld_f4(const float* p) { return *(const f32x4*)p; }
DI f32x4 ld_f4_nt(const float* p) { return __builtin_nontemporal_load((const f32x4*)p); }
DI f32x4 bf4_to_f4(u32x2 u) { f32x4 r = {bflo(u[0]), bfhi(u[0]), bflo(u[1]), bfhi(u[1])}; return r; }
DI float dpp_xor1(float x) { return __int_as_float(__builtin_amdgcn_mov_dpp(__float_as_int(x), 0xB1, 0xF, 0xF, true)); }
DI float dpp_xor2(float x) { return __int_as_float(__builtin_amdgcn_mov_dpp(__float_as_int(x), 0x4E, 0xF, 0xF, true)); }
DI float dpp_hmirror(float x) { return __int_as_float(__builtin_amdgcn_mov_dpp(__float_as_int(x), 0x141, 0xF, 0xF, true)); }
DI float dpp_mirror(float x) { return __int_as_float(__builtin_amdgcn_mov_dpp(__float_as_int(x), 0x140, 0xF, 0xF, true)); }
DI float shx(float x, int m, int lane) { return __int_as_float(__builtin_amdgcn_ds_bpermute((lane ^ m) << 2, __float_as_int(x))); }
DI float wave_sum(float x, int lane) {
    x += dpp_xor1(x); x += dpp_xor2(x); x += dpp_hmirror(x); x += dpp_mirror(x); x += shx(x, 16, lane); x += shx(x, 32, lane); return x;
}
DI float sum16d(float x) { x += dpp_xor1(x); x += dpp_xor2(x); x += dpp_hmirror(x); x += dpp_mirror(x); return x; }
DI float sigmoidf_(float x) { return __builtin_amdgcn_rcpf(1.f + __expf(-x)); }
DI int otid_(int wv) { int l; asm volatile("v_mbcnt_lo_u32_b32 %0, -1, 0\n\tv_mbcnt_hi_u32_b32 %0, -1, %0" : "=v"(l)); return (wv << 6) | l; }
#define otid() otid_(wv__)
DI int kvrow_of(int row) { return row < 4096 ? row : 4096 + ((row - 4096) >> 10) * 1536 + ((row - 4096) & 1023); }
DI int cond_of(int row) { return row < 4096 ? 0 : 1 + ((row - 4096) >> 10); }

constexpr int HTB = 128 * 64 * 2;
DI int lds_byte(int r, int c) { const int st = (r >> 4) * 2 + (c >> 5), rr = r & 15, cc = c & 31, ob = rr * 64 + cc * 2; return st * 1024 + (ob ^ (((ob >> 9) & 1) << 5)); }
DI void stage_rc(int b, int& R, int& C) { const int st = b / 1024, sb = b % 1024, swz = sb ^ (((sb >> 9) & 1) << 5); R = (st >> 1) * 16 + swz / 64; C = (st & 1) * 32 + (swz % 64) / 2; }

#define G_SA(b, h) (((b) * 2 + (h)) * HTB)
#define G_SB(b, h) ((4 + (b) * 2 + (h)) * HTB)
#define G_STAGE(bufoff, gbase) do { _Pragma("unroll") for (int _i = 0; _i < 2; ++_i) \
    __builtin_amdgcn_global_load_lds((const unsigned*)((const char*)(gbase) + voff[_i]), (LAS unsigned*)(lds + (bufoff) + ldsw + _i * 8192), 16, 0, 0); } while (0)
#define G_LDA(dst, b, h) do { _Pragma("unroll") for (int m = 0; m < 4; ++m) _Pragma("unroll") for (int k = 0; k < 2; ++k) dst[m][k] = *(const LAS bf16x8*)(lds + G_SA(b, h) + aoff + m * 2048 + k * 1024); } while (0)
#define G_LDB(dst, b, h) do { _Pragma("unroll") for (int n = 0; n < 2; ++n) _Pragma("unroll") for (int k = 0; k < 2; ++k) dst[n][k] = *(const LAS bf16x8*)(lds + G_SB(b, h) + boff + n * 2048 + k * 1024); } while (0)
#define G_MMA(ai, bj, At_, Bt_) do { __builtin_amdgcn_s_setprio(1); _Pragma("unroll") for (int m = 0; m < 4; ++m) _Pragma("unroll") for (int n = 0; n < 2; ++n) _Pragma("unroll") for (int k = 0; k < 2; ++k) \
    acc[ai][bj][m][n] = __builtin_amdgcn_mfma_f32_16x16x32_bf16(Bt_[n][k], At_[m][k], acc[ai][bj][m][n], 0, 0, 0); __builtin_amdgcn_s_setprio(0); } while (0)
#define G_WAIT_V(n) asm volatile("s_waitcnt vmcnt(" #n ")" ::: "memory")
#define G_WAIT_L(n) asm volatile("s_waitcnt lgkmcnt(" #n ")" ::: "memory")
#define G_BAR __builtin_amdgcn_s_barrier()
#define G_SCHED __builtin_amdgcn_sched_barrier(0)

template <class Epi>
DI void gemm_phase(LAS unsigned char* lds, const bf16_t* A, const bf16_t* Bt, int M, int N, int K, const Epi& E, const int wv__, int pitch = 0, int nsplit = 1) {
    if (pitch == 0) pitch = K;
    const int tid = otid(), wid = __builtin_amdgcn_readfirstlane(tid >> 6), lane = tid & 63, wr = wid >> 2, wc = wid & 3, fr = lane & 15, fq = lane >> 4;
    const int nt = K / 64, nM = M / 256, nN = N / 256, ntiles = nM * nN * nsplit;
    unsigned voff[2];
#pragma unroll
    for (int i = 0; i < 2; ++i) { int R, C; stage_rc(tid * 16 + i * 8192, R, C); voff[i] = (unsigned)(R * pitch + C) * 2u; }
    const size_t kstep = 128, hstep = (size_t)128 * pitch * 2;
    const unsigned ldsw = (unsigned)wid * 1024u;
    const int aoff = lds_byte(wr * 64 + fr, fq * 8), boff = lds_byte(wc * 32 + fr, fq * 8);
    int tile = blockIdx.x;
    if (tile >= ntiles) return;
    const char* cA; const char* cB; int pm, pnq;
#define G_TILE_PTRS(tl) do { const int ks_ = (tl) % nsplit, t2_ = (tl) / nsplit; pm = t2_ % nM; const int pn_ = t2_ / nM; pnq = pn_ + ks_ * nN; \
        cA = (const char*)A + (size_t)pm * 2 * hstep + (size_t)ks_ * K * 2; cB = (const char*)Bt + (size_t)pn_ * 2 * hstep + (size_t)ks_ * K * 2; } while (0)
    G_TILE_PTRS(tile);
    G_STAGE(G_SB(0, 0), cB); G_STAGE(G_SA(0, 0), cA); G_STAGE(G_SB(0, 1), cB + hstep); G_STAGE(G_SA(0, 1), cA + hstep);
    for (;;) {
        const int pm_cur = pm, pnq_cur = pnq;
        f32x4 acc[2][2][4][2];
#pragma unroll
        for (int a = 0; a < 2; ++a)
#pragma unroll
            for (int b = 0; b < 2; ++b)
#pragma unroll
                for (int m = 0; m < 4; ++m)
#pragma unroll
                    for (int n = 0; n < 2; ++n) acc[a][b][m][n] = (f32x4){0.f, 0.f, 0.f, 0.f};
        bf16x8 At[4][2], B0[2][2], B1[2][2];
        if (wr == 1) G_BAR;
        G_WAIT_V(4); G_BAR;
        G_STAGE(G_SB(1, 0), cB + kstep); G_STAGE(G_SA(1, 0), cA + kstep); G_STAGE(G_SB(1, 1), cB + hstep + kstep);
        G_WAIT_V(6); G_BAR;
        for (int t = 0; t < nt - 2; t += 2) {
            const char* a1 = cA + (size_t)(t + 1) * kstep;
            const char* a2 = cA + (size_t)(t + 2) * kstep; const char* b2 = cB + (size_t)(t + 2) * kstep;
            const char* a3 = a2 + kstep; const char* b3 = b2 + kstep;
            G_LDB(B0, 0, 0); G_SCHED; G_LDA(At, 0, 0); G_STAGE(G_SA(1, 1), a1 + hstep);
            G_WAIT_L(8); G_BAR; G_WAIT_L(0); G_MMA(0, 0, At, B0); G_BAR; G_SCHED;
            G_LDB(B1, 0, 1); G_STAGE(G_SB(0, 0), b2);
            G_BAR; G_WAIT_L(0); G_MMA(0, 1, At, B1); G_BAR;
            G_LDA(At, 0, 1); G_STAGE(G_SA(0, 0), a2);
            G_BAR; G_WAIT_L(0); G_MMA(1, 0, At, B0); G_BAR; G_SCHED;
            G_STAGE(G_SB(0, 1), b2 + hstep);
            G_WAIT_V(6); G_BAR; G_MMA(1, 1, At, B1); G_BAR;
            G_LDB(B0, 1, 0); G_SCHED; G_LDA(At, 1, 0); G_STAGE(G_SA(0, 1), a2 + hstep);
            G_WAIT_L(8); G_BAR; G_WAIT_L(0); G_MMA(0, 0, At, B0); G_BAR; G_SCHED;
            G_LDB(B1, 1, 1); G_STAGE(G_SB(1, 0), b3);
            G_BAR; G_WAIT_L(0); G_MMA(0, 1, At, B1); G_BAR;
            G_LDA(At, 1, 1); G_STAGE(G_SA(1, 0), a3);
            G_BAR; G_WAIT_L(0); G_MMA(1, 0, At, B0); G_BAR; G_SCHED;
            G_STAGE(G_SB(1, 1), b3 + hstep);
            G_WAIT_V(6); G_BAR; G_MMA(1, 1, At, B1); G_BAR;
        }
        {
            const char* a1 = cA + (size_t)(nt - 1) * kstep;
            G_LDB(B0, 0, 0); G_LDA(At, 0, 0); G_STAGE(G_SA(1, 1), a1 + hstep);
            G_BAR; G_WAIT_L(0); G_MMA(0, 0, At, B0); G_BAR;
            G_LDB(B1, 0, 1); G_BAR; G_WAIT_L(0); G_MMA(0, 1, At, B1); G_BAR;
            G_LDA(At, 0, 1); G_WAIT_V(4); G_BAR; G_WAIT_L(0); G_MMA(1, 0, At, B0); G_MMA(1, 1, At, B1); G_BAR;
        }
        {
            G_LDB(B0, 1, 0); G_LDA(At, 1, 0); G_WAIT_V(2); G_BAR; G_WAIT_L(0); G_MMA(0, 0, At, B0); G_BAR;
            G_LDB(B1, 1, 1); G_WAIT_V(0); G_BAR; G_WAIT_L(0); G_MMA(0, 1, At, B1); G_BAR;
            G_LDA(At, 1, 1); G_BAR; G_WAIT_L(0); G_MMA(1, 0, At, B0); G_MMA(1, 1, At, B1); G_BAR;
        }
        if (wr == 0) G_BAR;
        const int next = tile + (int)gridDim.x;
        if (next < ntiles) { G_TILE_PTRS(next); G_STAGE(G_SB(0, 0), cB); G_STAGE(G_SA(0, 0), cA); G_STAGE(G_SB(0, 1), cB + hstep); G_STAGE(G_SA(0, 1), cA + hstep); }
        E.run(acc, pm_cur, pnq_cur, wr, wc, fr, fq);
        if (next >= ntiles) break;
        tile = next;
    }
#undef G_TILE_PTRS
}

typedef f32x4 acc_t[2][2][4][2];
#define EPI_LOOP(...) _Pragma("unroll") for (int ai = 0; ai < 2; ++ai) _Pragma("unroll") for (int m = 0; m < 4; ++m) { const int row = pm * 256 + ai * 128 + wr * 64 + m * 16 + fr; \
    _Pragma("unroll") for (int bj = 0; bj < 2; ++bj) { const int col0 = pn * 256 + bj * 128 + wc * 32 + fq * 4; f32x4 v0 = acc[ai][bj][m][0], v1 = acc[ai][bj][m][1]; __VA_ARGS__ } }
struct RopeRegs { float fr[4]; };
DI void rope_preload(RopeRegs& R, int fq) {
#pragma unroll
    for (int j = 0; j < 4; ++j) R.fr[j] = __builtin_amdgcn_exp2f(-(float)(fq * 4 + j) * (13.287712379549449f / 16.f)) * 0.15915494309189535f;
}
DI void rope_rot(const RopeRegs& R, int pos, f32x4& a, f32x4& b) {
    const float pf = (float)pos;
#pragma unroll
    for (int j = 0; j < 4; ++j) {
        const float rev = pf * R.fr[j];
        const float c = __builtin_amdgcn_cosf(rev), sn = __builtin_amdgcn_sinf(rev);
        const float x1 = a[j], x2 = b[j]; a[j] = x1 * c - x2 * sn; b[j] = x1 * sn + x2 * c;
    }
}
struct Epi0 {
    bf16_t *QD, *KD, *VD, *CQR, *KPE, *SG; float *CKVR, *oak, *oav, *okpe; const f32x2* rope;
    DI void run(const acc_t& acc, int pm, int pn, int wr, int wc, int fr, int fq) const {
        const bool samp = pm >= 16;
        const int cb = pn * 256;
        const bool ropey = samp && (cb < 2048 || cb == 3840);
        RopeRegs RR; rope_preload(RR, fq); (void)ropey;
        const int prow0 = (((pm * 256) & 1023) >> 6) + wr;
        EPI_LOOP(
            const int kvr = kvrow_of(row);
            if (col0 < 2048 || (col0 >= 3840 && col0 < 3904)) {
                f32x4 r0 = v0, r1 = v1;
                if (samp) rope_rot(RR, ((col0 >> 5) & 1) ? (m * 16 + fr) : (prow0 + 2 * ai), r0, r1);
                if (col0 < 1024) { bf16_t* q = QD + (size_t)row * 1024 + col0; st_bf4(q, r0); st_bf4(q + 16, r1); }
                else if (col0 < 2048) {
                    const int c = col0 - 1024; bf16_t* q = KD + (size_t)kvr * 1024 + c; st_bf4(q, r0); st_bf4(q + 16, r1);
                    if (!samp) { float* o = oak + (size_t)row * 1024 + c; st_f4(o, v0); st_f4(o + 16, v1); }
                } else {
                    const int c = col0 - 3840; bf16_t* q = KPE + (size_t)kvr * 64 + c; st_bf4(q, r0); st_bf4(q + 16, r1);
                    if (!samp) { float* o = okpe + (size_t)row * 64 + c; st_f4(o, v0); st_f4(o + 16, v1); }
                }
            } else if (col0 < 3072) {
                const int c = col0 - 2048; bf16_t* q = VD + (size_t)kvr * 1024 + c; st_bf4(q, v0); st_bf4(q + 16, v1);
                if (!samp) { float* o = oav + (size_t)row * 1024 + c; st_f4(o, v0); st_f4(o + 16, v1); }
            } else if (col0 < 3584) {
                bf16_t* q = CQR + (size_t)row * 512 + (col0 - 3072); st_bf4(q, v0); st_bf4(q + 16, v1);
            } else if (col0 < 3840) {
                float* o = CKVR + (size_t)row * 256 + (col0 - 3584); st_f4(o, v0); st_f4(o + 16, v1);
            } else if (col0 < 5952) {
                f32x4 s0, s1;
                _Pragma("unroll") for (int j = 0; j < 4; ++j) { s0[j] = v0[j] * sigmoidf_(v0[j]); s1[j] = v1[j] * sigmoidf_(v1[j]); }
                bf16_t* q = SG + (size_t)row * 2048 + (col0 - 3904); st_bf4(q, s0); st_bf4(q + 16, s1);
            }
        )
    }
};
struct EpiQ {
    bf16_t* QB; const f32x2* rope;
    DI void run(const acc_t& acc, int pm, int pn, int wr, int wc, int fr, int fq) const {
        const bool samp = pm >= 16;
        RopeRegs RR; rope_preload(RR, fq);
        const int prow0 = (((pm * 256) & 1023) >> 6) + wr;
        EPI_LOOP(
            const int hh = col0 / 192; const int w = col0 - hh * 192;
            if (samp && w >= 128) rope_rot(RR, (((w - 128) >> 5) & 1) ? (m * 16 + fr) : (prow0 + 2 * ai), v0, v1);
            bf16_t* q = QB + (size_t)row * 1536 + col0; st_bf4(q, v0); st_bf4(q + 16, v1);
        )
    }
};
struct EpiBf {
    bf16_t* O; int ldc; int ncols;
    DI void run(const acc_t& acc, int pm, int pn, int wr, int wc, int fr, int fq) const {
        EPI_LOOP(
            if (col0 < ncols) { bf16_t* q = O + (size_t)row * ldc + col0; st_bf4(q, v0); st_bf4(q + 16, v1); }
        )
    }
};
struct EpiOut {
    const float* xp; const float* xs; float* xo; const float* modg;
    DI void run(const acc_t& acc, int pm, int pn, int wr, int wc, int fr, int fq) const {
        const int brow = pm * 256, cbase = pn * 256 + wc * 32 + fq * 4;
        const float* g = modg + cond_of(brow) * 6144 + cbase;
        f32x4 gg[2][2];
#pragma unroll
        for (int bj = 0; bj < 2; ++bj) { gg[bj][0] = ld_f4(g + bj * 128); gg[bj][1] = ld_f4(g + bj * 128 + 16); }
        const float* xi = (brow < 4096 ? xp + (size_t)brow * 2048 : xs + (size_t)(brow - 4096) * 2048) + (size_t)(wr * 64 + fr) * 2048 + cbase;
        float* xob = xo + (size_t)(brow + wr * 64 + fr) * 2048 + cbase;
        f32x4 xv[4][2][2][2];
#define EO_LOAD(b) _Pragma("unroll") for (int mm = 0; mm < 2; ++mm) _Pragma("unroll") for (int bj = 0; bj < 2; ++bj) { \
            const float* q = xi + (size_t)(((b) >> 1) * 128 + (((b) & 1) * 2 + mm) * 16) * 2048 + bj * 128; xv[b][mm][bj][0] = ld_f4(q); xv[b][mm][bj][1] = ld_f4(q + 16); }
#define EO_STORE(b) _Pragma("unroll") for (int mm = 0; mm < 2; ++mm) _Pragma("unroll") for (int bj = 0; bj < 2; ++bj) { \
            float* o = xob + (size_t)(((b) >> 1) * 128 + (((b) & 1) * 2 + mm) * 16) * 2048 + bj * 128; \
            st_f4(o, xv[b][mm][bj][0] + gg[bj][0] * acc[(b) >> 1][bj][((b) & 1) * 2 + mm][0]); st_f4(o + 16, xv[b][mm][bj][1] + gg[bj][1] * acc[(b) >> 1][bj][((b) & 1) * 2 + mm][1]); }
        EO_LOAD(0) EO_LOAD(1) EO_STORE(0) EO_LOAD(2) EO_STORE(1) EO_LOAD(3) EO_STORE(2) EO_STORE(3)
#undef EO_LOAD
#undef EO_STORE
    }
};
struct EpiGate {
    bf16_t* O; const float* modg;
    DI void run(const acc_t& acc, int pm, int pn, int wr, int wc, int fr, int fq) const {
        const float* g = modg + cond_of(pm * 256) * 6144 + pn * 256 + wc * 32 + fq * 4;
        f32x4 gg[2][2];
#pragma unroll
        for (int bj = 0; bj < 2; ++bj) { gg[bj][0] = ld_f4(g + bj * 128); gg[bj][1] = ld_f4(g + bj * 128 + 16); }
        EPI_LOOP(
            bf16_t* q = O + (size_t)row * 2048 + col0; st_bf4(q, gg[bj][0] * v0); st_bf4(q + 16, gg[bj][1] * v1);
        )
    }
};
typedef _Float16 h16x2 __attribute__((ext_vector_type(2)));
DI unsigned pkh2(float a, float b) { f32x2 v = {a, b}; h16x2 r = __builtin_convertvector(v, h16x2); return __builtin_bit_cast(unsigned, r); }
DI float h2f_(unsigned short h) { return (float)__builtin_bit_cast(_Float16, h); }
DI f32x4 h4_to_f4(u32x2 u) { const unsigned u0 = u[0], u1 = u[1]; f32x4 r = {h2f_((unsigned short)(u0 & 0xffffu)), h2f_((unsigned short)(u0 >> 16)), h2f_((unsigned short)(u1 & 0xffffu)), h2f_((unsigned short)(u1 >> 16))}; return r; }
template <int CTRL> DI float dpp_rowshift0(float x) { return __int_as_float(__builtin_amdgcn_update_dpp(0, __float_as_int(x), CTRL, 0xF, 0xF, true)); }
struct EpiDecay {
    bf16_t* O; const float* bias; int rev;
    DI void run(const acc_t& acc, int pm, int pn, int wr, int wc, int fr, int fq) const {
        const float* bp = bias + pn * 256 + wc * 32 + fq * 4;
        f32x4 bb[2][2];
#pragma unroll
        for (int bj = 0; bj < 2; ++bj) { bb[bj][0] = ld_f4(bp + bj * 128); bb[bj][1] = ld_f4(bp + bj * 128 + 16); }
        EPI_LOOP(
            f32x4 r0; f32x4 r1;
            _Pragma("unroll") for (int j = 0; j < 4; ++j) {
                float a = 0.6065306597126334f * sigmoidf_(bb[bj][0][j] + v0[j]); float b = 0.6065306597126334f * sigmoidf_(bb[bj][1][j] + v1[j]);
                if (rev) {
                    a += dpp_rowshift0<0x101>(a); a += dpp_rowshift0<0x102>(a); a += dpp_rowshift0<0x104>(a); a += dpp_rowshift0<0x108>(a);
                    b += dpp_rowshift0<0x101>(b); b += dpp_rowshift0<0x102>(b); b += dpp_rowshift0<0x104>(b); b += dpp_rowshift0<0x108>(b);
                } else {
                    a += dpp_rowshift0<0x111>(a); a += dpp_rowshift0<0x112>(a); a += dpp_rowshift0<0x114>(a); a += dpp_rowshift0<0x118>(a);
                    b += dpp_rowshift0<0x111>(b); b += dpp_rowshift0<0x112>(b); b += dpp_rowshift0<0x114>(b); b += dpp_rowshift0<0x118>(b);
                }
                r0[j] = a; r1[j] = b;
            }
            bf16_t* q = O + (size_t)row * 2048 + col0;
            { u32x2 u = {pkh2(r0[0], r0[1]), pkh2(r0[2], r0[3])}; *(u32x2*)q = u; }
            { u32x2 u = {pkh2(r1[0], r1[1]), pkh2(r1[2], r1[3])}; *(u32x2*)(q + 16) = u; }
        )
    }
};
struct EpiLora {
    bf16_t* O; const float* bias; float mul;
    DI void run(const acc_t& acc, int pm, int pn, int wr, int wc, int fr, int fq) const {
        const float* bp = bias + pn * 256 + wc * 32 + fq * 4;
        f32x4 bb[2][2];
#pragma unroll
        for (int bj = 0; bj < 2; ++bj) { bb[bj][0] = ld_f4(bp + bj * 128); bb[bj][1] = ld_f4(bp + bj * 128 + 16); }
        EPI_LOOP(
            f32x4 r0, r1;
            _Pragma("unroll") for (int j = 0; j < 4; ++j) { r0[j] = mul * sigmoidf_(bb[bj][0][j] + v0[j]); r1[j] = mul * sigmoidf_(bb[bj][1][j] + v1[j]); }
            bf16_t* q = O + (size_t)row * 2048 + col0; st_bf4(q, r0); st_bf4(q + 16, r1);
        )
    }
};

DI void transpose_tile(LAS float* tl, const float* src, int K, int N, bf16_t* dst, int Kpad, int kt, int ntile, const int wv__) {
    const int tid = otid(), k0 = kt * 64, n0 = ntile * 256;
    const int kr = tid >> 6, nc = (tid & 63) * 4;
    f32x4 v[8];
#pragma unroll
    for (int i = 0; i < 8; ++i) {
        const int k = k0 + kr + i * 8;
        v[i] = (f32x4){0.f, 0.f, 0.f, 0.f};
        if (k < K && n0 + nc < N) v[i] = ld_f4_nt(src + (size_t)k * N + n0 + nc);
    }
#pragma unroll
    for (int i = 0; i < 8; ++i) {
        LAS float* t = tl + (kr + i * 8) * 257 + nc;
        t[0] = v[i][0]; t[1] = v[i][1]; t[2] = v[i][2]; t[3] = v[i][3];
    }
    __syncthreads();
    const int kc = (tid & 7) * 8;
#pragma unroll
    for (int i = 0; i < 4; ++i) {
        const int n = (tid >> 3) + i * 64;
        float e[8];
#pragma unroll
        for (int j = 0; j < 8; ++j) e[j] = tl[(kc + j) * 257 + n];
        u32x4 o = {pk2(e[0], e[1]), pk2(e[2], e[3]), pk2(e[4], e[5]), pk2(e[6], e[7])};
        *(u32x4*)(dst + (size_t)(n0 + n) * Kpad + k0 + kc) = o;
    }
    __syncthreads();
}
DI void cvt_cache(const float* src, bf16_t* dst, int W, int item, const int wv__) {
    const size_t e = (size_t)item * 4096 + otid() * 8;
    const int srow = (int)(e / W), c = (int)(e % W);
    const int b = srow >> 9, s = srow & 511;
    const int drow = 4096 + b * 1536 + 1024 + s;
    const f32x4 a = ld_f4_nt(src + e), bb = ld_f4_nt(src + e + 4);
    u32x4 o = {pk2(a[0], a[1]), pk2(a[2], a[3]), pk2(bb[0], bb[1]), pk2(bb[2], bb[3])};
    *(u32x4*)(dst + (size_t)drow * W + c) = o;
}
DI void mod_job(const Params& p, LAS unsigned char* lds, int item, const int wv__) {
    LAS float* sl = (LAS float*)lds;
    LAS float* red = sl + 5 * 2048;
    const int tid = otid();
    const float* cc = p.in[8]; const float* cctx = p.in[9];
    for (int i = tid; i < 5 * 2048; i += NTHREADS) { const int cnd = i >> 11, k = i & 2047; const float c = cnd == 0 ? cctx[k] : cc[(cnd - 1) * 2048 + k]; sl[i] = c * sigmoidf_(c); }
    __syncthreads();
    const int l = item / 192, n0 = (item % 192) * 32;
    const int kg = tid >> 3, cl = (tid & 7) * 4;
    const float* W = p.in[10] + (size_t)l * 2048 * 6144 + n0 + cl;
    f32x4 acc[5];
#pragma unroll
    for (int c = 0; c < 5; ++c) acc[c] = (f32x4){0.f, 0.f, 0.f, 0.f};
#pragma unroll 8
    for (int pass = 0; pass < 32; ++pass) {
        const int k = pass * 64 + kg;
        const f32x4 w = ld_f4_nt(W + (size_t)k * 6144);
#pragma unroll
        for (int c = 0; c < 5; ++c) acc[c] += sl[c * 2048 + k] * w;
    }
#pragma unroll
    for (int c = 0; c < 5; ++c)
#pragma unroll
        for (int j = 0; j < 4; ++j) red[kg * 160 + c * 32 + cl + j] = acc[c][j];
    __syncthreads();
    if (tid < 160) {
        float s = 0.f;
        for (int g = 0; g < 64; ++g) s += red[g * 160 + tid];
        const int cnd = tid >> 5, c = tid & 31;
        float* mod = (float*)(p.ws + OFF_MOD);
        mod[(size_t)(l * 5 + cnd) * 6144 + n0 + c] = s + p.in[11][l * 6144 + n0 + c];
    }
    __syncthreads();
}
DI void prep_phase(const Params& p, LAS unsigned char* lds, const int wv__) {
    constexpr int J_MOD = 384;
    constexpr int J_T0 = 32 * 24, J_T1 = 32 * 34, J_TO = 32 * 8, J_TUQ = 8 * 6, J_TUKV = 4 * 8, J_TL = 2 * 8;
    constexpr int J_CK = 512, J_CV = 512, J_CC = 128, J_CP = 32;
    constexpr int TOTAL = J_MOD + J_T0 + J_T1 + 2 * J_TO + J_TUQ + J_TUKV + 4 * J_TL + J_CK + J_CV + J_CC + J_CP + 1;
    LAS float* tl = (LAS float*)lds;
    for (int job = blockIdx.x; job < TOTAL + 384; job += gridDim.x) {
        int j = job;
        if (gridDim.x == 256) {
            if (job >= 512 && job < 1280) { if ((job & 255) < 128) continue; j = job - (((job - 512) >> 8) * 128 + 128); }
            else if (job >= 1280) j = job - 384;
        } else if (job >= TOTAL) continue;
        if (j < J_MOD) { mod_job(p, lds, j, wv__); continue; } j -= J_MOD;
        if (j < J_T0) { transpose_tile(tl, p.in[14], 2048, 5952, (bf16_t*)(p.ws + OFF_WT0), 2048, j % 32, j / 32, wv__); continue; } j -= J_T0;
        if (j < J_T1) { transpose_tile(tl, p.in[22], 2048, 8576, (bf16_t*)(p.ws + OFF_WT1), 2048, j % 32, j / 32, wv__); continue; } j -= J_T1;
        if (j < J_TO) { transpose_tile(tl, p.in[15], 2048, 2048, (bf16_t*)(p.ws + OFF_WOT0), 2048, j % 32, j / 32, wv__); continue; } j -= J_TO;
        if (j < J_TO) { transpose_tile(tl, p.in[23], 2048, 2048, (bf16_t*)(p.ws + OFF_WOT1), 2048, j % 32, j / 32, wv__); continue; } j -= J_TO;
        if (j < J_TUQ) { transpose_tile(tl, p.in[19], 512, 1536, (bf16_t*)(p.ws + OFF_WUQ), 512, j % 8, j / 8, wv__); continue; } j -= J_TUQ;
        if (j < J_TUKV) { transpose_tile(tl, p.in[21], 256, 2048, (bf16_t*)(p.ws + OFF_WUKV), 256, j % 4, j / 4, wv__); continue; } j -= J_TUKV;
        if (j < 4 * J_TL) {
            const int which = j / J_TL, jj = j % J_TL, z = which & 1;
            const float* src = (which < 2 ? p.in[26] : p.in[28]) + (size_t)z * 96 * 2048;
            bf16_t* dst = (bf16_t*)(p.ws + (which < 2 ? OFF_W2T : OFF_A2T)) + (size_t)z * 2048 * 128;
            transpose_tile(tl, src, 96, 2048, dst, 128, jj % 2, jj / 2, wv__); continue;
        } j -= 4 * J_TL;
        if (j < J_CK) { cvt_cache(p.in[2], (bf16_t*)(p.ws + OFF_KD), 1024, j, wv__); continue; } j -= J_CK;
        if (j < J_CV) { cvt_cache(p.in[3], (bf16_t*)(p.ws + OFF_VD), 1024, j, wv__); continue; } j -= J_CV;
        if (j < J_CC) { cvt_cache(p.in[4], (bf16_t*)(p.ws + OFF_CKVA), 256, j, wv__); continue; } j -= J_CC;
        if (j < J_CP) { cvt_cache(p.in[5], (bf16_t*)(p.ws + OFF_KPE), 64, j, wv__); continue; } j -= J_CP;
        {
            f32x2* tab = (f32x2*)(p.ws + OFF_ROPE);
            for (int i = otid(); i < 1024; i += NTHREADS) {
                const int pos = i >> 4, fi = i & 15;
                const float f = powf(10000.f, -(float)fi / 16.f);
                const float ang = (float)pos * f;
                f32x2 t = {cosf(ang), sinf(ang)};
                tab[i] = t;
            }
        }
    }
}

DI void norm_mod_phase(const float* xp, const float* xs, const float* g, const float* modl, bf16_t* H, const int wv__) {
    const int tid_ = otid(), lane = tid_ & 63, wg = blockIdx.x * 8 + (tid_ >> 6), nw = gridDim.x * 8;
    for (int row = wg; row < 8192; row += nw) {
        const float* x = row < 4096 ? xp + (size_t)row * 2048 : xs + (size_t)(row - 4096) * 2048;
        const float* md = modl + cond_of(row) * 6144;
        f32x4 v[8]; float ss = 0.f;
#pragma unroll
        for (int i = 0; i < 8; ++i) { v[i] = ld_f4(x + i * 256 + lane * 4); ss += v[i][0] * v[i][0] + v[i][1] * v[i][1] + v[i][2] * v[i][2] + v[i][3] * v[i][3]; }
        f32x4 gs[8], sh[8];
#pragma unroll
        for (int i = 0; i < 8; ++i) { const int c = i * 256 + lane * 4; gs[i] = ld_f4(g + c) * (1.f + ld_f4(md + 2048 + c)); sh[i] = ld_f4(md + c); }
        ss = wave_sum(ss, lane);
        const float rstd = rsqrtf(ss * (1.f / 2048.f) + 1e-6f);
#pragma unroll
        for (int i = 0; i < 8; ++i) {
            const int c = i * 256 + lane * 4;
            const f32x4 h = v[i] * rstd * gs[i] + sh[i];
            st_bf4(H + (size_t)row * 2048 + c, h);
        }
    }
}
DI void final_norm_phase(float* x, const bf16_t* O2, const float* g, const int wv__) {
    const int tid_ = otid(), lane = tid_ & 63, wg = blockIdx.x * 8 + (tid_ >> 6), nw = gridDim.x * 8;
    for (int row = wg; row < 8192; row += nw) {
        float* xr = x + (size_t)row * 2048;
        f32x4 v[8]; float ss = 0.f;
#pragma unroll
        for (int i = 0; i < 8; ++i) { v[i] = ld_f4(xr + i * 256 + lane * 4) + bf4_to_f4(*(const u32x2*)(O2 + (size_t)row * 2048 + i * 256 + lane * 4)); ss += v[i][0] * v[i][0] + v[i][1] * v[i][1] + v[i][2] * v[i][2] + v[i][3] * v[i][3]; }
        ss = wave_sum(ss, lane);
        const float rstd = rsqrtf(ss * (1.f / 2048.f) + 1e-6f);
#pragma unroll
        for (int i = 0; i < 8; ++i) { const int c = i * 256 + lane * 4; st_f4(xr + c, v[i] * rstd * ld_f4(g + c)); }
    }
}
DI void lat_norm_phase(const Params& p, const int wv__) {
    const int tid_ = otid(), lane = tid_ & 63, wg = blockIdx.x * 8 + (tid_ >> 6), nw = gridDim.x * 8;
    const bf16_t* CQR = (const bf16_t*)(p.ws + OFF_CQR); const float* CKVR = (const float*)(p.ws + OFF_CKVR);
    bf16_t* CQN = (bf16_t*)(p.ws + OFF_CQN); bf16_t* CKVA = (bf16_t*)(p.ws + OFF_CKVA);
    const float* qg = p.in[18]; const float* kg = p.in[20];
    for (int row = wg; row < 8192; row += nw) {
        const u32x4 u = *(const u32x4*)(CQR + (size_t)row * 512 + lane * 8);
        float q[8] = {bflo(u[0]), bfhi(u[0]), bflo(u[1]), bfhi(u[1]), bflo(u[2]), bfhi(u[2]), bflo(u[3]), bfhi(u[3])};
        float ss = 0.f;
#pragma unroll
        for (int i = 0; i < 8; ++i) ss += q[i] * q[i];
        ss = wave_sum(ss, lane);
        float rstd = rsqrtf(ss * (1.f / 512.f) + 1e-6f);
        const f32x4 g0 = ld_f4(qg + lane * 8), g1 = ld_f4(qg + lane * 8 + 4);
        u32x4 o = {pk2(q[0] * rstd * g0[0], q[1] * rstd * g0[1]), pk2(q[2] * rstd * g0[2], q[3] * rstd * g0[3]),
                   pk2(q[4] * rstd * g1[0], q[5] * rstd * g1[1]), pk2(q[6] * rstd * g1[2], q[7] * rstd * g1[3])};
        *(u32x4*)(CQN + (size_t)row * 512 + lane * 8) = o;
        const f32x4 kv = ld_f4(CKVR + (size_t)row * 256 + lane * 4);
        float s2 = kv[0] * kv[0] + kv[1] * kv[1] + kv[2] * kv[2] + kv[3] * kv[3];
        s2 = wave_sum(s2, lane);
        rstd = rsqrtf(s2 * (1.f / 256.f) + 1e-6f);
        const f32x4 r = kv * rstd * ld_f4(kg + lane * 4);
        if (row < 4096) st_f4(p.out + OUT_CKV + (size_t)row * 256 + lane * 4, r);
        st_bf4(CKVA + (size_t)kvrow_of(row) * 256 + lane * 4, r);
    }
}

template <int TYPE>
DI void attn_unit(const Params& p, LAS unsigned char* lds, int samp, int b, int h, int qb, float lam, const int wv__) {
    constexpr int NC = TYPE == 0 ? 2 : 1, KS = TYPE == 0 ? 2 : 6, KDIM = TYPE == 0 ? 128 : 192;
    constexpr int KP = KDIM * 2 + 16, VP = 288, CPK = KDIM / 8, NKC = 64 * CPK / NTHREADS;
    LAS unsigned char* Ks = lds; LAS unsigned char* Vs = lds + 64 * KP;
    const int tid = otid(), wid = tid >> 6, lane = tid & 63, fr = lane & 15, fq = lane >> 4;
    const int row0 = samp ? 4096 + b * 1024 + qb * 128 : b * 256 + qb * 128, qrow = row0 + wid * 16 + fr;
    const int kv0 = samp ? 4096 + b * 1536 : b * 256, ntile = samp ? 24 : 4;
    const bf16_t* QD = (const bf16_t*)(p.ws + OFF_QD); const bf16_t* KD = (const bf16_t*)(p.ws + OFF_KD); const bf16_t* VD = (const bf16_t*)(p.ws + OFF_VD);
    const bf16_t* QB = (const bf16_t*)(p.ws + OFF_QB); const bf16_t* KVB = (const bf16_t*)(p.ws + OFF_KVB); const bf16_t* KPE = (const bf16_t*)(p.ws + OFF_KPE);
    bf16x8 qf[NC * KS];
#pragma unroll
    for (int i = 0; i < NC * KS; ++i)
        qf[i] = TYPE == 0 ? *(const bf16x8*)(QD + (size_t)qrow * 1024 + h * 128 + i * 32 + fq * 8) : *(const bf16x8*)(QB + (size_t)qrow * 1536 + h * 192 + i * 32 + fq * 8);
    f32x4 o[NC][8];
    float mrun[NC], lrun[NC];
#pragma unroll
    for (int c = 0; c < NC; ++c) { mrun[c] = -1e30f; lrun[c] = 0.f;
#pragma unroll
        for (int v = 0; v < 8; ++v) o[c][v] = (f32x4){0.f, 0.f, 0.f, 0.f}; }
    const float sl2 = (TYPE == 0 ? 0.125f : 0.07216878364870322f) * 1.4426950408889634f;
    u32x4 kreg[NKC], vreg[2];
    auto prefetch = [&](int t) {
#pragma unroll
        for (int i = 0; i < NKC; ++i) {
            const int q = tid + i * NTHREADS, key = q / CPK, ch = q % CPK; const size_t r = (size_t)(kv0 + t * 64 + key);
            const bf16_t* src;
            if (TYPE == 0) src = KD + r * 1024 + h * 128 + ch * 8;
            else src = ch < 16 ? KVB + r * 2048 + h * 256 + ch * 8 : KPE + r * 64 + (ch - 16) * 8;
            kreg[i] = *(const u32x4*)src;
        }
#pragma unroll
        for (int i = 0; i < 2; ++i) {
            const int q = tid + i * NTHREADS, key = q >> 4, ch = q & 15; const size_t r = (size_t)(kv0 + t * 64 + key);
            const bf16_t* src = TYPE == 0 ? VD + r * 1024 + h * 128 + ch * 8 : KVB + r * 2048 + h * 256 + 128 + ch * 8;
            vreg[i] = *(const u32x4*)src;
        }
    };
    constexpr int BUFB = 64 * KP + 64 * VP;
    auto lds_write = [&](int buf) {
        LAS unsigned char* Kb = lds + buf * BUFB; LAS unsigned char* Vb = Kb + 64 * KP;
#pragma unroll
        for (int i = 0; i < NKC; ++i) { const int q = tid + i * NTHREADS, key = q / CPK, ch = q % CPK; *(LAS u32x4*)(Kb + key * KP + ch * 16) = kreg[i]; }
#pragma unroll
        for (int i = 0; i < 2; ++i) { const int q = tid + i * NTHREADS, key = q >> 4, ch = q & 15; *(LAS u32x4*)(Vb + key * VP + ch * 16) = vreg[i]; }
    };
    prefetch(0);
    lds_write(0);
    if (ntile > 1) prefetch(1);
    __syncthreads();
    const int qq = (lane & 15) >> 2, pp = lane & 3;
    for (int t = 0; t < ntile; ++t) {
        if (t + 1 < ntile) lds_write((t + 1) & 1);
        if (t + 2 < ntile) prefetch(t + 2);
        LAS unsigned char* Kc = lds + (t & 1) * BUFB; LAS unsigned char* Vc = Kc + 64 * KP;
        f32x4 s[NC][4];
#pragma unroll
        for (int c = 0; c < NC; ++c)
#pragma unroll
            for (int nt = 0; nt < 4; ++nt) {
                s[c][nt] = (f32x4){0.f, 0.f, 0.f, 0.f};
#pragma unroll
                for (int ks = 0; ks < KS; ++ks) {
                    const bf16x8 kf = *(const LAS bf16x8*)(Kc + (nt * 16 + fr) * KP + (c * KS + ks) * 64 + fq * 16);
                    s[c][nt] = __builtin_amdgcn_mfma_f32_16x16x32_bf16(kf, qf[c * KS + ks], s[c][nt], 0, 0, 0);
                }
                if (nt & 1) __builtin_amdgcn_sched_barrier(0);
            }
        __builtin_amdgcn_sched_barrier(0);
        bf16x8 pb[NC][2];
#pragma unroll
        for (int c = 0; c < NC; ++c) {
            float mx = -1e30f;
#pragma unroll
            for (int nt = 0; nt < 4; ++nt)
#pragma unroll
                for (int j = 0; j < 4; ++j) mx = fmaxf(mx, s[c][nt][j]);
            mx = fmaxf(mx, shx(mx, 16, lane)); mx = fmaxf(mx, shx(mx, 32, lane));
            const float mnew = fmaxf(mrun[c], mx);
            const float alpha = __builtin_amdgcn_exp2f((mrun[c] - mnew) * sl2);
            mrun[c] = mnew;
            const float nm = -mnew * sl2;
            float ls = 0.f;
#pragma unroll
            for (int nt = 0; nt < 4; ++nt)
#pragma unroll
                for (int j = 0; j < 4; ++j) { const float e = __builtin_amdgcn_exp2f(fmaf(s[c][nt][j], sl2, nm)); s[c][nt][j] = e; ls += e; }
            lrun[c] = lrun[c] * alpha + ls;
            if (__builtin_amdgcn_ballot_w64(alpha != 1.f) != 0ull) {
#pragma unroll
                for (int v = 0; v < 8; ++v) o[c][v] *= alpha;
            }
#pragma unroll
            for (int s2 = 0; s2 < 2; ++s2) {
                u32x4 u = {pk2(s[c][2 * s2][0], s[c][2 * s2][1]), pk2(s[c][2 * s2][2], s[c][2 * s2][3]), pk2(s[c][2 * s2 + 1][0], s[c][2 * s2 + 1][1]), pk2(s[c][2 * s2 + 1][2], s[c][2 * s2 + 1][3])};
                pb[c][s2] = __builtin_bit_cast(bf16x8, u);
            }
        }
#pragma unroll
        for (int s2 = 0; s2 < 2; ++s2)
#pragma unroll
            for (int v = 0; v < 8; ++v) {
                LAS unsigned char* a0 = Vc + (32 * s2 + 4 * fq + qq) * VP + v * 32 + 8 * pp;
                const s16x4 lo = __builtin_amdgcn_ds_read_tr16_b64_v4i16((LAS s16x4*)a0);
                const s16x4 hi = __builtin_amdgcn_ds_read_tr16_b64_v4i16((LAS s16x4*)(a0 + 16 * VP));
                const bf16x8 va = __builtin_shufflevector(lo, hi, 0, 1, 2, 3, 4, 5, 6, 7);
#pragma unroll
                for (int c = 0; c < NC; ++c) o[c][v] = __builtin_amdgcn_mfma_f32_16x16x32_bf16(va, pb[c][s2], o[c][v], 0, 0, 0);
                if ((v & 1) == 1) __builtin_amdgcn_sched_barrier(0);
            }
        __syncthreads();
    }
    float linv[NC];
#pragma unroll
    for (int c = 0; c < NC; ++c) { float l = lrun[c]; l += shx(l, 16, lane); l += shx(l, 32, lane); linv[c] = 1.f / l; }
    const bf16_t* SG = (const bf16_t*)(p.ws + OFF_SG0);
    bf16_t* Y = (bf16_t*)(p.ws + OFF_H);
    if (TYPE == 0) {
        float ss = 0.f;
#pragma unroll
        for (int v = 0; v < 8; ++v)
#pragma unroll
            for (int j = 0; j < 4; ++j) { const float x = o[0][v][j] * linv[0] - lam * o[NC - 1][v][j] * linv[NC - 1]; o[0][v][j] = x; ss += x * x; }
        ss += shx(ss, 16, lane); ss += shx(ss, 32, lane);
        const float rstd = rsqrtf(ss * (1.f / 128.f) + 1e-6f) * 0.8f;
        const float* sg = p.in[17];
#pragma unroll
        for (int v = 0; v < 8; ++v) {
            const int d = v * 16 + fq * 4;
            const f32x4 g = ld_f4(sg + d);
            const f32x4 gt = bf4_to_f4(*(const u32x2*)(SG + (size_t)qrow * 2048 + h * 128 + d));
            st_bf4(Y + (size_t)qrow * 2048 + h * 128 + d, o[0][v] * rstd * g * gt);
        }
    } else {
#pragma unroll
        for (int v = 0; v < 8; ++v) {
            const int d = v * 16 + fq * 4;
            const f32x4 gt = bf4_to_f4(*(const u32x2*)(SG + (size_t)qrow * 2048 + 1024 + h * 128 + d));
            st_bf4(Y + (size_t)qrow * 2048 + 1024 + h * 128 + d, o[0][v] * linv[0] * gt);
        }
    }
}
DI void attn_phase(const Params& p, LAS unsigned char* lds, const int wv__) {
    const float* lp = p.in[16];
    const int lane = otid() & 63;
    const float s01 = wave_sum(lp[lane] * lp[64 + lane], lane), s23 = wave_sum(lp[128 + lane] * lp[192 + lane], lane);
    const float lam = __expf(s01) - __expf(s23) + 0.2f;
    for (int u = blockIdx.x; u < 1024; u += gridDim.x) {
        const int grp = u >> 8, i = u & 255;
        if (grp == 0) attn_unit<0>(p, lds, 1, i >> 6, (i >> 3) & 7, i & 7, lam, wv__);
        else if (grp == 1) attn_unit<1>(p, lds, 1, i >> 6, (i >> 3) & 7, i & 7, lam, wv__);
        else if (grp == 2) attn_unit<0>(p, lds, 0, i >> 4, (i >> 1) & 7, i & 1, lam, wv__);
        else attn_unit<1>(p, lds, 0, i >> 4, (i >> 1) & 7, i & 1, lam, wv__);
    }
}

DI f32x4 tshift(f32x4 x, f32x4 pv, f32x4 nx, f32x4 m0, f32x4 m1) { return x + m0 * (pv - x) + m1 * (nx - x); }
DI void seq_pos(int row, int& t, int& T) { if (row < 4096) { t = row & 255; T = 256; } else { t = (row - 4096) & 1023; T = 1024; } }

DI void lora_in_phase(const Params& p, const int wv__) {
    const int tid_ = otid(), lane = tid_ & 63, wg = blockIdx.x * 8 + (tid_ >> 6), nw = gridDim.x * 8;
    const bf16_t* PART = (const bf16_t*)(p.ws + OFF_PART);
    const float* mu = p.in[24];
    const int o = lane * 8, arr = o >> 7, idx = o & 127;
    bf16_t* dstb = (bf16_t*)(p.ws + (arr < 2 ? OFF_WDT : OFF_ADT)) + (size_t)(arr & 1) * 8192 * 128 + idx;
    for (int row = wg; row < 8192; row += nw) {
        u32x4 res = {0u, 0u, 0u, 0u};
        if (idx < 96) {
            int t, T; seq_pos(row, t, T);
            const int col = 8192 + arr * 96 + idx;
            const bf16_t* c = PART + (size_t)row * 2048 + arr * 96 + idx;
            float xc[8], xp[8], xn[8];
#pragma unroll
            for (int e = 0; e < 8; ++e) { xc[e] = 0.f; xp[e] = 0.f; xn[e] = 0.f; }
#pragma unroll
            for (int ks = 0; ks < 4; ++ks) {
                const u32x4 uc = *(const u32x4*)(c + ks * 512);
#pragma unroll
                for (int e = 0; e < 4; ++e) { xc[2 * e] += bflo(uc[e]); xc[2 * e + 1] += bfhi(uc[e]); }
                if (t > 0) { const u32x4 up = *(const u32x4*)(c + ks * 512 - 2048);
#pragma unroll
                    for (int e = 0; e < 4; ++e) { xp[2 * e] += bflo(up[e]); xp[2 * e + 1] += bfhi(up[e]); } }
                if (t < T - 1) { const u32x4 un = *(const u32x4*)(c + ks * 512 + 2048);
#pragma unroll
                    for (int e = 0; e < 4; ++e) { xn[2 * e] += bflo(un[e]); xn[2 * e + 1] += bfhi(un[e]); } }
            }
            float r[8];
#pragma unroll
            for (int e = 0; e < 4; ++e) {
                const f32x2 m0 = *(const f32x2*)(mu + col + 2 * e), m1 = *(const f32x2*)(mu + 8576 + col + 2 * e);
                r[2 * e] = xc[2 * e] + m0[0] * (xp[2 * e] - xc[2 * e]) + m1[0] * (xn[2 * e] - xc[2 * e]);
                r[2 * e + 1] = xc[2 * e + 1] + m0[1] * (xp[2 * e + 1] - xc[2 * e + 1]) + m1[1] * (xn[2 * e + 1] - xc[2 * e + 1]);
            }
            if (arr < 2) {
#pragma unroll
                for (int e = 0; e < 8; ++e) r[e] = tanhf(r[e]);
            }
            res = (u32x4){pk2(r[0], r[1]), pk2(r[2], r[3]), pk2(r[4], r[5]), pk2(r[6], r[7])};
        }
        *(u32x4*)(dstb + (size_t)row * 128) = res;
    }
}

struct StageRegs { u32x2 raw[9], ra, re, rep; int row; };
DI void scan_stage_load(StageRegs& R, const bf16_t* C1, const bf16_t* AZ, const bf16_t* EZ, const float* mu, const float* kkw, const float* kaw, const float* rkw,
                        int row, int t, int T, int h, int z, int c4, bool first  ) {
    (void)mu; (void)kkw; (void)kaw; (void)rkw;
    R.row = row;
    const bf16_t* c = C1 + (size_t)row * 8576 + h * 64 + c4;
    const u32x2 zero = {0u, 0u};
#pragma unroll
    for (int g = 0; g < 3; ++g) {
        R.raw[g * 3 + 1] = *(const u32x2*)(c + g * 2048);
        R.raw[g * 3 + 0] = t > 0 ? *(const u32x2*)(c + g * 2048 - 8576) : zero;
        R.raw[g * 3 + 2] = t < T - 1 ? *(const u32x2*)(c + g * 2048 + 8576) : zero;
    }
    R.ra = *(const u32x2*)(AZ + ((size_t)z * 8192 + row) * 2048 + h * 64 + c4);
    R.re = *(const u32x2*)(EZ + ((size_t)z * 8192 + row) * 2048 + h * 64 + c4);
    R.rep = first ? zero : *(const u32x2*)(EZ + ((size_t)z * 8192 + row + (z ? 1 : -1)) * 2048 + h * 64 + c4);
}
DI void scan_stage_store(const StageRegs& R, LAS float* sb, float* BN, bool lead, int h, int z, const LAS float* pt, bool wlast, LAS float* plast  ) {
    f32x4 x[3];
#pragma unroll
    for (int g = 0; g < 3; ++g) x[g] = tshift(bf4_to_f4(R.raw[g * 3 + 1]), bf4_to_f4(R.raw[g * 3 + 0]), bf4_to_f4(R.raw[g * 3 + 2]), *(const LAS f32x4*)(pt + (2 * g) * 64), *(const LAS f32x4*)(pt + (2 * g + 1) * 64));
    const f32x4 a = bf4_to_f4(R.ra), cs = h4_to_f4(R.re), cp = h4_to_f4(R.rep);
    const f32x4 kkr = x[1] * *(const LAS f32x4*)(pt + 6 * 64);
    float ss = kkr[0] * kkr[0] + kkr[1] * kkr[1] + kkr[2] * kkr[2] + kkr[3] * kkr[3];
    ss = sum16d(ss);
    const f32x4 kk = kkr * rsqrtf(fmaxf(ss, 1e-12f));
    const f32x4 kz = x[1] * (1.f + (a - 1.f) * *(const LAS f32x4*)(pt + 7 * 64));
    const f32x4 kka = kk * a;
    f32x4 pc, ip, pp;
#pragma unroll
    for (int j = 0; j < 4; ++j) { pc[j] = __expf(-cs[j]); ip[j] = __expf(cs[j]); pp[j] = __expf(-cp[j]); }
    const f32x4 rk = *(const LAS f32x4*)(pt + 8 * 64);
    float bn = x[0][0] * kz[0] * rk[0] + x[0][1] * kz[1] * rk[1] + x[0][2] * kz[2] * rk[2] + x[0][3] * kz[3] * rk[3];
    bn = sum16d(bn);
    if (lead) BN[((size_t)z * 8192 + R.row) * 32 + h] = bn;
    *(LAS f32x4*)(sb) = x[0] * pc; *(LAS f32x4*)(sb + 64) = kka * ip; *(LAS f32x4*)(sb + 128) = kz * ip; *(LAS f32x4*)(sb + 192) = -kk * pp; *(LAS f32x4*)(sb + 320) = x[2];
    if (wlast) *(LAS f32x4*)plast = pc;
}

DI void scan_phase(const Params& p, LAS unsigned char* lds, const int wv__) {
    const int tid = otid(), wid = __builtin_amdgcn_readfirstlane(tid >> 6), lane = tid & 63, half = wid >> 2, ht = tid & 255;
    const bf16_t* C1 = (const bf16_t*)(p.ws + OFF_C);
    const bf16_t* AZ = (const bf16_t*)(p.ws + OFF_AZ); const bf16_t* EZ = (const bf16_t*)(p.ws + OFF_EZ);
    bf16_t* YZ = (bf16_t*)(p.ws + OFF_YZ); float* BN = (float*)(p.ws + OFF_BN);
    const float* mu = p.in[24];
    LAS float* lf = (LAS float*)lds;
    for (int u = blockIdx.x; u < 256; u += gridDim.x) {
        if (half == 0) {
            const int rg = ht >> 3, cg8 = ht & 7, stt = ht >> 4, c4 = (ht & 15) * 4;
            const int b = u >> 6, h = (u >> 1) & 31, z = u & 1, T = 1024, rowbase = 4096 + b * 1024;
            LAS float* base = lf;
            LAS unsigned* ybase = (LAS unsigned*)(lf + 24576);
            f32x2 S[2][4];
            {
                const float* st = (z ? p.in[7] : p.in[6]) + (((size_t)b * 32 + h) * 64 + 2 * rg) * 64 + cg8 * 8;
#pragma unroll
                for (int rr = 0; rr < 2; ++rr) { const f32x4 v0 = ld_f4(st + rr * 64), v1 = ld_f4(st + rr * 64 + 4);
                    S[rr][0] = (f32x2){v0[0], v0[1]}; S[rr][1] = (f32x2){v0[2], v0[3]}; S[rr][2] = (f32x2){v1[0], v1[1]}; S[rr][3] = (f32x2){v1[2], v1[3]}; }
            }
            LAS float* ptab = lf + 26112;
            {
                if (ht < 16) {
                    const int hc = h * 64 + c4;
#pragma unroll
                    for (int g = 0; g < 3; ++g) { *(LAS f32x4*)(ptab + (2 * g) * 64 + c4) = ld_f4(mu + g * 2048 + hc); *(LAS f32x4*)(ptab + (2 * g + 1) * 64 + c4) = ld_f4(mu + 8576 + g * 2048 + hc); }
                    *(LAS f32x4*)(ptab + 6 * 64 + c4) = ld_f4(p.in[29] + hc); *(LAS f32x4*)(ptab + 7 * 64 + c4) = ld_f4(p.in[30] + hc); *(LAS f32x4*)(ptab + 8 * 64 + c4) = ld_f4(p.in[31] + hc);
                }
                __syncthreads();
            }
            StageRegs R;
            auto sload = [&](int ci, bool prm) { (void)prm; const int step = ci * 16 + stt, t = z ? T - 1 - step : step; scan_stage_load(R, C1, AZ, EZ, mu, p.in[29], p.in[30], p.in[31], rowbase + t, t, T, h, z, c4, stt == 0); };
            auto sstore = [&](int ci) { scan_stage_store(R, base + ((ci & 1) * 16 + stt) * 384 + c4, BN, (ht & 15) == 0, h, z, ptab + c4, stt == 15, base + (ci & 1) * 16 * 384 + 256 + c4); };
            auto flush = [&](int ci) {
                const LAS unsigned* yb = ybase + (ci & 1) * (16 * 32);
                const int fs = ht >> 4, fr4 = (ht & 15) * 2;
                const u32x2 yv = *(const LAS u32x2*)(yb + fs * 32 + fr4);
                const int step = ci * 16 + fs, t = z ? T - 1 - step : step;
                *(u32x2*)(YZ + ((size_t)z * 8192 + rowbase + t) * 2048 + h * 64 + fr4 * 2) = yv;
            };
            sload(0, true); sstore(0);
            __syncthreads();
            for (int ci = 0; ci < 64; ++ci) {
                if (ci > 0) flush(ci - 1);
                if (ci + 1 < 64) sload(ci + 1, false);
                const LAS float* cb = base + (ci & 1) * 16 * 384;
                LAS unsigned* ybuf = ybase + (ci & 1) * (16 * 32);
                f32x4 cur[8], nxt[8]; f32x2 vcur, vnxt;
                {
                    const LAS float* sb = cb + cg8 * 8;
#pragma unroll
                    for (int q = 0; q < 4; ++q) { cur[2 * q] = *(const LAS f32x4*)(sb + q * 64); cur[2 * q + 1] = *(const LAS f32x4*)(sb + q * 64 + 4); }
                    vcur = *(const LAS f32x2*)(cb + 320 + 2 * rg);
                }
#pragma unroll
                for (int s = 0; s < 16; ++s) {
                    if (s < 15) {
                        const LAS float* sb = cb + (s + 1) * 384 + cg8 * 8;
#pragma unroll
                        for (int q = 0; q < 4; ++q) { nxt[2 * q] = *(const LAS f32x4*)(sb + q * 64); nxt[2 * q + 1] = *(const LAS f32x4*)(sb + q * 64 + 4); }
                        vnxt = *(const LAS f32x2*)(cb + (s + 1) * 384 + 320 + 2 * rg);
                    }
                    f32x2 dp[4], bp[4], cp[4], ap[4];
#pragma unroll
                    for (int q = 0; q < 2; ++q) {
                        dp[2 * q] = (f32x2){cur[q][0], cur[q][1]}; dp[2 * q + 1] = (f32x2){cur[q][2], cur[q][3]};
                        bp[2 * q] = (f32x2){cur[2 + q][0], cur[2 + q][1]}; bp[2 * q + 1] = (f32x2){cur[2 + q][2], cur[2 + q][3]};
                        cp[2 * q] = (f32x2){cur[4 + q][0], cur[4 + q][1]}; cp[2 * q + 1] = (f32x2){cur[4 + q][2], cur[4 + q][3]};
                        ap[2 * q] = (f32x2){cur[6 + q][0], cur[6 + q][1]}; ap[2 * q + 1] = (f32x2){cur[6 + q][2], cur[6 + q][3]};
                    }
                    float sa[2], yy[2];
#pragma unroll
                    for (int rr = 0; rr < 2; ++rr) {
                        f32x2 a2 = S[rr][0] * ap[0] + S[rr][1] * ap[1];
                        f32x2 b2 = S[rr][2] * ap[2] + S[rr][3] * ap[3];
                        a2 += b2;
                        float x = a2[0] + a2[1];
                        x += dpp_xor1(x); x += dpp_xor2(x); x += dpp_hmirror(x);
                        sa[rr] = x;
                    }
#pragma unroll
                    for (int rr = 0; rr < 2; ++rr) {
                        const f32x2 sa2 = {sa[rr], sa[rr]}, v2 = {vcur[rr], vcur[rr]};
                        f32x2 y2 = {0.f, 0.f}, y3 = {0.f, 0.f};
#pragma unroll
                        for (int q = 0; q < 4; ++q) {
                            S[rr][q] = sa2 * bp[q] + (v2 * cp[q] + S[rr][q]);
                            if (q & 1) y3 += S[rr][q] * dp[q]; else y2 += S[rr][q] * dp[q];
                        }
                        y2 += y3;
                        float x = y2[0] + y2[1];
                        x += dpp_xor1(x); x += dpp_xor2(x); x += dpp_hmirror(x);
                        yy[rr] = x;
                    }
                    ybuf[s * 32 + rg] = pk2(yy[0], yy[1]);
                    if (s < 15) {
#pragma unroll
                        for (int q = 0; q < 8; ++q) cur[q] = nxt[q];
                        vcur = vnxt;
                    }
                }
                {
                    const f32x4 p0 = *(const LAS f32x4*)(cb + 256 + cg8 * 8), p1 = *(const LAS f32x4*)(cb + 256 + cg8 * 8 + 4);
                    const f32x2 pl[4] = {(f32x2){p0[0], p0[1]}, (f32x2){p0[2], p0[3]}, (f32x2){p1[0], p1[1]}, (f32x2){p1[2], p1[3]}};
#pragma unroll
                    for (int rr = 0; rr < 2; ++rr)
#pragma unroll
                        for (int q = 0; q < 4; ++q) S[rr][q] *= pl[q];
                }
                if (ci + 1 < 64) sstore(ci + 1);
                __syncthreads();
            }
            flush(63);
            __syncthreads();
        } else {
            const int pw = wid - 4, pu = 4 * u + pw;
            const int b = pu >> 6, h = (pu >> 1) & 31, z = pu & 1, T = 256, rowbase = b * 256;
            const int rg = lane >> 2, cg = lane & 3, stt = lane >> 4, c4 = (lane & 15) * 4;
            LAS float* base = lf + 12288 + pw * (2 * 4 * 384);
            LAS unsigned* ybuf = (LAS unsigned*)(lf + 25600) + pw * (4 * 32);
            f32x2 S[4][8];
#pragma unroll
            for (int rr = 0; rr < 4; ++rr)
#pragma unroll
                for (int q = 0; q < 8; ++q) S[rr][q] = (f32x2){0.f, 0.f};
            LAS float* ptab = lf + 26688 + pw * 576;
            {
                if (lane < 16) {
                    const int hc = h * 64 + c4;
#pragma unroll
                    for (int g = 0; g < 3; ++g) { *(LAS f32x4*)(ptab + (2 * g) * 64 + c4) = ld_f4(mu + g * 2048 + hc); *(LAS f32x4*)(ptab + (2 * g + 1) * 64 + c4) = ld_f4(mu + 8576 + g * 2048 + hc); }
                    *(LAS f32x4*)(ptab + 6 * 64 + c4) = ld_f4(p.in[29] + hc); *(LAS f32x4*)(ptab + 7 * 64 + c4) = ld_f4(p.in[30] + hc); *(LAS f32x4*)(ptab + 8 * 64 + c4) = ld_f4(p.in[31] + hc);
                }
                __syncthreads();
            }
            StageRegs R;
            auto sload = [&](int it, bool prm) { (void)prm; const int step = it * 4 + stt, t = z ? T - 1 - step : step; scan_stage_load(R, C1, AZ, EZ, mu, p.in[29], p.in[30], p.in[31], rowbase + t, t, T, h, z, c4, (step & 15) == 0); };
            auto sstore = [&](int it) { scan_stage_store(R, base + ((it & 1) * 4 + stt) * 384 + c4, BN, (lane & 15) == 0, h, z, ptab + c4, (it & 3) == 3 && stt == 3, base + (it & 1) * 4 * 384 + 256 + c4); };
            sload(0, true); sstore(0);
            __syncthreads();
            for (int it = 0; it < 64; ++it) {
                if (it + 1 < 64) sload(it + 1, false);
                const LAS float* cb = base + (it & 1) * 4 * 384;
#pragma unroll 1
                for (int s = 0; s < 4; ++s) {
                    const LAS float* sb = cb + s * 384 + cg * 16;
                    f32x2 dp[8], bp[8], cp[8], ap[8];
#pragma unroll
                    for (int q = 0; q < 4; ++q) {
                        const f32x4 a4 = *(const LAS f32x4*)(sb + 192 + q * 4);
                        ap[2 * q] = (f32x2){a4[0], a4[1]}; ap[2 * q + 1] = (f32x2){a4[2], a4[3]};
                    }
                    const f32x4 vv = *(const LAS f32x4*)(cb + s * 384 + 320 + 4 * rg);
                    float yy[4], sav[4];
#pragma unroll
                    for (int rr = 0; rr < 4; ++rr) {
                        f32x2 a2 = S[rr][0] * ap[0] + S[rr][1] * ap[1];
                        f32x2 b2 = S[rr][2] * ap[2] + S[rr][3] * ap[3];
                        a2 += S[rr][4] * ap[4] + S[rr][5] * ap[5];
                        b2 += S[rr][6] * ap[6] + S[rr][7] * ap[7];
                        a2 += b2;
                        float sa = a2[0] + a2[1];
                        sa += dpp_xor1(sa); sa += dpp_xor2(sa);
                        sav[rr] = sa;
                    }
                    __builtin_amdgcn_sched_barrier(0);
#pragma unroll
                    for (int q = 0; q < 4; ++q) {
                        const f32x4 a0 = *(const LAS f32x4*)(sb + q * 4), a1 = *(const LAS f32x4*)(sb + 64 + q * 4), a2 = *(const LAS f32x4*)(sb + 128 + q * 4);
                        dp[2 * q] = (f32x2){a0[0], a0[1]}; dp[2 * q + 1] = (f32x2){a0[2], a0[3]};
                        bp[2 * q] = (f32x2){a1[0], a1[1]}; bp[2 * q + 1] = (f32x2){a1[2], a1[3]};
                        cp[2 * q] = (f32x2){a2[0], a2[1]}; cp[2 * q + 1] = (f32x2){a2[2], a2[3]};
                    }
#pragma unroll
                    for (int rr = 0; rr < 4; ++rr) {
                        const f32x2 sa2 = {sav[rr], sav[rr]}, v2 = {vv[rr], vv[rr]};
                        f32x2 y2 = {0.f, 0.f}, y3 = {0.f, 0.f};
#pragma unroll
                        for (int q = 0; q < 8; ++q) {
                            S[rr][q] = sa2 * bp[q] + (v2 * cp[q] + S[rr][q]);
                            if (q & 1) y3 += S[rr][q] * dp[q]; else y2 += S[rr][q] * dp[q];
                        }
                        y2 += y3;
                        float x = y2[0] + y2[1];
                        x += dpp_xor1(x); x += dpp_xor2(x);
                        yy[rr] = x;
                    }
                    const u32x2 yo = {pk2(yy[0], yy[1]), pk2(yy[2], yy[3])};
                    *(LAS u32x2*)(ybuf + s * 32 + rg * 2) = yo;
                }
                {
                    const int fs = lane >> 4, fr4 = (lane & 15) * 2;
                    const u32x2 yv = *(const LAS u32x2*)(ybuf + fs * 32 + fr4);
                    const int step = it * 4 + fs, t = z ? T - 1 - step : step;
                    *(u32x2*)(YZ + ((size_t)z * 8192 + rowbase + t) * 2048 + h * 64 + fr4 * 2) = yv;
                }
                if ((it & 3) == 3) {
#pragma unroll
                    for (int q = 0; q < 4; ++q) {
                        const f32x4 pv = *(const LAS f32x4*)(cb + 256 + cg * 16 + q * 4);
                        const f32x2 pa = {pv[0], pv[1]}, pb2 = {pv[2], pv[3]};
#pragma unroll
                        for (int rr = 0; rr < 4; ++rr) { S[rr][2 * q] *= pa; S[rr][2 * q + 1] *= pb2; }
                    }
                }
                if (it + 1 < 64) sstore(it + 1);
                __syncthreads();
            }
            {
                float* st = p.out + (z ? OUT_SB : OUT_SF) + (((size_t)b * 32 + h) * 64 + 4 * rg) * 64 + cg * 16;
#pragma unroll
                for (int rr = 0; rr < 4; ++rr)
#pragma unroll
                    for (int q = 0; q < 4; ++q) { const f32x4 v = {S[rr][2 * q][0], S[rr][2 * q][1], S[rr][2 * q + 1][0], S[rr][2 * q + 1][1]}; st_f4(st + rr * 64 + q * 4, v); }
            }
            __syncthreads();
        }
    }
}

DI void post_phase(const Params& p, const int wv__) {
    const int tid_ = otid(), lane = tid_ & 63, wg = blockIdx.x * 8 + (tid_ >> 6), nw = gridDim.x * 8;
    const bf16_t* C1 = (const bf16_t*)(p.ws + OFF_C);
    const bf16_t* YZ = (const bf16_t*)(p.ws + OFF_YZ); const float* BN = (const float*)(p.ws + OFF_BN);
    bf16_t* Y1 = (bf16_t*)(p.ws + OFF_H);
    const float* mu = p.in[24]; const float* lnw = p.in[32]; const float* lnb = p.in[33];
    const int cb = wg & 7, c = cb * 256 + lane * 4, hd = c >> 6;
    const f32x4 mv0 = ld_f4(mu + 4096 + c), mv1 = ld_f4(mu + 8576 + 4096 + c), mg0 = ld_f4(mu + 6144 + c), mg1 = ld_f4(mu + 8576 + 6144 + c);
    const f32x4 w4 = ld_f4(lnw + c), b4 = ld_f4(lnb + c);
#pragma unroll 4
    for (int row = wg >> 3; row < 8192; row += nw >> 3) {
        int t, T; seq_pos(row, t, T);
        const bf16_t* cr = C1 + (size_t)row * 8576;
        const bool hp = t > 0, hn = t < T - 1;
        const f32x4 ya = bf4_to_f4(*(const u32x2*)(YZ + (size_t)row * 2048 + c));
        const f32x4 yb = bf4_to_f4(*(const u32x2*)(YZ + ((size_t)8192 + row) * 2048 + c));
        const u32x2 zero = {0u, 0u};
        const u32x2 vc = *(const u32x2*)(cr + 4096 + c), gc = *(const u32x2*)(cr + 6144 + c);
        const u32x2 vp = hp ? *(const u32x2*)(cr - 8576 + 4096 + c) : zero, gp = hp ? *(const u32x2*)(cr - 8576 + 6144 + c) : zero;
        const u32x2 vn = hn ? *(const u32x2*)(cr + 8576 + 4096 + c) : zero, gn = hn ? *(const u32x2*)(cr + 8576 + 6144 + c) : zero;
        const float bna = BN[(size_t)row * 32 + hd], bnb = BN[((size_t)8192 + row) * 32 + hd];
        const float ma = sum16d(ya[0] + ya[1] + ya[2] + ya[3]) * (1.f / 64.f), mb = sum16d(yb[0] + yb[1] + yb[2] + yb[3]) * (1.f / 64.f);
        const f32x4 da = ya - ma, db = yb - mb;
        const float va = sum16d(da[0] * da[0] + da[1] * da[1] + da[2] * da[2] + da[3] * da[3]) * (1.f / 64.f);
        const float vb = sum16d(db[0] * db[0] + db[1] * db[1] + db[2] * db[2] + db[3] * db[3]) * (1.f / 64.f);
        const float rsa = rsqrtf(va + 64e-5f), rsb = rsqrtf(vb + 64e-5f);
        const f32x4 v = tshift(bf4_to_f4(vc), bf4_to_f4(vp), bf4_to_f4(vn), mv0, mv1);
        const f32x4 g = tshift(bf4_to_f4(gc), bf4_to_f4(gp), bf4_to_f4(gn), mg0, mg1);
        f32x4 res = (da * rsa + db * rsb) * w4 + 2.f * b4 + (bna + bnb) * v;
#pragma unroll
        for (int j = 0; j < 4; ++j) res[j] *= g[j] * sigmoidf_(g[j]);
        st_bf4(Y1 + (size_t)row * 2048 + c, res);
    }
}

#define XB_TMO      128
#define XB_XCNT(j)  (256  + 64 * (j))
#define XB_XSUB(j)  (1280 + 64 * (j))
#define XB_XGEN(j)  (2304 + 64 * (j))
#define XB_TOP      3328
#define XB_TOPGEN   3392
#define XCD_BAR_WORDS 3456
#define XB_SPIN_CAP (1u << 18)
DI unsigned xb_ld(unsigned* p)              { return __hip_atomic_load(p, __ATOMIC_RELAXED, __HIP_MEMORY_SCOPE_AGENT); }
DI unsigned xb_add(unsigned* p, unsigned v) { return __hip_atomic_fetch_add(p, v, __ATOMIC_RELAXED, __HIP_MEMORY_SCOPE_AGENT); }
DI unsigned xb_xcc_id() { return (unsigned)__builtin_amdgcn_s_getreg((3 << 11) | 20) & 0xFu; }
#define XB_SPIN(cond, bar) do { unsigned _sp = 0; while (cond) { __builtin_amdgcn_s_sleep(1); \
    if ((++_sp & 255u) == 0u) { if (xb_ld(&(bar)[XB_TMO])) break; if (_sp > XB_SPIN_CAP) { atomicAdd(&(bar)[XB_TMO], 1u); break; } } } } while (0)
struct XcdBarrier { unsigned* bar; unsigned x; volatile LAS unsigned* st; };
DI int ltid_(int wv) { return (wv << 6) | (int)__builtin_amdgcn_mbcnt_hi(~0u, __builtin_amdgcn_mbcnt_lo(~0u, 0u)); }
DI XcdBarrier xcd_barrier_post(unsigned* bar, volatile LAS unsigned* st, const int wv__) {
    XcdBarrier b; b.bar = bar; b.x = xb_xcc_id(); b.st = st;
    if (otid() == 0) (void)xb_add(&bar[XB_XCNT(b.x)], 1u);
    return b;
}
DI void xcd_barrier_complete(unsigned* bar, unsigned x, unsigned& nloc, unsigned& nx) {
    const unsigned G = gridDim.x * gridDim.y * gridDim.z;
    unsigned sum, cnt, mine, sp = 0u;
    for (;;) {
        sum = 0u; cnt = 0u; mine = 0u;
#pragma unroll
        for (unsigned j = 0; j < 16; ++j) { const unsigned c = xb_ld(&bar[XB_XCNT(j)]); sum += c; cnt += (c > 0u) ? 1u : 0u; mine = (j == x) ? c : mine; }
        if (sum == G) break;
        __builtin_amdgcn_s_sleep(1);
        if ((++sp & 255u) == 0u) { if (xb_ld(&bar[XB_TMO])) break; if (sp > XB_SPIN_CAP) { atomicAdd(&bar[XB_TMO], 1u); break; } }
    }
    nloc = mine > 0u ? mine : 1u; nx = cnt > 0u ? cnt : 1u;
}
DI void xcd_barrier(const XcdBarrier& b, const int wv__) {
    asm volatile("s_waitcnt vmcnt(0)" ::: "memory");
    __syncthreads();
    if (otid() == 0) {
        unsigned* bar = b.bar;
        __builtin_amdgcn_s_waitcnt(0);
        unsigned nloc = b.st[0], nx = b.st[1];
        if (nloc == 0u) { xcd_barrier_complete(bar, b.x, nloc, nx); b.st[0] = nloc; b.st[1] = nx; }
        const unsigned old = xb_add(&bar[XB_XSUB(b.x)], 1u);
        const unsigned gen = old / nloc;
        if (old + 1u == (gen + 1u) * nloc) {
            __builtin_amdgcn_fence(__ATOMIC_RELEASE, "agent");
            asm volatile("s_waitcnt vmcnt(0)" ::: "memory");
            const unsigned og = xb_add(&bar[XB_TOP], 1u);
            const unsigned tg = og / nx;
            if (og + 1u == (tg + 1u) * nx) xb_add(&bar[XB_TOPGEN], 1u);
            else XB_SPIN(xb_ld(&bar[XB_TOPGEN]) == tg, bar);
            __builtin_amdgcn_fence(__ATOMIC_ACQUIRE, "agent");
            xb_add(&bar[XB_XGEN(b.x)], 1u);
            asm volatile("s_waitcnt vmcnt(0)" ::: "memory");
        } else {
            XB_SPIN(xb_ld(&bar[XB_XGEN(b.x)]) == gen, bar);
            __builtin_amdgcn_fence(__ATOMIC_ACQUIRE, "agent");
            asm volatile("s_waitcnt vmcnt(0)" ::: "memory");
        }
    }
    __syncthreads();
}

constexpr int NPHASE = 15;
#ifndef PHASE_MASK
#define PHASE_MASK 0x7fff
#endif
#ifndef PH_ORDER
#define PH_ORDER 0xEDCBA9876543210ull
#define PH_COUNT 15
#endif
#define PH_ON(n) (((PHASE_MASK) >> (n)) & 1)
__global__ void __launch_bounds__(NTHREADS) mega(KArgs ka, int ph_lo, int ph_hi) {
    cg::grid_group grid = cg::this_grid();
    const int wv__ = __builtin_amdgcn_readfirstlane((int)(threadIdx.x >> 6));
    LAS unsigned char* lds = (LAS unsigned char*)dyn_lds;
    __shared__ uint4 xb_words;
    if (otid() == 0) xb_words = make_uint4(0u, 0u, 0u, 0u);
    XcdBarrier xb; xb.bar = nullptr; xb.x = 0u; xb.st = (volatile LAS unsigned*)&xb_words;
    typedef void* vptr_t;
    const __attribute__((address_space(4))) vptr_t* kat = (const __attribute__((address_space(4))) vptr_t*)__builtin_amdgcn_kernarg_segment_ptr();
    for (int si = ph_lo; si < ph_hi; ++si) {
        const int ph = (int)((PH_ORDER >> (4 * si)) & 15ull);
        if (si == ph_lo) {
            unsigned* bar = (unsigned*)((unsigned char*)kat[35] + OFF_BAR);
            if (blockIdx.x == 0) { const int t0 = otid();
#pragma unroll 1
                for (int i = t0; i < XCD_BAR_WORDS; i += NTHREADS) bar[i] = 0u; }
            __syncthreads();
        } else if (si == ph_lo + 1) {
            grid.sync();
            xb = xcd_barrier_post((unsigned*)((unsigned char*)kat[35] + OFF_BAR), (volatile LAS unsigned*)&xb_words, wv__);
        } else xcd_barrier(xb, wv__);
        int oz = 0; asm volatile("" : "+s"(oz));
        Params p;
        p.in[0] = (const float*)kat[0 + oz];
        p.in[1] = (const float*)kat[1 + oz];
        p.in[2] = (const float*)kat[2 + oz];
        p.in[3] = (const float*)kat[3 + oz];
        p.in[4] = (const float*)kat[4 + oz];
        p.in[5] = (const float*)kat[5 + oz];
        p.in[6] = (const float*)kat[6 + oz];
        p.in[7] = (const float*)kat[7 + oz];
        p.in[8] = (const float*)kat[8 + oz];
        p.in[9] = (const float*)kat[9 + oz];
        p.in[10] = (const float*)kat[10 + oz];
        p.in[11] = (const float*)kat[11 + oz];
        p.in[12] = (const float*)kat[12 + oz];
        p.in[13] = (const float*)kat[13 + oz];
        p.in[14] = (const float*)kat[14 + oz];
        p.in[15] = (const float*)kat[15 + oz];
        p.in[16] = (const float*)kat[16 + oz];
        p.in[17] = (const float*)kat[17 + oz];
        p.in[18] = (const float*)kat[18 + oz];
        p.in[19] = (const float*)kat[19 + oz];
        p.in[20] = (const float*)kat[20 + oz];
        p.in[21] = (const float*)kat[21 + oz];
        p.in[22] = (const float*)kat[22 + oz];
        p.in[23] = (const float*)kat[23 + oz];
        p.in[24] = (const float*)kat[24 + oz];
        p.in[25] = (const float*)kat[25 + oz];
        p.in[26] = (const float*)kat[26 + oz];
        p.in[27] = (const float*)kat[27 + oz];
        p.in[28] = (const float*)kat[28 + oz];
        p.in[29] = (const float*)kat[29 + oz];
        p.in[30] = (const float*)kat[30 + oz];
        p.in[31] = (const float*)kat[31 + oz];
        p.in[32] = (const float*)kat[32 + oz];
        p.in[33] = (const float*)kat[33 + oz];
        p.out = (float*)kat[34 + oz]; p.ws = (unsigned char*)kat[35 + oz];
        unsigned char* ws = p.ws;
        float* mod = (float*)(ws + OFF_MOD);
        const f32x2* rope = (const f32x2*)(ws + OFF_ROPE);
        switch (ph) {
        case 0: if (PH_ON(0)) prep_phase(p, lds, wv__); break;
        case 1: if (PH_ON(1)) norm_mod_phase(p.in[0], p.in[1], p.in[12], mod, (bf16_t*)(ws + OFF_H), wv__); break;
        case 2: if (PH_ON(2)) {
            Epi0 e; e.QD = (bf16_t*)(ws + OFF_QD); e.KD = (bf16_t*)(ws + OFF_KD); e.VD = (bf16_t*)(ws + OFF_VD); e.CQR = (bf16_t*)(ws + OFF_CQR); e.KPE = (bf16_t*)(ws + OFF_KPE);
            e.SG = (bf16_t*)(ws + OFF_SG0); e.CKVR = (float*)(ws + OFF_CKVR); e.oak = p.out + OUT_AK; e.oav = p.out + OUT_AV; e.okpe = p.out + OUT_KPE; e.rope = rope;
            gemm_phase(lds, (const bf16_t*)(ws + OFF_H), (const bf16_t*)(ws + OFF_WT0), 8192, 6144, 2048, e, wv__);
        } break;
        case 3: if (PH_ON(3)) lat_norm_phase(p, wv__); break;
        case 4: if (PH_ON(4)) {
            EpiQ eq; eq.QB = (bf16_t*)(ws + OFF_QB); eq.rope = rope;
            gemm_phase(lds, (const bf16_t*)(ws + OFF_CQN), (const bf16_t*)(ws + OFF_WUQ), 8192, 1536, 512, eq, wv__);
            EpiBf ek; ek.O = (bf16_t*)(ws + OFF_KVB); ek.ldc = 2048; ek.ncols = 2048;
            gemm_phase(lds, (const bf16_t*)(ws + OFF_CKVA), (const bf16_t*)(ws + OFF_WUKV), 10240, 2048, 256, ek, wv__);
        } break;
        case 5: if (PH_ON(5)) attn_phase(p, lds, wv__); break;
        case 6: if (PH_ON(6)) {
            EpiOut e; e.xp = p.in[0]; e.xs = p.in[1]; e.xo = p.out + OUT_Y; e.modg = mod + 4096;
            gemm_phase(lds, (const bf16_t*)(ws + OFF_H), (const bf16_t*)(ws + OFF_WOT0), 8192, 2048, 2048, e, wv__);
        } break;
        case 7: if (PH_ON(7)) norm_mod_phase(p.out + OUT_Y, p.out + OUT_Y + (size_t)4096 * 2048, p.in[12] + 2048, mod + 5 * 6144, (bf16_t*)(ws + OFF_H), wv__); break;
        case 8: if (PH_ON(8)) {
            EpiBf e; e.O = (bf16_t*)(ws + OFF_C); e.ldc = 8576; e.ncols = 8192;
            gemm_phase(lds, (const bf16_t*)(ws + OFF_H), (const bf16_t*)(ws + OFF_WT1), 8192, 8192, 2048, e, wv__);
            EpiBf e2; e2.O = (bf16_t*)(ws + OFF_PART); e2.ldc = 2048; e2.ncols = 2048;
            gemm_phase(lds, (const bf16_t*)(ws + OFF_H), (const bf16_t*)(ws + OFF_WT1) + (size_t)8192 * 2048, 8192, 512, 512, e2, wv__, 2048, 4);
        } break;
        case 9: if (PH_ON(9)) lora_in_phase(p, wv__); break;
        case 10: if (PH_ON(10)) {
#pragma unroll 1
            for (int z = 0; z < 2; ++z) {
                EpiDecay ew; ew.O = (bf16_t*)(ws + OFF_EZ) + (size_t)z * 8192 * 2048; ew.bias = p.in[25] + z * 2048; ew.rev = z;
                gemm_phase(lds, (const bf16_t*)(ws + OFF_WDT) + (size_t)z * 8192 * 128, (const bf16_t*)(ws + OFF_W2T) + (size_t)z * 2048 * 128, 8192, 2048, 128, ew, wv__);
                EpiLora ea; ea.O = (bf16_t*)(ws + OFF_AZ) + (size_t)z * 8192 * 2048; ea.bias = p.in[27] + z * 2048; ea.mul = 1.f;
                gemm_phase(lds, (const bf16_t*)(ws + OFF_ADT) + (size_t)z * 8192 * 128, (const bf16_t*)(ws + OFF_A2T) + (size_t)z * 2048 * 128, 8192, 2048, 128, ea, wv__);
            }
        } break;
        case 11: if (PH_ON(11)) scan_phase(p, lds, wv__); break;
        case 12: if (PH_ON(12)) post_phase(p, wv__); break;
        case 13: if (PH_ON(13)) {
            EpiGate e; e.O = (bf16_t*)(ws + OFF_C); e.modg = mod + 5 * 6144 + 4096;
            gemm_phase(lds, (const bf16_t*)(ws + OFF_H), (const bf16_t*)(ws + OFF_WOT1), 8192, 2048, 2048, e, wv__);
        } break;
        case 14: if (PH_ON(14)) final_norm_phase(p.out + OUT_Y, (const bf16_t*)(ws + OFF_C), p.in[13], wv__); break;
        }
    }
}

extern "C" void kernel_launch(void* const* d_in, const int* in_sizes, int n_in, void* d_out, int out_size, void* d_ws, size_t ws_size, hipStream_t stream) {
    static int grid_blocks = 0;
    if (!grid_blocks) {
        hipFuncSetAttribute((const void*)mega, hipFuncAttributeMaxDynamicSharedMemorySize, LDS_BYTES);
        int dev = 0, cus = 0, per_cu = 0;
        hipGetDevice(&dev);
        hipDeviceGetAttribute(&cus, hipDeviceAttributeMultiprocessorCount, dev);
        hipOccupancyMaxActiveBlocksPerMultiprocessor(&per_cu, mega, NTHREADS, LDS_BYTES);
        if (per_cu < 1) per_cu = 1;
        grid_blocks = cus * per_cu;
        if (grid_blocks > 256) grid_blocks = 256;
    }
    KArgs p{};
    for (int i = 0; i < 34; ++i) p.a[i] = d_in[i];
    p.a[34] = d_out;
    p.a[35] = d_ws;
    int lo = 0, hi = PH_COUNT;
    void* args[] = {&p, &lo, &hi};
    hipError_t e = hipLaunchCooperativeKernel((const void*)mega, dim3(grid_blocks), dim3(NTHREADS), args, LDS_BYTES, stream);
    if (e != hipSuccess) fprintf(stderr, "cooperative launch failed: %s (grid %d, ws %zu need %zu)\n", hipGetErrorString(e), grid_blocks, ws_size, (size_t)WS_NEEDED);
}
```

```cpp
#include <hip/hip_runtime.h>
#include <hip/hip_cooperative_groups.h>
#include <cstdio>
namespace cg = cooperative_groups;

#define DI __device__ __forceinline__
#define LAS __attribute__((address_space(3)))
typedef unsigned short bf16_t;
typedef short bf16x8 __attribute__((ext_vector_type(8)));
typedef short s16x4 __attribute__((ext_vector_type(4)));
typedef float f32x4 __attribute__((ext_vector_type(4)));
typedef float f32x2 __attribute__((ext_vector_type(2)));
typedef unsigned u32x4 __attribute__((ext_vector_type(4)));
typedef unsigned u32x2 __attribute__((ext_vector_type(2)));
typedef __bf16 nbf2 __attribute__((ext_vector_type(2)));

extern __shared__ __attribute__((aligned(16))) unsigned char dyn_lds[];
constexpr int LDS_BYTES = 131072;
constexpr int NTHREADS = 512;

constexpr size_t SZ_H    = (size_t)8192 * 2048 * 2;
constexpr size_t OFF_WOT1 = 0;
constexpr size_t OFF_WT0  = OFF_WOT1 + (size_t)2048 * 2048 * 2;
constexpr size_t OFF_WT1  = OFF_WT0 + (size_t)6144 * 2048 * 2;
constexpr size_t OFF_WOT0 = OFF_WT1 + (size_t)8704 * 2048 * 2;
constexpr size_t OFF_WUQ  = OFF_WOT0 + (size_t)2048 * 2048 * 2;
constexpr size_t OFF_WUKV = OFF_WUQ + (size_t)1536 * 512 * 2;
constexpr size_t OFF_W2T  = OFF_WUKV + (size_t)2048 * 256 * 2;
constexpr size_t OFF_A2T  = OFF_W2T + (size_t)2 * 2048 * 128 * 2;
constexpr size_t END_W    = OFF_A2T + (size_t)2 * 2048 * 128 * 2;
constexpr size_t OFF_YZ   = OFF_WT0;
static_assert(OFF_YZ + 2 * SZ_H <= END_W, "yz alias");
constexpr size_t OFF_MOD  = END_W;
constexpr size_t OFF_ROPE = OFF_MOD + (size_t)2 * 5 * 6144 * 4;
constexpr size_t OFF_BN   = OFF_ROPE + 64 * 16 * 8;
constexpr size_t OFF_H    = OFF_BN + (size_t)2 * 8192 * 32 * 4;
constexpr size_t OFF_C    = OFF_H + SZ_H;
constexpr size_t SZ_C     = (size_t)8192 * 8576 * 2;
constexpr size_t OFF_QD   = OFF_C;
constexpr size_t OFF_KD   = OFF_QD + (size_t)8192 * 1024 * 2;
constexpr size_t OFF_VD   = OFF_KD + (size_t)10240 * 1024 * 2;
constexpr size_t OFF_CQR  = OFF_VD + (size_t)10240 * 1024 * 2;
constexpr size_t OFF_CKVR = OFF_CQR + (size_t)8192 * 512 * 2;
constexpr size_t OFF_KPE  = OFF_CKVR + (size_t)8192 * 256 * 4;
constexpr size_t OFF_SG0  = OFF_KPE + (size_t)10240 * 64 * 2;
static_assert(OFF_SG0 + SZ_H <= OFF_C + SZ_C, "region C");
constexpr size_t OFF_E    = OFF_C + SZ_C;
constexpr size_t OFF_PART = OFF_E;
constexpr size_t OFF_AZ   = OFF_E;
constexpr size_t OFF_EZ   = OFF_E + 2 * SZ_H;
constexpr size_t SZ_E     = 4 * SZ_H;
constexpr size_t OFF_CQN  = OFF_E;
constexpr size_t OFF_CKVA = OFF_CQN + (size_t)8192 * 512 * 2;
constexpr size_t OFF_QB   = OFF_CKVA + (size_t)10240 * 256 * 2;
constexpr size_t OFF_KVB  = OFF_QB + (size_t)8192 * 1536 * 2;
static_assert(OFF_KVB + (size_t)10240 * 2048 * 2 <= OFF_E + SZ_E, "region E");
constexpr size_t OFF_BAR = OFF_E + SZ_E;
constexpr size_t WS_NEEDED = OFF_BAR + 16384;
constexpr size_t OFF_WDT = OFF_H;
constexpr size_t OFF_ADT = OFF_H + (size_t)2 * 8192 * 128 * 2;

constexpr size_t OUT_Y = 0, OUT_AK = 16777216, OUT_AV = 20971520, OUT_CKV = 25165824, OUT_KPE = 26214400, OUT_SF = 26476544, OUT_SB = 28573696;

struct Params {
    const float* in[34];
    float* out;
    unsigned char* ws;
};
struct KArgs { const void* a[36]; };

DI unsigned pk2(float a, float b) { f32x2 v = {a, b}; nbf2 r = __builtin_convertvector(v, nbf2); return __builtin_bit_cast(unsigned, r); }
DI float bflo(unsigned u) { return __uint_as_float(u << 16); }
DI float bfhi(unsigned u) { return __uint_as_float(u & 0xffff0000u); }
DI void st_bf4(bf16_t* p, f32x4 v) { u32x2 r = {pk2(v[0], v[1]), pk2(v[2], v[3])}; *(u32x2*)p = r; }
DI void st_f4(float* p, f32x4 v) { *(f32x4*)p = v; }
DI void st_f4_nt(float* p, f32x4 v) { __builtin_nontemporal_store(v, (f32x4*)p); }
DI f32x4 ld_f4(const float* p) { return *(const f32x4*)p; }
DI f32x4 ld_f4_nt(const float* p) { return __builtin_nontemporal_load((const f32x4*)p); }
DI f32x4 bf4_to_f4(u32x2 u) { f32x4 r = {bflo(u[0]), bfhi(u[0]), bflo(u[1]), bfhi(u[1])}; return r; }
DI float dpp_xor1(float x) { return __int_as_float(__builtin_amdgcn_mov_dpp(__float_as_int(x), 0xB1, 0xF, 0xF, true)); }
DI float dpp_xor2(float x) { return __int_as_float(__builtin_amdgcn_mov_dpp(__float_as_int(x), 0x4E, 0xF, 0xF, true)); }
DI float dpp_hmirror(float x) { return __int_as_float(__builtin_amdgcn_mov_dpp(__float_as_int(x), 0x141, 0xF, 0xF, true)); }
DI float dpp_mirror(float x) { return __int_as_float(__builtin_amdgcn_mov_dpp(__float_as_int(x), 0x140, 0xF, 0xF, true)); }
DI float shx(float x, int m, int lane) { return __int_as_float(__builtin_amdgcn_ds_bpermute((lane ^ m) << 2, __float_as_int(x))); }
DI float wave_sum(float x, int lane) {
    x += dpp_xor1(x); x += dpp_xor2(x); x += dpp_hmirror(x); x += dpp_mirror(x); x += shx(x, 16, lane); x += shx(x, 32, lane); return x;
}
DI float sum16d(float x) { x += dpp_xor1(x); x += dpp_xor2(x); x += dpp_hmirror(x); x += dpp_mirror(x); return x; }
DI float sigmoidf_(float x) { return __builtin_amdgcn_rcpf(1.f + __expf(-x)); }
DI int otid_(int wv) { int l; asm volatile("v_mbcnt_lo_u32_b32 %0, -1, 0\n\tv_mbcnt_hi_u32_b32 %0, -1, %0" : "=v"(l)); return (wv << 6) | l; }
#define otid() otid_(wv__)
DI int kvrow_of(int row) { return row < 4096 ? row : 4096 + ((row - 4096) >> 10) * 1536 + ((row - 4096) & 1023); }
DI int cond_of(int row) { return row < 4096 ? 0 : 1 + ((row - 4096) >> 10); }

constexpr int HTB = 128 * 64 * 2;
DI int lds_byte(int r, int c) { const int st = (r >> 4) * 2 + (c >> 5), rr = r & 15, cc = c & 31, ob = rr * 64 + cc * 2; return st * 1024 + (ob ^ (((ob >> 9) & 1) << 5)); }
DI void stage_rc(int b, int& R, int& C) { const int st = b / 1024, sb = b % 1024, swz = sb ^ (((sb >> 9) & 1) << 5); R = (st >> 1) * 16 + swz / 64; C = (st & 1) * 32 + (swz % 64) / 2; }

#define G_SA(b, h) (((b) * 2 + (h)) * HTB)
#define G_SB(b, h) ((4 + (b) * 2 + (h)) * HTB)
#define G_STAGE(bufoff, gbase) do { _Pragma("unroll") for (int _i = 0; _i < 2; ++_i) \
    __builtin_amdgcn_global_load_lds((const unsigned*)((const char*)(gbase) + voff[_i]), (LAS unsigned*)(lds + (bufoff) + ldsw + _i * 8192), 16, 0, 0); } while (0)
#define G_LDA(dst, b, h) do { _Pragma("unroll") for (int m = 0; m < 4; ++m) _Pragma("unroll") for (int k = 0; k < 2; ++k) dst[m][k] = *(const LAS bf16x8*)(lds + G_SA(b, h) + aoff + m * 2048 + k * 1024); } while (0)
#define G_LDB(dst, b, h) do { _Pragma("unroll") for (int n = 0; n < 2; ++n) _Pragma("unroll") for (int k = 0; k < 2; ++k) dst[n][k] = *(const LAS bf16x8*)(lds + G_SB(b, h) + boff + n * 2048 + k * 1024); } while (0)
#define G_MMA(ai, bj, At_, Bt_) do { __builtin_amdgcn_s_setprio(1); _Pragma("unroll") for (int m = 0; m < 4; ++m) _Pragma("unroll") for (int n = 0; n < 2; ++n) _Pragma("unroll") for (int k = 0; k < 2; ++k) \
    acc[ai][bj][m][n] = __builtin_amdgcn_mfma_f32_16x16x32_bf16(Bt_[n][k], At_[m][k], acc[ai][bj][m][n], 0, 0, 0); __builtin_amdgcn_s_setprio(0); } while (0)
#define G_WAIT_V(n) asm volatile("s_waitcnt vmcnt(" #n ")" ::: "memory")
#define G_WAIT_L(n) asm volatile("s_waitcnt lgkmcnt(" #n ")" ::: "memory")
#define G_BAR __builtin_amdgcn_s_barrier()
#define G_SCHED __builtin_amdgcn_sched_barrier(0)

template <class Epi>
DI void gemm_phase(LAS unsigned char* lds, const bf16_t* A, const bf16_t* Bt, int M, int N, int K, const Epi& E, const int wv__, int pitch = 0, int nsplit = 1) {
    if (pitch == 0) pitch = K;
    const int tid = otid(), wid = __builtin_amdgcn_readfirstlane(tid >> 6), lane = tid & 63, wr = wid >> 2, wc = wid & 3, fr = lane & 15, fq = lane >> 4;
    const int nt = K / 64, nM = M / 256, nN = N / 256, ntiles = nM * nN * nsplit;
    unsigned voff[2];
#pragma unroll
    for (int i = 0; i < 2; ++i) { int R, C; stage_rc(tid * 16 + i * 8192, R, C); voff[i] = (unsigned)(R * pitch + C) * 2u; }
    const size_t kstep = 128, hstep = (size_t)128 * pitch * 2;
    const unsigned ldsw = (unsigned)wid * 1024u;
    const int aoff = lds_byte(wr * 64 + fr, fq * 8), boff = lds_byte(wc * 32 + fr, fq * 8);
    int tile = blockIdx.x;
    if (tile >= ntiles) return;
    const char* cA; const char* cB; int pm, pnq;
#define G_TILE_PTRS(tl) do { const int ks_ = (tl) % nsplit, t2_ = (tl) / nsplit; pm = t2_ % nM; const int pn_ = t2_ / nM; pnq = pn_ + ks_ * nN; \
        cA = (const char*)A + (size_t)pm * 2 * hstep + (size_t)ks_ * K * 2; cB = (const char*)Bt + (size_t)pn_ * 2 * hstep + (size_t)ks_ * K * 2; } while (0)
    G_TILE_PTRS(tile);
    G_STAGE(G_SB(0, 0), cB); G_STAGE(G_SA(0, 0), cA); G_STAGE(G_SB(0, 1), cB + hstep); G_STAGE(G_SA(0, 1), cA + hstep);
    for (;;) {
        const int pm_cur = pm, pnq_cur = pnq;
        f32x4 acc[2][2][4][2];
#pragma unroll
        for (int a = 0; a < 2; ++a)
#pragma unroll
            for (int b = 0; b < 2; ++b)
#pragma unroll
                for (int m = 0; m < 4; ++m)
#pragma unroll
                    for (int n = 0; n < 2; ++n) acc[a][b][m][n] = (f32x4){0.f, 0.f, 0.f, 0.f};
        bf16x8 At[4][2], B0[2][2], B1[2][2];
        if (wr == 1) G_BAR;
        G_WAIT_V(4); G_BAR;
        G_STAGE(G_SB(1, 0), cB + kstep); G_STAGE(G_SA(1, 0), cA + kstep); G_STAGE(G_SB(1, 1), cB + hstep + kstep);
        G_WAIT_V(6); G_BAR;
        for (int t = 0; t < nt - 2; t += 2) {
            const char* a1 = cA + (size_t)(t + 1) * kstep;
            const char* a2 = cA + (size_t)(t + 2) * kstep; const char* b2 = cB + (size_t)(t + 2) * kstep;
            const char* a3 = a2 + kstep; const char* b3 = b2 + kstep;
            G_LDB(B0, 0, 0); G_SCHED; G_LDA(At, 0, 0); G_STAGE(G_SA(1, 1), a1 + hstep);
            G_WAIT_L(8); G_BAR; G_WAIT_L(0); G_MMA(0, 0, At, B0); G_BAR; G_SCHED;
            G_LDB(B1, 0, 1); G_STAGE(G_SB(0, 0), b2);
            G_BAR; G_WAIT_L(0); G_MMA(0, 1, At, B1); G_BAR;
            G_LDA(At, 0, 1); G_STAGE(G_SA(0, 0), a2);
            G_BAR; G_WAIT_L(0); G_MMA(1, 0, At, B0); G_BAR; G_SCHED;
            G_STAGE(G_SB(0, 1), b2 + hstep);
            G_WAIT_V(6); G_BAR; G_MMA(1, 1, At, B1); G_BAR;
            G_LDB(B0, 1, 0); G_SCHED; G_LDA(At, 1, 0); G_STAGE(G_SA(0, 1), a2 + hstep);
            G_WAIT_L(8); G_BAR; G_WAIT_L(0); G_MMA(0, 0, At, B0); G_BAR; G_SCHED;
            G_LDB(B1, 1, 1); G_STAGE(G_SB(1, 0), b3);
            G_BAR; G_WAIT_L(0); G_MMA(0, 1, At, B1); G_BAR;
            G_LDA(At, 1, 1); G_STAGE(G_SA(1, 0), a3);
            G_BAR; G_WAIT_L(0); G_MMA(1, 0, At, B0); G_BAR; G_SCHED;
            G_STAGE(G_SB(1, 1), b3 + hstep);
            G_WAIT_V(6); G_BAR; G_MMA(1, 1, At, B1); G_BAR;
        }
        {
            const char* a1 = cA + (size_t)(nt - 1) * kstep;
            G_LDB(B0, 0, 0); G_LDA(At, 0, 0); G_STAGE(G_SA(1, 1), a1 + hstep);
            G_BAR; G_WAIT_L(0); G_MMA(0, 0, At, B0); G_BAR;
            G_LDB(B1, 0, 1); G_BAR; G_WAIT_L(0); G_MMA(0, 1, At, B1); G_BAR;
            G_LDA(At, 0, 1); G_WAIT_V(4); G_BAR; G_WAIT_L(0); G_MMA(1, 0, At, B0); G_MMA(1, 1, At, B1); G_BAR;
        }
        {
            G_LDB(B0, 1, 0); G_LDA(At, 1, 0); G_WAIT_V(2); G_BAR; G_WAIT_L(0); G_MMA(0, 0, At, B0); G_BAR;
            G_LDB(B1, 1, 1); G_WAIT_V(0); G_BAR; G_WAIT_L(0); G_MMA(0, 1, At, B1); G_BAR;
            G_LDA(At, 1, 1); G_BAR; G_WAIT_L(0); G_MMA(1, 0, At, B0); G_MMA(1, 1, At, B1); G_BAR;
        }
        if (wr == 0) G_BAR;
        const int next = tile + (int)gridDim.x;
        if (next < ntiles) { G_TILE_PTRS(next); G_STAGE(G_SB(0, 0), cB); G_STAGE(G_SA(0, 0), cA); G_STAGE(G_SB(0, 1), cB + hstep); G_STAGE(G_SA(0, 1), cA + hstep); }
        E.run(acc, pm_cur, pnq_cur, wr, wc, fr, fq);
        if (next >= ntiles) break;
        tile = next;
    }
#undef G_TILE_PTRS
}

typedef f32x4 acc_t[2][2][4][2];
#define EPI_LOOP(...) _Pragma("unroll") for (int ai = 0; ai < 2; ++ai) _Pragma("unroll") for (int m = 0; m < 4; ++m) { const int row = pm * 256 + ai * 128 + wr * 64 + m * 16 + fr; \
    _Pragma("unroll") for (int bj = 0; bj < 2; ++bj) { const int col0 = pn * 256 + bj * 128 + wc * 32 + fq * 4; f32x4 v0 = acc[ai][bj][m][0], v1 = acc[ai][bj][m][1]; __VA_ARGS__ } }
struct RopeRegs { float fr[4]; };
DI void rope_preload(RopeRegs& R, int fq) {
#pragma unroll
    for (int j = 0; j < 4; ++j) R.fr[j] = __builtin_amdgcn_exp2f(-(float)(fq * 4 + j) * (13.287712379549449f / 16.f)) * 0.15915494309189535f;
}
DI void rope_rot(const RopeRegs& R, int pos, f32x4& a, f32x4& b) {
    const float pf = (float)pos;
#pragma unroll
    for (int j = 0; j < 4; ++j) {
        const float rev = pf * R.fr[j];
        const float c = __builtin_amdgcn_cosf(rev), sn = __builtin_amdgcn_sinf(rev);
        const float x1 = a[j], x2 = b[j]; a[j] = x1 * c - x2 * sn; b[j] = x1 * sn + x2 * c;
    }
}
struct Epi0 {
    bf16_t *QD, *KD, *VD, *CQR, *KPE, *SG; float *CKVR, *oak, *oav, *okpe; const f32x2* rope;
    DI void run(const acc_t& acc, int pm, int pn, int wr, int wc, int fr, int fq) const {
        const bool samp = pm >= 16;
        const int cb = pn * 256;
        const bool ropey = samp && (cb < 2048 || cb == 3840);
        RopeRegs RR; rope_preload(RR, fq); (void)ropey;
        const int prow0 = (((pm * 256) & 1023) >> 6) + wr;
        EPI_LOOP(
            const int kvr = kvrow_of(row);
            if (col0 < 2048 || (col0 >= 3840 && col0 < 3904)) {
                f32x4 r0 = v0, r1 = v1;
                if (samp) rope_rot(RR, ((col0 >> 5) & 1) ? (m * 16 + fr) : (prow0 + 2 * ai), r0, r1);
                if (col0 < 1024) { bf16_t* q = QD + (size_t)row * 1024 + col0; st_bf4(q, r0); st_bf4(q + 16, r1); }
                else if (col0 < 2048) {
                    const int c = col0 - 1024; bf16_t* q = KD + (size_t)kvr * 1024 + c; st_bf4(q, r0); st_bf4(q + 16, r1);
                    if (!samp) { float* o = oak + (size_t)row * 1024 + c; st_f4_nt(o, v0); st_f4_nt(o + 16, v1); }
                } else {
                    const int c = col0 - 3840; bf16_t* q = KPE + (size_t)kvr * 64 + c; st_bf4(q, r0); st_bf4(q + 16, r1);
                    if (!samp) { float* o = okpe + (size_t)row * 64 + c; st_f4_nt(o, v0); st_f4_nt(o + 16, v1); }
                }
            } else if (col0 < 3072) {
                const int c = col0 - 2048; bf16_t* q = VD + (size_t)kvr * 1024 + c; st_bf4(q, v0); st_bf4(q + 16, v1);
                if (!samp) { float* o = oav + (size_t)row * 1024 + c; st_f4_nt(o, v0); st_f4_nt(o + 16, v1); }
            } else if (col0 < 3584) {
                bf16_t* q = CQR + (size_t)row * 512 + (col0 - 3072); st_bf4(q, v0); st_bf4(q + 16, v1);
            } else if (col0 < 3840) {
                float* o = CKVR + (size_t)row * 256 + (col0 - 3584); st_f4(o, v0); st_f4(o + 16, v1);
            } else if (col0 < 5952) {
                f32x4 s0, s1;
                _Pragma("unroll") for (int j = 0; j < 4; ++j) { s0[j] = v0[j] * sigmoidf_(v0[j]); s1[j] = v1[j] * sigmoidf_(v1[j]); }
                bf16_t* q = SG + (size_t)row * 2048 + (col0 - 3904); st_bf4(q, s0); st_bf4(q + 16, s1);
            }
        )
    }
};
struct EpiQ {
    bf16_t* QB; const f32x2* rope;
    DI void run(const acc_t& acc, int pm, int pn, int wr, int wc, int fr, int fq) const {
        const bool samp = pm >= 16;
        RopeRegs RR; rope_preload(RR, fq);
        const int prow0 = (((pm * 256) & 1023) >> 6) + wr;
        EPI_LOOP(
            const int hh = col0 / 192; const int w = col0 - hh * 192;
            if (samp && w >= 128) rope_rot(RR, (((w - 128) >> 5) & 1) ? (m * 16 + fr) : (prow0 + 2 * ai), v0, v1);
            bf16_t* q = QB + (size_t)row * 1536 + col0; st_bf4(q, v0); st_bf4(q + 16, v1);
        )
    }
};
struct EpiBf {
    bf16_t* O; int ldc; int ncols;
    DI void run(const acc_t& acc, int pm, int pn, int wr, int wc, int fr, int fq) const {
        EPI_LOOP(
            if (col0 < ncols) { bf16_t* q = O + (size_t)row * ldc + col0; st_bf4(q, v0); st_bf4(q + 16, v1); }
        )
    }
};
struct EpiOut {
    const float* xp; const float* xs; float* xo; const float* modg;
    DI void run(const acc_t& acc, int pm, int pn, int wr, int wc, int fr, int fq) const {
        const int brow = pm * 256, cbase = pn * 256 + wc * 32 + fq * 4;
        const float* g = modg + cond_of(brow) * 6144 + cbase;
        f32x4 gg[2][2];
#pragma unroll
        for (int bj = 0; bj < 2; ++bj) { gg[bj][0] = ld_f4(g + bj * 128); gg[bj][1] = ld_f4(g + bj * 128 + 16); }
        const float* xi = (brow < 4096 ? xp + (size_t)brow * 2048 : xs + (size_t)(brow - 4096) * 2048) + (size_t)(wr * 64 + fr) * 2048 + cbase;
        float* xob = xo + (size_t)(brow + wr * 64 + fr) * 2048 + cbase;
        f32x4 xv[4][2][2][2];
#define EO_LOAD(b) _Pragma("unroll") for (int mm = 0; mm < 2; ++mm) _Pragma("unroll") for (int bj = 0; bj < 2; ++bj) { \
            const float* q = xi + (size_t)(((b) >> 1) * 128 + (((b) & 1) * 2 + mm) * 16) * 2048 + bj * 128; xv[b][mm][bj][0] = ld_f4(q); xv[b][mm][bj][1] = ld_f4(q + 16); }
#define EO_STORE(b) _Pragma("unroll") for (int mm = 0; mm < 2; ++mm) _Pragma("unroll") for (int bj = 0; bj < 2; ++bj) { \
            float* o = xob + (size_t)(((b) >> 1) * 128 + (((b) & 1) * 2 + mm) * 16) * 2048 + bj * 128; \
            st_f4(o, xv[b][mm][bj][0] + gg[bj][0] * acc[(b) >> 1][bj][((b) & 1) * 2 + mm][0]); st_f4(o + 16, xv[b][mm][bj][1] + gg[bj][1] * acc[(b) >> 1][bj][((b) & 1) * 2 + mm][1]); }
        EO_LOAD(0) EO_LOAD(1) EO_STORE(0) EO_LOAD(2) EO_STORE(1) EO_LOAD(3) EO_STORE(2) EO_STORE(3)
#undef EO_LOAD
#undef EO_STORE
    }
};
struct EpiGate {
    bf16_t* O; const float* modg;
    DI void run(const acc_t& acc, int pm, int pn, int wr, int wc, int fr, int fq) const {
        const float* g = modg + cond_of(pm * 256) * 6144 + pn * 256 + wc * 32 + fq * 4;
        f32x4 gg[2][2];
#pragma unroll
        for (int bj = 0; bj < 2; ++bj) { gg[bj][0] = ld_f4(g + bj * 128); gg[bj][1] = ld_f4(g + bj * 128 + 16); }
        EPI_LOOP(
            bf16_t* q = O + (size_t)row * 2048 + col0; st_bf4(q, gg[bj][0] * v0); st_bf4(q + 16, gg[bj][1] * v1);
        )
    }
};
typedef _Float16 h16x2 __attribute__((ext_vector_type(2)));
DI unsigned pkh2(float a, float b) { f32x2 v = {a, b}; h16x2 r = __builtin_convertvector(v, h16x2); return __builtin_bit_cast(unsigned, r); }
DI float h2f_(unsigned short h) { return (float)__builtin_bit_cast(_Float16, h); }
DI f32x4 h4_to_f4(u32x2 u) { const unsigned u0 = u[0], u1 = u[1]; f32x4 r = {h2f_((unsigned short)(u0 & 0xffffu)), h2f_((unsigned short)(u0 >> 16)), h2f_((unsigned short)(u1 & 0xffffu)), h2f_((unsigned short)(u1 >> 16))}; return r; }
template <int CTRL> DI float dpp_rowshift0(float x) { return __int_as_float(__builtin_amdgcn_update_dpp(0, __float_as_int(x), CTRL, 0xF, 0xF, true)); }
struct EpiDecay {
    bf16_t* O; const float* bias; int rev;
    DI void run(const acc_t& acc, int pm, int pn, int wr, int wc, int fr, int fq) const {
        const float* bp = bias + pn * 256 + wc * 32 + fq * 4;
        f32x4 bb[2][2];
#pragma unroll
        for (int bj = 0; bj < 2; ++bj) { bb[bj][0] = ld_f4(bp + bj * 128); bb[bj][1] = ld_f4(bp + bj * 128 + 16); }
        EPI_LOOP(
            f32x4 r0; f32x4 r1;
            _Pragma("unroll") for (int j = 0; j < 4; ++j) {
                float a = 0.6065306597126334f * sigmoidf_(bb[bj][0][j] + v0[j]); float b = 0.6065306597126334f * sigmoidf_(bb[bj][1][j] + v1[j]);
                if (rev) {
                    a += dpp_rowshift0<0x101>(a); a += dpp_rowshift0<0x102>(a); a += dpp_rowshift0<0x104>(a); a += dpp_rowshift0<0x108>(a);
                    b += dpp_rowshift0<0x101>(b); b += dpp_rowshift0<0x102>(b); b += dpp_rowshift0<0x104>(b); b += dpp_rowshift0<0x108>(b);
                } else {
                    a += dpp_rowshift0<0x111>(a); a += dpp_rowshift0<0x112>(a); a += dpp_rowshift0<0x114>(a); a += dpp_rowshift0<0x118>(a);
                    b += dpp_rowshift0<0x111>(b); b += dpp_rowshift0<0x112>(b); b += dpp_rowshift0<0x114>(b); b += dpp_rowshift0<0x118>(b);
                }
                r0[j] = a; r1[j] = b;
            }
            bf16_t* q = O + (size_t)row * 2048 + col0;
            { u32x2 u = {pkh2(r0[0], r0[1]), pkh2(r0[2], r0[3])}; *(u32x2*)q = u; }
            { u32x2 u = {pkh2(r1[0], r1[1]), pkh2(r1[2], r1[3])}; *(u32x2*)(q + 16) = u; }
        )
    }
};
struct EpiLora {
    bf16_t* O; const float* bias; float mul;
    DI void run(const acc_t& acc, int pm, int pn, int wr, int wc, int fr, int fq) const {
        const float* bp = bias + pn * 256 + wc * 32 + fq * 4;
        f32x4 bb[2][2];
#pragma unroll
        for (int bj = 0; bj < 2; ++bj) { bb[bj][0] = ld_f4(bp + bj * 128); bb[bj][1] = ld_f4(bp + bj * 128 + 16); }
        EPI_LOOP(
            f32x4 r0, r1;
            _Pragma("unroll") for (int j = 0; j < 4; ++j) { r0[j] = mul * sigmoidf_(bb[bj][0][j] + v0[j]); r1[j] = mul * sigmoidf_(bb[bj][1][j] + v1[j]); }
            bf16_t* q = O + (size_t)row * 2048 + col0; st_bf4(q, r0); st_bf4(q + 16, r1);
        )
    }
};

DI void transpose_tile(LAS float* tl, const float* src, int K, int N, bf16_t* dst, int Kpad, int kt, int ntile, const int wv__) {
    const int tid = otid(), k0 = kt * 64, n0 = ntile * 256;
    const int kr = tid >> 6, nc = (tid & 63) * 4;
    f32x4 v[8];
#pragma unroll
    for (int i = 0; i < 8; ++i) {
        const int k = k0 + kr + i * 8;
        v[i] = (f32x4){0.f, 0.f, 0.f, 0.f};
        if (k < K && n0 + nc < N) v[i] = ld_f4_nt(src + (size_t)k * N + n0 + nc);
    }
#pragma unroll
    for (int i = 0; i < 8; ++i) {
        LAS float* t = tl + (kr + i * 8) * 257 + nc;
        t[0] = v[i][0]; t[1] = v[i][1]; t[2] = v[i][2]; t[3] = v[i][3];
    }
    __syncthreads();
    const int kc = (tid & 7) * 8;
#pragma unroll
    for (int i = 0; i < 4; ++i) {
        const int n = (tid >> 3) + i * 64;
        float e[8];
#pragma unroll
        for (int j = 0; j < 8; ++j) e[j] = tl[(kc + j) * 257 + n];
        u32x4 o = {pk2(e[0], e[1]), pk2(e[2], e[3]), pk2(e[4], e[5]), pk2(e[6], e[7])};
        *(u32x4*)(dst + (size_t)(n0 + n) * Kpad + k0 + kc) = o;
    }
    __syncthreads();
}
DI void cvt_cache(const float* src, bf16_t* dst, int W, int item, const int wv__) {
    const size_t e = (size_t)item * 4096 + otid() * 8;
    const int srow = (int)(e / W), c = (int)(e % W);
    const int b = srow >> 9, s = srow & 511;
    const int drow = 4096 + b * 1536 + 1024 + s;
    const f32x4 a = ld_f4_nt(src + e), bb = ld_f4_nt(src + e + 4);
    u32x4 o = {pk2(a[0], a[1]), pk2(a[2], a[3]), pk2(bb[0], bb[1]), pk2(bb[2], bb[3])};
    *(u32x4*)(dst + (size_t)drow * W + c) = o;
}
DI void mod_job(const Params& p, LAS unsigned char* lds, int item, const int wv__) {
    LAS float* sl = (LAS float*)lds;
    LAS float* red = sl + 5 * 2048;
    const int tid = otid();
    const float* cc = p.in[8]; const float* cctx = p.in[9];
    for (int i = tid; i < 5 * 2048; i += NTHREADS) { const int cnd = i >> 11, k = i & 2047; const float c = cnd == 0 ? cctx[k] : cc[(cnd - 1) * 2048 + k]; sl[i] = c * sigmoidf_(c); }
    __syncthreads();
    const int l = item / 192, n0 = (item % 192) * 32;
    const int kg = tid >> 3, cl = (tid & 7) * 4;
    const float* W = p.in[10] + (size_t)l * 2048 * 6144 + n0 + cl;
    f32x4 acc[5];
#pragma unroll
    for (int c = 0; c < 5; ++c) acc[c] = (f32x4){0.f, 0.f, 0.f, 0.f};
#pragma unroll 8
    for (int pass = 0; pass < 32; ++pass) {
        const int k = pass * 64 + kg;
        const f32x4 w = ld_f4_nt(W + (size_t)k * 6144);
#pragma unroll
        for (int c = 0; c < 5; ++c) acc[c] += sl[c * 2048 + k] * w;
    }
#pragma unroll
    for (int c = 0; c < 5; ++c)
#pragma unroll
        for (int j = 0; j < 4; ++j) red[kg * 160 + c * 32 + cl + j] = acc[c][j];
    __syncthreads();
    if (tid < 160) {
        float s = 0.f;
        for (int g = 0; g < 64; ++g) s += red[g * 160 + tid];
        const int cnd = tid >> 5, c = tid & 31;
        float* mod = (float*)(p.ws + OFF_MOD);
        mod[(size_t)(l * 5 + cnd) * 6144 + n0 + c] = s + p.in[11][l * 6144 + n0 + c];
    }
    __syncthreads();
}
DI void prep_phase(const Params& p, LAS unsigned char* lds, const int wv__) {
    constexpr int J_MOD = 384;
    constexpr int J_T0 = 32 * 24, J_T1 = 32 * 34, J_TO = 32 * 8, J_TUQ = 8 * 6, J_TUKV = 4 * 8, J_TL = 2 * 8;
    constexpr int J_CK = 512, J_CV = 512, J_CC = 128, J_CP = 32;
    constexpr int TOTAL = J_MOD + J_T0 + J_T1 + 2 * J_TO + J_TUQ + J_TUKV + 4 * J_TL + J_CK + J_CV + J_CC + J_CP + 1;
    LAS float* tl = (LAS float*)lds;
    for (int job = blockIdx.x; job < TOTAL + 384; job += gridDim.x) {
        int j = job;
        if (gridDim.x == 256) {
            if (job >= 512 && job < 1280) { if ((job & 255) < 128) continue; j = job - (((job - 512) >> 8) * 128 + 128); }
            else if (job >= 1280) j = job - 384;
        } else if (job >= TOTAL) continue;
        if (j < J_MOD) { mod_job(p, lds, j, wv__); continue; } j -= J_MOD;
        if (j < J_T0) { transpose_tile(tl, p.in[14], 2048, 5952, (bf16_t*)(p.ws + OFF_WT0), 2048, j % 32, j / 32, wv__); continue; } j -= J_T0;
        if (j < J_T1) { transpose_tile(tl, p.in[22], 2048, 8576, (bf16_t*)(p.ws + OFF_WT1), 2048, j % 32, j / 32, wv__); continue; } j -= J_T1;
        if (j < J_TO) { transpose_tile(tl, p.in[15], 2048, 2048, (bf16_t*)(p.ws + OFF_WOT0), 2048, j % 32, j / 32, wv__); continue; } j -= J_TO;
        if (j < J_TO) { transpose_tile(tl, p.in[23], 2048, 2048, (bf16_t*)(p.ws + OFF_WOT1), 2048, j % 32, j / 32, wv__); continue; } j -= J_TO;
        if (j < J_TUQ) { transpose_tile(tl, p.in[19], 512, 1536, (bf16_t*)(p.ws + OFF_WUQ), 512, j % 8, j / 8, wv__); continue; } j -= J_TUQ;
        if (j < J_TUKV) { transpose_tile(tl, p.in[21], 256, 2048, (bf16_t*)(p.ws + OFF_WUKV), 256, j % 4, j / 4, wv__); continue; } j -= J_TUKV;
        if (j < 4 * J_TL) {
            const int which = j / J_TL, jj = j % J_TL, z = which & 1;
            const float* src = (which < 2 ? p.in[26] : p.in[28]) + (size_t)z * 96 * 2048;
            bf16_t* dst = (bf16_t*)(p.ws + (which < 2 ? OFF_W2T : OFF_A2T)) + (size_t)z * 2048 * 128;
            transpose_tile(tl, src, 96, 2048, dst, 128, jj % 2, jj / 2, wv__); continue;
        } j -= 4 * J_TL;
        if (j < J_CK) { cvt_cache(p.in[2], (bf16_t*)(p.ws + OFF_KD), 1024, j, wv__); continue; } j -= J_CK;
        if (j < J_CV) { cvt_cache(p.in[3], (bf16_t*)(p.ws + OFF_VD), 1024, j, wv__); continue; } j -= J_CV;
        if (j < J_CC) { cvt_cache(p.in[4], (bf16_t*)(p.ws + OFF_CKVA), 256, j, wv__); continue; } j -= J_CC;
        if (j < J_CP) { cvt_cache(p.in[5], (bf16_t*)(p.ws + OFF_KPE), 64, j, wv__); continue; } j -= J_CP;
        {
            f32x2* tab = (f32x2*)(p.ws + OFF_ROPE);
            for (int i = otid(); i < 1024; i += NTHREADS) {
                const int pos = i >> 4, fi = i & 15;
                const float f = powf(10000.f, -(float)fi / 16.f);
                const float ang = (float)pos * f;
                f32x2 t = {cosf(ang), sinf(ang)};
                tab[i] = t;
            }
        }
    }
}

DI void norm_mod_phase(const float* xp, const float* xs, const float* g, const float* modl, bf16_t* H, const int wv__) {
    const int tid_ = otid(), lane = tid_ & 63, wg = blockIdx.x * 8 + (tid_ >> 6), nw = gridDim.x * 8;
    for (int row = wg; row < 8192; row += nw) {
        const float* x = row < 4096 ? xp + (size_t)row * 2048 : xs + (size_t)(row - 4096) * 2048;
        const float* md = modl + cond_of(row) * 6144;
        f32x4 v[8]; float ss = 0.f;
#pragma unroll
        for (int i = 0; i < 8; ++i) { v[i] = ld_f4_nt(x + i * 256 + lane * 4); ss += v[i][0] * v[i][0] + v[i][1] * v[i][1] + v[i][2] * v[i][2] + v[i][3] * v[i][3]; }
        f32x4 gs[8], sh[8];
#pragma unroll
        for (int i = 0; i < 8; ++i) { const int c = i * 256 + lane * 4; gs[i] = ld_f4(g + c) * (1.f + ld_f4(md + 2048 + c)); sh[i] = ld_f4(md + c); }
        ss = wave_sum(ss, lane);
        const float rstd = rsqrtf(ss * (1.f / 2048.f) + 1e-6f);
#pragma unroll
        for (int i = 0; i < 8; ++i) {
            const int c = i * 256 + lane * 4;
            const f32x4 h = v[i] * rstd * gs[i] + sh[i];
            st_bf4(H + (size_t)row * 2048 + c, h);
        }
    }
}
DI void final_norm_phase(float* x, const bf16_t* O2, const float* g, const int wv__) {
    const int tid_ = otid(), lane = tid_ & 63, wg = blockIdx.x * 8 + (tid_ >> 6), nw = gridDim.x * 8;
    for (int row = wg; row < 8192; row += nw) {
        float* xr = x + (size_t)row * 2048;
        f32x4 v[8]; float ss = 0.f;
#pragma unroll
        for (int i = 0; i < 8; ++i) { v[i] = ld_f4_nt(xr + i * 256 + lane * 4) + bf4_to_f4(__builtin_nontemporal_load((const u32x2*)(O2 + (size_t)row * 2048 + i * 256 + lane * 4))); ss += v[i][0] * v[i][0] + v[i][1] * v[i][1] + v[i][2] * v[i][2] + v[i][3] * v[i][3]; }
        ss = wave_sum(ss, lane);
        const float rstd = rsqrtf(ss * (1.f / 2048.f) + 1e-6f);
#pragma unroll
        for (int i = 0; i < 8; ++i) { const int c = i * 256 + lane * 4; st_f4_nt(xr + c, v[i] * rstd * ld_f4(g + c)); }
    }
}
DI void lat_norm_phase(const Params& p, const int wv__) {
    const int tid_ = otid(), lane = tid_ & 63, wg = blockIdx.x * 8 + (tid_ >> 6), nw = gridDim.x * 8;
    const bf16_t* CQR = (const bf16_t*)(p.ws + OFF_CQR); const float* CKVR = (const float*)(p.ws + OFF_CKVR);
    bf16_t* CQN = (bf16_t*)(p.ws + OFF_CQN); bf16_t* CKVA = (bf16_t*)(p.ws + OFF_CKVA);
    const float* qg = p.in[18]; const float* kg = p.in[20];
    for (int row = wg; row < 8192; row += nw) {
        const u32x4 u = *(const u32x4*)(CQR + (size_t)row * 512 + lane * 8);
        float q[8] = {bflo(u[0]), bfhi(u[0]), bflo(u[1]), bfhi(u[1]), bflo(u[2]), bfhi(u[2]), bflo(u[3]), bfhi(u[3])};
        float ss = 0.f;
#pragma unroll
        for (int i = 0; i < 8; ++i) ss += q[i] * q[i];
        ss = wave_sum(ss, lane);
        float rstd = rsqrtf(ss * (1.f / 512.f) + 1e-6f);
        const f32x4 g0 = ld_f4(qg + lane * 8), g1 = ld_f4(qg + lane * 8 + 4);
        u32x4 o = {pk2(q[0] * rstd * g0[0], q[1] * rstd * g0[1]), pk2(q[2] * rstd * g0[2], q[3] * rstd * g0[3]),
                   pk2(q[4] * rstd * g1[0], q[5] * rstd * g1[1]), pk2(q[6] * rstd * g1[2], q[7] * rstd * g1[3])};
        *(u32x4*)(CQN + (size_t)row * 512 + lane * 8) = o;
        const f32x4 kv = ld_f4(CKVR + (size_t)row * 256 + lane * 4);
        float s2 = kv[0] * kv[0] + kv[1] * kv[1] + kv[2] * kv[2] + kv[3] * kv[3];
        s2 = wave_sum(s2, lane);
        rstd = rsqrtf(s2 * (1.f / 256.f) + 1e-6f);
        const f32x4 r = kv * rstd * ld_f4(kg + lane * 4);
        if (row < 4096) st_f4_nt(p.out + OUT_CKV + (size_t)row * 256 + lane * 4, r);
        st_bf4(CKVA + (size_t)kvrow_of(row) * 256 + lane * 4, r);
    }
}

template <int TYPE>
DI void attn_unit(const Params& p, LAS unsigned char* lds, int samp, int b, int h, int qb, float lam, const int wv__) {
    constexpr int NC = TYPE == 0 ? 2 : 1, KS = TYPE == 0 ? 2 : 6, KDIM = TYPE == 0 ? 128 : 192;
    constexpr int KP = KDIM * 2 + 16, VP = 288, CPK = KDIM / 8, NKC = 64 * CPK / NTHREADS;
    LAS unsigned char* Ks = lds; LAS unsigned char* Vs = lds + 64 * KP;
    const int tid = otid(), wid = tid >> 6, lane = tid & 63, fr = lane & 15, fq = lane >> 4;
    const int row0 = samp ? 4096 + b * 1024 + qb * 128 : b * 256 + qb * 128, qrow = row0 + wid * 16 + fr;
    const int kv0 = samp ? 4096 + b * 1536 : b * 256, ntile = samp ? 24 : 4;
    const bf16_t* QD = (const bf16_t*)(p.ws + OFF_QD); const bf16_t* KD = (const bf16_t*)(p.ws + OFF_KD); const bf16_t* VD = (const bf16_t*)(p.ws + OFF_VD);
    const bf16_t* QB = (const bf16_t*)(p.ws + OFF_QB); const bf16_t* KVB = (const bf16_t*)(p.ws + OFF_KVB); const bf16_t* KPE = (const bf16_t*)(p.ws + OFF_KPE);
    bf16x8 qf[NC * KS];
#pragma unroll
    for (int i = 0; i < NC * KS; ++i)
        qf[i] = TYPE == 0 ? *(const bf16x8*)(QD + (size_t)qrow * 1024 + h * 128 + i * 32 + fq * 8) : *(const bf16x8*)(QB + (size_t)qrow * 1536 + h * 192 + i * 32 + fq * 8);
    f32x4 o[NC][8];
    float mrun[NC], lrun[NC];
#pragma unroll
    for (int c = 0; c < NC; ++c) { mrun[c] = -1e30f; lrun[c] = 0.f;
#pragma unroll
        for (int v = 0; v < 8; ++v) o[c][v] = (f32x4){0.f, 0.f, 0.f, 0.f}; }
    const float sl2 = (TYPE == 0 ? 0.125f : 0.07216878364870322f) * 1.4426950408889634f;
    u32x4 kreg[NKC], vreg[2];
    auto prefetch = [&](int t) {
#pragma unroll
        for (int i = 0; i < NKC; ++i) {
            const int q = tid + i * NTHREADS, key = q / CPK, ch = q % CPK; const size_t r = (size_t)(kv0 + t * 64 + key);
            const bf16_t* src;
            if (TYPE == 0) src = KD + r * 1024 + h * 128 + ch * 8;
            else src = ch < 16 ? KVB + r * 2048 + h * 256 + ch * 8 : KPE + r * 64 + (ch - 16) * 8;
            kreg[i] = *(const u32x4*)src;
        }
#pragma unroll
        for (int i = 0; i < 2; ++i) {
            const int q = tid + i * NTHREADS, key = q >> 4, ch = q & 15; const size_t r = (size_t)(kv0 + t * 64 + key);
            const bf16_t* src = TYPE == 0 ? VD + r * 1024 + h * 128 + ch * 8 : KVB + r * 2048 + h * 256 + 128 + ch * 8;
            vreg[i] = *(const u32x4*)src;
        }
    };
    constexpr int BUFB = 64 * KP + 64 * VP;
    auto lds_write = [&](int buf) {
        LAS unsigned char* Kb = lds + buf * BUFB; LAS unsigned char* Vb = Kb + 64 * KP;
#pragma unroll
        for (int i = 0; i < NKC; ++i) { const int q = tid + i * NTHREADS, key = q / CPK, ch = q % CPK; *(LAS u32x4*)(Kb + key * KP + ch * 16) = kreg[i]; }
#pragma unroll
        for (int i = 0; i < 2; ++i) { const int q = tid + i * NTHREADS, key = q >> 4, ch = q & 15; *(LAS u32x4*)(Vb + key * VP + ch * 16) = vreg[i]; }
    };
    prefetch(0);
    lds_write(0);
    if (ntile > 1) prefetch(1);
    __syncthreads();
    const int qq = (lane & 15) >> 2, pp = lane & 3;
    for (int t = 0; t < ntile; ++t) {
        if (t + 1 < ntile) lds_write((t + 1) & 1);
        if (t + 2 < ntile) prefetch(t + 2);
        LAS unsigned char* Kc = lds + (t & 1) * BUFB; LAS unsigned char* Vc = Kc + 64 * KP;
        f32x4 s[NC][4];
#pragma unroll
        for (int c = 0; c < NC; ++c)
#pragma unroll
            for (int nt = 0; nt < 4; ++nt) {
                s[c][nt] = (f32x4){0.f, 0.f, 0.f, 0.f};
#pragma unroll
                for (int ks = 0; ks < KS; ++ks) {
                    const bf16x8 kf = *(const LAS bf16x8*)(Kc + (nt * 16 + fr) * KP + (c * KS + ks) * 64 + fq * 16);
                    s[c][nt] = __builtin_amdgcn_mfma_f32_16x16x32_bf16(kf, qf[c * KS + ks], s[c][nt], 0, 0, 0);
                }
                if (nt & 1) __builtin_amdgcn_sched_barrier(0);
            }
        __builtin_amdgcn_sched_barrier(0);
        bf16x8 pb[NC][2];
#pragma unroll
        for (int c = 0; c < NC; ++c) {
            float mx = -1e30f;
#pragma unroll
            for (int nt = 0; nt < 4; ++nt)
#pragma unroll
                for (int j = 0; j < 4; ++j) mx = fmaxf(mx, s[c][nt][j]);
            mx = fmaxf(mx, shx(mx, 16, lane)); mx = fmaxf(mx, shx(mx, 32, lane));
            const float mnew = fmaxf(mrun[c], mx);
            const float alpha = __builtin_amdgcn_exp2f((mrun[c] - mnew) * sl2);
            mrun[c] = mnew;
            const float nm = -mnew * sl2;
            float ls = 0.f;
#pragma unroll
            for (int nt = 0; nt < 4; ++nt)
#pragma unroll
                for (int j = 0; j < 4; ++j) { const float e = __builtin_amdgcn_exp2f(fmaf(s[c][nt][j], sl2, nm)); s[c][nt][j] = e; ls += e; }
            lrun[c] = lrun[c] * alpha + ls;
            if (__builtin_amdgcn_ballot_w64(alpha != 1.f) != 0ull) {
#pragma unroll
                for (int v = 0; v < 8; ++v) o[c][v] *= alpha;
            }
#pragma unroll
            for (int s2 = 0; s2 < 2; ++s2) {
                u32x4 u = {pk2(s[c][2 * s2][0], s[c][2 * s2][1]), pk2(s[c][2 * s2][2], s[c][2 * s2][3]), pk2(s[c][2 * s2 + 1][0], s[c][2 * s2 + 1][1]), pk2(s[c][2 * s2 + 1][2], s[c][2 * s2 + 1][3])};
                pb[c][s2] = __builtin_bit_cast(bf16x8, u);
            }
        }
#pragma unroll
        for (int s2 = 0; s2 < 2; ++s2)
#pragma unroll
            for (int v = 0; v < 8; ++v) {
                LAS unsigned char* a0 = Vc + (32 * s2 + 4 * fq + qq) * VP + v * 32 + 8 * pp;
                const s16x4 lo = __builtin_amdgcn_ds_read_tr16_b64_v4i16((LAS s16x4*)a0);
                const s16x4 hi = __builtin_amdgcn_ds_read_tr16_b64_v4i16((LAS s16x4*)(a0 + 16 * VP));
                const bf16x8 va = __builtin_shufflevector(lo, hi, 0, 1, 2, 3, 4, 5, 6, 7);
#pragma unroll
                for (int c = 0; c < NC; ++c) o[c][v] = __builtin_amdgcn_mfma_f32_16x16x32_bf16(va, pb[c][s2], o[c][v], 0, 0, 0);
                if ((v & 1) == 1) __builtin_amdgcn_sched_barrier(0);
            }
        __syncthreads();
    }
    float linv[NC];
#pragma unroll
    for (int c = 0; c < NC; ++c) { float l = lrun[c]; l += shx(l, 16, lane); l += shx(l, 32, lane); linv[c] = 1.f / l; }
    const bf16_t* SG = (const bf16_t*)(p.ws + OFF_SG0);
    bf16_t* Y = (bf16_t*)(p.ws + OFF_H);
    if (TYPE == 0) {
        float ss = 0.f;
#pragma unroll
        for (int v = 0; v < 8; ++v)
#pragma unroll
            for (int j = 0; j < 4; ++j) { const float x = o[0][v][j] * linv[0] - lam * o[NC - 1][v][j] * linv[NC - 1]; o[0][v][j] = x; ss += x * x; }
        ss += shx(ss, 16, lane); ss += shx(ss, 32, lane);
        const float rstd = rsqrtf(ss * (1.f / 128.f) + 1e-6f) * 0.8f;
        const float* sg = p.in[17];
#pragma unroll
        for (int v = 0; v < 8; ++v) {
            const int d = v * 16 + fq * 4;
            const f32x4 g = ld_f4(sg + d);
            const f32x4 gt = bf4_to_f4(*(const u32x2*)(SG + (size_t)qrow * 2048 + h * 128 + d));
            st_bf4(Y + (size_t)qrow * 2048 + h * 128 + d, o[0][v] * rstd * g * gt);
        }
    } else {
#pragma unroll
        for (int v = 0; v < 8; ++v) {
            const int d = v * 16 + fq * 4;
            const f32x4 gt = bf4_to_f4(*(const u32x2*)(SG + (size_t)qrow * 2048 + 1024 + h * 128 + d));
            st_bf4(Y + (size_t)qrow * 2048 + 1024 + h * 128 + d, o[0][v] * linv[0] * gt);
        }
    }
}
DI void attn_phase(const Params& p, LAS unsigned char* lds, const int wv__) {
    const float* lp = p.in[16];
    const int lane = otid() & 63;
    const float s01 = wave_sum(lp[lane] * lp[64 + lane], lane), s23 = wave_sum(lp[128 + lane] * lp[192 + lane], lane);
    const float lam = __expf(s01) - __expf(s23) + 0.2f;
    for (int u = blockIdx.x; u < 1024; u += gridDim.x) {
        const int grp = u >> 8, i = u & 255;
        if (grp == 0) attn_unit<0>(p, lds, 1, i >> 6, (i >> 3) & 7, i & 7, lam, wv__);
        else if (grp == 1) attn_unit<1>(p, lds, 1, i >> 6, (i >> 3) & 7, i & 7, lam, wv__);
        else if (grp == 2) attn_unit<0>(p, lds, 0, i >> 4, (i >> 1) & 7, i & 1, lam, wv__);
        else attn_unit<1>(p, lds, 0, i >> 4, (i >> 1) & 7, i & 1, lam, wv__);
    }
}

DI f32x4 tshift(f32x4 x, f32x4 pv, f32x4 nx, f32x4 m0, f32x4 m1) { return x + m0 * (pv - x) + m1 * (nx - x); }
DI void seq_pos(int row, int& t, int& T) { if (row < 4096) { t = row & 255; T = 256; } else { t = (row - 4096) & 1023; T = 1024; } }

DI void lora_in_phase(const Params& p, const int wv__) {
    const int tid_ = otid(), lane = tid_ & 63, wg = blockIdx.x * 8 + (tid_ >> 6), nw = gridDim.x * 8;
    const bf16_t* PART = (const bf16_t*)(p.ws + OFF_PART);
    const float* mu = p.in[24];
    const int o = lane * 8, arr = o >> 7, idx = o & 127;
    bf16_t* dstb = (bf16_t*)(p.ws + (arr < 2 ? OFF_WDT : OFF_ADT)) + (size_t)(arr & 1) * 8192 * 128 + idx;
    for (int row = wg; row < 8192; row += nw) {
        u32x4 res = {0u, 0u, 0u, 0u};
        if (idx < 96) {
            int t, T; seq_pos(row, t, T);
            const int col = 8192 + arr * 96 + idx;
            const bf16_t* c = PART + (size_t)row * 2048 + arr * 96 + idx;
            float xc[8], xp[8], xn[8];
#pragma unroll
            for (int e = 0; e < 8; ++e) { xc[e] = 0.f; xp[e] = 0.f; xn[e] = 0.f; }
#pragma unroll
            for (int ks = 0; ks < 4; ++ks) {
                const u32x4 uc = *(const u32x4*)(c + ks * 512);
#pragma unroll
                for (int e = 0; e < 4; ++e) { xc[2 * e] += bflo(uc[e]); xc[2 * e + 1] += bfhi(uc[e]); }
                if (t > 0) { const u32x4 up = *(const u32x4*)(c + ks * 512 - 2048);
#pragma unroll
                    for (int e = 0; e < 4; ++e) { xp[2 * e] += bflo(up[e]); xp[2 * e + 1] += bfhi(up[e]); } }
                if (t < T - 1) { const u32x4 un = *(const u32x4*)(c + ks * 512 + 2048);
#pragma unroll
                    for (int e = 0; e < 4; ++e) { xn[2 * e] += bflo(un[e]); xn[2 * e + 1] += bfhi(un[e]); } }
            }
            float r[8];
#pragma unroll
            for (int e = 0; e < 4; ++e) {
                const f32x2 m0 = *(const f32x2*)(mu + col + 2 * e), m1 = *(const f32x2*)(mu + 8576 + col + 2 * e);
                r[2 * e] = xc[2 * e] + m0[0] * (xp[2 * e] - xc[2 * e]) + m1[0] * (xn[2 * e] - xc[2 * e]);
                r[2 * e + 1] = xc[2 * e + 1] + m0[1] * (xp[2 * e + 1] - xc[2 * e + 1]) + m1[1] * (xn[2 * e + 1] - xc[2 * e + 1]);
            }
            if (arr < 2) {
#pragma unroll
                for (int e = 0; e < 8; ++e) r[e] = tanhf(r[e]);
            }
            res = (u32x4){pk2(r[0], r[1]), pk2(r[2], r[3]), pk2(r[4], r[5]), pk2(r[6], r[7])};
        }
        *(u32x4*)(dstb + (size_t)row * 128) = res;
    }
}

struct StageRegs { u32x2 raw[9], ra, re, rep; int row; };
DI void scan_stage_load(StageRegs& R, const bf16_t* C1, const bf16_t* AZ, const bf16_t* EZ, const float* mu, const float* kkw, const float* kaw, const float* rkw,
                        int row, int t, int T, int h, int z, int c4, bool first  ) {
    (void)mu; (void)kkw; (void)kaw; (void)rkw;
    R.row = row;
    const bf16_t* c = C1 + (size_t)row * 8576 + h * 64 + c4;
    const u32x2 zero = {0u, 0u};
#pragma unroll
    for (int g = 0; g < 3; ++g) {
        R.raw[g * 3 + 1] = *(const u32x2*)(c + g * 2048);
        R.raw[g * 3 + 0] = t > 0 ? *(const u32x2*)(c + g * 2048 - 8576) : zero;
        R.raw[g * 3 + 2] = t < T - 1 ? *(const u32x2*)(c + g * 2048 + 8576) : zero;
    }
    R.ra = *(const u32x2*)(AZ + ((size_t)z * 8192 + row) * 2048 + h * 64 + c4);
    R.re = *(const u32x2*)(EZ + ((size_t)z * 8192 + row) * 2048 + h * 64 + c4);
    R.rep = first ? zero : *(const u32x2*)(EZ + ((size_t)z * 8192 + row + (z ? 1 : -1)) * 2048 + h * 64 + c4);
}
DI void scan_stage_store(const StageRegs& R, LAS float* sb, float* BN, bool lead, int h, int z, const LAS float* pt, bool wlast, LAS float* plast  ) {
    f32x4 x[3];
#pragma unroll
    for (int g = 0; g < 3; ++g) x[g] = tshift(bf4_to_f4(R.raw[g * 3 + 1]), bf4_to_f4(R.raw[g * 3 + 0]), bf4_to_f4(R.raw[g * 3 + 2]), *(const LAS f32x4*)(pt + (2 * g) * 64), *(const LAS f32x4*)(pt + (2 * g + 1) * 64));
    const f32x4 a = bf4_to_f4(R.ra), cs = h4_to_f4(R.re), cp = h4_to_f4(R.rep);
    const f32x4 kkr = x[1] * *(const LAS f32x4*)(pt + 6 * 64);
    float ss = kkr[0] * kkr[0] + kkr[1] * kkr[1] + kkr[2] * kkr[2] + kkr[3] * kkr[3];
    ss = sum16d(ss);
    const f32x4 kk = kkr * rsqrtf(fmaxf(ss, 1e-12f));
    const f32x4 kz = x[1] * (1.f + (a - 1.f) * *(const LAS f32x4*)(pt + 7 * 64));
    const f32x4 kka = kk * a;
    f32x4 pc, ip, pp;
#pragma unroll
    for (int j = 0; j < 4; ++j) { pc[j] = __expf(-cs[j]); ip[j] = __expf(cs[j]); pp[j] = __expf(-cp[j]); }
    const f32x4 rk = *(const LAS f32x4*)(pt + 8 * 64);
    float bn = x[0][0] * kz[0] * rk[0] + x[0][1] * kz[1] * rk[1] + x[0][2] * kz[2] * rk[2] + x[0][3] * kz[3] * rk[3];
    bn = sum16d(bn);
    if (lead) BN[((size_t)z * 8192 + R.row) * 32 + h] = bn;
    *(LAS f32x4*)(sb) = x[0] * pc; *(LAS f32x4*)(sb + 64) = kka * ip; *(LAS f32x4*)(sb + 128) = kz * ip; *(LAS f32x4*)(sb + 192) = -kk * pp; *(LAS f32x4*)(sb + 320) = x[2];
    if (wlast) *(LAS f32x4*)plast = pc;
}

DI void scan_phase(const Params& p, LAS unsigned char* lds, const int wv__) {
    const int tid = otid(), wid = __builtin_amdgcn_readfirstlane(tid >> 6), lane = tid & 63, half = wid >> 2, ht = tid & 255;
    const bf16_t* C1 = (const bf16_t*)(p.ws + OFF_C);
    const bf16_t* AZ = (const bf16_t*)(p.ws + OFF_AZ); const bf16_t* EZ = (const bf16_t*)(p.ws + OFF_EZ);
    bf16_t* YZ = (bf16_t*)(p.ws + OFF_YZ); float* BN = (float*)(p.ws + OFF_BN);
    const float* mu = p.in[24];
    LAS float* lf = (LAS float*)lds;
    for (int u = blockIdx.x; u < 256; u += gridDim.x) {
        if (half == 0) {
            const int rg = ht >> 3, cg8 = ht & 7, stt = ht >> 4, c4 = (ht & 15) * 4;
            const int b = u >> 6, h = (u >> 1) & 31, z = u & 1, T = 1024, rowbase = 4096 + b * 1024;
            LAS float* base = lf;
            LAS unsigned* ybase = (LAS unsigned*)(lf + 24576);
            f32x2 S[2][4];
            {
                const float* st = (z ? p.in[7] : p.in[6]) + (((size_t)b * 32 + h) * 64 + 2 * rg) * 64 + cg8 * 8;
#pragma unroll
                for (int rr = 0; rr < 2; ++rr) { const f32x4 v0 = ld_f4(st + rr * 64), v1 = ld_f4(st + rr * 64 + 4);
                    S[rr][0] = (f32x2){v0[0], v0[1]}; S[rr][1] = (f32x2){v0[2], v0[3]}; S[rr][2] = (f32x2){v1[0], v1[1]}; S[rr][3] = (f32x2){v1[2], v1[3]}; }
            }
            LAS float* ptab = lf + 26112;
            {
                if (ht < 16) {
                    const int hc = h * 64 + c4;
#pragma unroll
                    for (int g = 0; g < 3; ++g) { *(LAS f32x4*)(ptab + (2 * g) * 64 + c4) = ld_f4(mu + g * 2048 + hc); *(LAS f32x4*)(ptab + (2 * g + 1) * 64 + c4) = ld_f4(mu + 8576 + g * 2048 + hc); }
                    *(LAS f32x4*)(ptab + 6 * 64 + c4) = ld_f4(p.in[29] + hc); *(LAS f32x4*)(ptab + 7 * 64 + c4) = ld_f4(p.in[30] + hc); *(LAS f32x4*)(ptab + 8 * 64 + c4) = ld_f4(p.in[31] + hc);
                }
                __syncthreads();
            }
            StageRegs R;
            auto sload = [&](int ci, bool prm) { (void)prm; const int step = ci * 16 + stt, t = z ? T - 1 - step : step; scan_stage_load(R, C1, AZ, EZ, mu, p.in[29], p.in[30], p.in[31], rowbase + t, t, T, h, z, c4, stt == 0); };
            auto sstore = [&](int ci) { scan_stage_store(R, base + ((ci & 1) * 16 + stt) * 384 + c4, BN, (ht & 15) == 0, h, z, ptab + c4, stt == 15, base + (ci & 1) * 16 * 384 + 256 + c4); };
            auto flush = [&](int ci) {
                const LAS unsigned* yb = ybase + (ci & 1) * (16 * 32);
                const int fs = ht >> 4, fr4 = (ht & 15) * 2;
                const u32x2 yv = *(const LAS u32x2*)(yb + fs * 32 + fr4);
                const int step = ci * 16 + fs, t = z ? T - 1 - step : step;
                *(u32x2*)(YZ + ((size_t)z * 8192 + rowbase + t) * 2048 + h * 64 + fr4 * 2) = yv;
            };
            sload(0, true); sstore(0);
            __syncthreads();
            for (int ci = 0; ci < 64; ++ci) {
                if (ci > 0) flush(ci - 1);
                if (ci + 1 < 64) sload(ci + 1, false);
                const LAS float* cb = base + (ci & 1) * 16 * 384;
                LAS unsigned* ybuf = ybase + (ci & 1) * (16 * 32);
                f32x4 cur[8], nxt[8]; f32x2 vcur, vnxt;
                {
                    const LAS float* sb = cb + cg8 * 8;
#pragma unroll
                    for (int q = 0; q < 4; ++q) { cur[2 * q] = *(const LAS f32x4*)(sb + q * 64); cur[2 * q + 1] = *(const LAS f32x4*)(sb + q * 64 + 4); }
                    vcur = *(const LAS f32x2*)(cb + 320 + 2 * rg);
                }
#pragma unroll
                for (int s = 0; s < 16; ++s) {
                    if (s < 15) {
                        const LAS float* sb = cb + (s + 1) * 384 + cg8 * 8;
#pragma unroll
                        for (int q = 0; q < 4; ++q) { nxt[2 * q] = *(const LAS f32x4*)(sb + q * 64); nxt[2 * q + 1] = *(const LAS f32x4*)(sb + q * 64 + 4); }
                        vnxt = *(const LAS f32x2*)(cb + (s + 1) * 384 + 320 + 2 * rg);
                    }
                    f32x2 dp[4], bp[4], cp[4], ap[4];
#pragma unroll
                    for (int q = 0; q < 2; ++q) {
                        dp[2 * q] = (f32x2){cur[q][0], cur[q][1]}; dp[2 * q + 1] = (f32x2){cur[q][2], cur[q][3]};
                        bp[2 * q] = (f32x2){cur[2 + q][0], cur[2 + q][1]}; bp[2 * q + 1] = (f32x2){cur[2 + q][2], cur[2 + q][3]};
                        cp[2 * q] = (f32x2){cur[4 + q][0], cur[4 + q][1]}; cp[2 * q + 1] = (f32x2){cur[4 + q][2], cur[4 + q][3]};
                        ap[2 * q] = (f32x2){cur[6 + q][0], cur[6 + q][1]}; ap[2 * q + 1] = (f32x2){cur[6 + q][2], cur[6 + q][3]};
                    }
                    float sa[2], yy[2];
#pragma unroll
                    for (int rr = 0; rr < 2; ++rr) {
                        f32x2 a2 = S[rr][0] * ap[0] + S[rr][1] * ap[1];
                        f32x2 b2 = S[rr][2] * ap[2] + S[rr][3] * ap[3];
                        a2 += b2;
                        float x = a2[0] + a2[1];
                        x += dpp_xor1(x); x += dpp_xor2(x); x += dpp_hmirror(x);
                        sa[rr] = x;
                    }
#pragma unroll
                    for (int rr = 0; rr < 2; ++rr) {
                        const f32x2 sa2 = {sa[rr], sa[rr]}, v2 = {vcur[rr], vcur[rr]};
                        f32x2 y2 = {0.f, 0.f}, y3 = {0.f, 0.f};
#pragma unroll
                        for (int q = 0; q < 4; ++q) {
                            S[rr][q] = sa2 * bp[q] + (v2 * cp[q] + S[rr][q]);
                            if (q & 1) y3 += S[rr][q] * dp[q]; else y2 += S[rr][q] * dp[q];
                        }
                        y2 += y3;
                        float x = y2[0] + y2[1];
                        x += dpp_xor1(x); x += dpp_xor2(x); x += dpp_hmirror(x);
                        yy[rr] = x;
                    }
                    ybuf[s * 32 + rg] = pk2(yy[0], yy[1]);
                    if (s < 15) {
#pragma unroll
                        for (int q = 0; q < 8; ++q) cur[q] = nxt[q];
                        vcur = vnxt;
                    }
                }
                {
                    const f32x4 p0 = *(const LAS f32x4*)(cb + 256 + cg8 * 8), p1 = *(const LAS f32x4*)(cb + 256 + cg8 * 8 + 4);
                    const f32x2 pl[4] = {(f32x2){p0[0], p0[1]}, (f32x2){p0[2], p0[3]}, (f32x2){p1[0], p1[1]}, (f32x2){p1[2], p1[3]}};
#pragma unroll
                    for (int rr = 0; rr < 2; ++rr)
#pragma unroll
                        for (int q = 0; q < 4; ++q) S[rr][q] *= pl[q];
                }
                if (ci + 1 < 64) sstore(ci + 1);
                __syncthreads();
            }
            flush(63);
            __syncthreads();
        } else {
            const int pw = wid - 4, pu = 4 * u + pw;
            const int b = pu >> 6, h = (pu >> 1) & 31, z = pu & 1, T = 256, rowbase = b * 256;
            const int rg = lane >> 2, cg = lane & 3, stt = lane >> 4, c4 = (lane & 15) * 4;
            LAS float* base = lf + 12288 + pw * (2 * 4 * 384);
            LAS unsigned* ybuf = (LAS unsigned*)(lf + 25600) + pw * (4 * 32);
            f32x2 S[4][8];
#pragma unroll
            for (int rr = 0; rr < 4; ++rr)
#pragma unroll
                for (int q = 0; q < 8; ++q) S[rr][q] = (f32x2){0.f, 0.f};
            LAS float* ptab = lf + 26688 + pw * 576;
            {
                if (lane < 16) {
                    const int hc = h * 64 + c4;
#pragma unroll
                    for (int g = 0; g < 3; ++g) { *(LAS f32x4*)(ptab + (2 * g) * 64 + c4) = ld_f4(mu + g * 2048 + hc); *(LAS f32x4*)(ptab + (2 * g + 1) * 64 + c4) = ld_f4(mu + 8576 + g * 2048 + hc); }
                    *(LAS f32x4*)(ptab + 6 * 64 + c4) = ld_f4(p.in[29] + hc); *(LAS f32x4*)(ptab + 7 * 64 + c4) = ld_f4(p.in[30] + hc); *(LAS f32x4*)(ptab + 8 * 64 + c4) = ld_f4(p.in[31] + hc);
                }
                __syncthreads();
            }
            StageRegs R;
            auto sload = [&](int it, bool prm) { (void)prm; const int step = it * 4 + stt, t = z ? T - 1 - step : step; scan_stage_load(R, C1, AZ, EZ, mu, p.in[29], p.in[30], p.in[31], rowbase + t, t, T, h, z, c4, (step & 15) == 0); };
            auto sstore = [&](int it) { scan_stage_store(R, base + ((it & 1) * 4 + stt) * 384 + c4, BN, (lane & 15) == 0, h, z, ptab + c4, (it & 3) == 3 && stt == 3, base + (it & 1) * 4 * 384 + 256 + c4); };
            sload(0, true); sstore(0);
            __syncthreads();
            for (int it = 0; it < 64; ++it) {
                if (it + 1 < 64) sload(it + 1, false);
                const LAS float* cb = base + (it & 1) * 4 * 384;
#pragma unroll 1
                for (int s = 0; s < 4; ++s) {
                    const LAS float* sb = cb + s * 384 + cg * 16;
                    f32x2 dp[8], bp[8], cp[8], ap[8];
#pragma unroll
                    for (int q = 0; q < 4; ++q) {
                        const f32x4 a4 = *(const LAS f32x4*)(sb + 192 + q * 4);
                        ap[2 * q] = (f32x2){a4[0], a4[1]}; ap[2 * q + 1] = (f32x2){a4[2], a4[3]};
                    }
                    const f32x4 vv = *(const LAS f32x4*)(cb + s * 384 + 320 + 4 * rg);
                    float yy[4], sav[4];
#pragma unroll
                    for (int rr = 0; rr < 4; ++rr) {
                        f32x2 a2 = S[rr][0] * ap[0] + S[rr][1] * ap[1];
                        f32x2 b2 = S[rr][2] * ap[2] + S[rr][3] * ap[3];
                        a2 += S[rr][4] * ap[4] + S[rr][5] * ap[5];
                        b2 += S[rr][6] * ap[6] + S[rr][7] * ap[7];
                        a2 += b2;
                        float sa = a2[0] + a2[1];
                        sa += dpp_xor1(sa); sa += dpp_xor2(sa);
                        sav[rr] = sa;
                    }
                    __builtin_amdgcn_sched_barrier(0);
#pragma unroll
                    for (int q = 0; q < 4; ++q) {
                        const f32x4 a0 = *(const LAS f32x4*)(sb + q * 4), a1 = *(const LAS f32x4*)(sb + 64 + q * 4), a2 = *(const LAS f32x4*)(sb + 128 + q * 4);
                        dp[2 * q] = (f32x2){a0[0], a0[1]}; dp[2 * q + 1] = (f32x2){a0[2], a0[3]};
                        bp[2 * q] = (f32x2){a1[0], a1[1]}; bp[2 * q + 1] = (f32x2){a1[2], a1[3]};
                        cp[2 * q] = (f32x2){a2[0], a2[1]}; cp[2 * q + 1] = (f32x2){a2[2], a2[3]};
                    }
#pragma unroll
                    for (int rr = 0; rr < 4; ++rr) {
                        const f32x2 sa2 = {sav[rr], sav[rr]}, v2 = {vv[rr], vv[rr]};
                        f32x2 y2 = {0.f, 0.f}, y3 = {0.f, 0.f};
#pragma unroll
                        for (int q = 0; q < 8; ++q) {
                            S[rr][q] = sa2 * bp[q] + (v2 * cp[q] + S[rr][q]);
                            if (q & 1) y3 += S[rr][q] * dp[q]; else y2 += S[rr][q] * dp[q];
                        }
                        y2 += y3;
                        float x = y2[0] + y2[1];
                        x += dpp_xor1(x); x += dpp_xor2(x);
                        yy[rr] = x;
                    }
                    const u32x2 yo = {pk2(yy[0], yy[1]), pk2(yy[2], yy[3])};
                    *(LAS u32x2*)(ybuf + s * 32 + rg * 2) = yo;
                }
                {
                    const int fs = lane >> 4, fr4 = (lane & 15) * 2;
                    const u32x2 yv = *(const LAS u32x2*)(ybuf + fs * 32 + fr4);
                    const int step = it * 4 + fs, t = z ? T - 1 - step : step;
                    *(u32x2*)(YZ + ((size_t)z * 8192 + rowbase + t) * 2048 + h * 64 + fr4 * 2) = yv;
                }
                if ((it & 3) == 3) {
#pragma unroll
                    for (int q = 0; q < 4; ++q) {
                        const f32x4 pv = *(const LAS f32x4*)(cb + 256 + cg * 16 + q * 4);
                        const f32x2 pa = {pv[0], pv[1]}, pb2 = {pv[2], pv[3]};
#pragma unroll
                        for (int rr = 0; rr < 4; ++rr) { S[rr][2 * q] *= pa; S[rr][2 * q + 1] *= pb2; }
                    }
                }
                if (it + 1 < 64) sstore(it + 1);
                __syncthreads();
            }
            {
                float* st = p.out + (z ? OUT_SB : OUT_SF) + (((size_t)b * 32 + h) * 64 + 4 * rg) * 64 + cg * 16;
#pragma unroll
                for (int rr = 0; rr < 4; ++rr)
#pragma unroll
                    for (int q = 0; q < 4; ++q) { const f32x4 v = {S[rr][2 * q][0], S[rr][2 * q][1], S[rr][2 * q + 1][0], S[rr][2 * q + 1][1]}; st_f4(st + rr * 64 + q * 4, v); }
            }
            __syncthreads();
        }
    }
}

DI void post_phase(const Params& p, const int wv__) {
    const int tid_ = otid(), lane = tid_ & 63, wg = blockIdx.x * 8 + (tid_ >> 6), nw = gridDim.x * 8;
    const bf16_t* C1 = (const bf16_t*)(p.ws + OFF_C);
    const bf16_t* YZ = (const bf16_t*)(p.ws + OFF_YZ); const float* BN = (const float*)(p.ws + OFF_BN);
    bf16_t* Y1 = (bf16_t*)(p.ws + OFF_H);
    const float* mu = p.in[24]; const float* lnw = p.in[32]; const float* lnb = p.in[33];
    const int cb = wg & 7, c = cb * 256 + lane * 4, hd = c >> 6;
    const f32x4 mv0 = ld_f4(mu + 4096 + c), mv1 = ld_f4(mu + 8576 + 4096 + c), mg0 = ld_f4(mu + 6144 + c), mg1 = ld_f4(mu + 8576 + 6144 + c);
    const f32x4 w4 = ld_f4(lnw + c), b4 = ld_f4(lnb + c);
#pragma unroll 4
    for (int row = wg >> 3; row < 8192; row += nw >> 3) {
        int t, T; seq_pos(row, t, T);
        const bf16_t* cr = C1 + (size_t)row * 8576;
        const bool hp = t > 0, hn = t < T - 1;
        const f32x4 ya = bf4_to_f4(__builtin_nontemporal_load((const u32x2*)(YZ + (size_t)row * 2048 + c)));
        const f32x4 yb = bf4_to_f4(__builtin_nontemporal_load((const u32x2*)(YZ + ((size_t)8192 + row) * 2048 + c)));
        const u32x2 zero = {0u, 0u};
        const u32x2 vc = *(const u32x2*)(cr + 4096 + c), gc = *(const u32x2*)(cr + 6144 + c);
        const u32x2 vp = hp ? *(const u32x2*)(cr - 8576 + 4096 + c) : zero, gp = hp ? *(const u32x2*)(cr - 8576 + 6144 + c) : zero;
        const u32x2 vn = hn ? *(const u32x2*)(cr + 8576 + 4096 + c) : zero, gn = hn ? *(const u32x2*)(cr + 8576 + 6144 + c) : zero;
        const float bna = BN[(size_t)row * 32 + hd], bnb = BN[((size_t)8192 + row) * 32 + hd];
        const float ma = sum16d(ya[0] + ya[1] + ya[2] + ya[3]) * (1.f / 64.f), mb = sum16d(yb[0] + yb[1] + yb[2] + yb[3]) * (1.f / 64.f);
        const f32x4 da = ya - ma, db = yb - mb;
        const float va = sum16d(da[0] * da[0] + da[1] * da[1] + da[2] * da[2] + da[3] * da[3]) * (1.f / 64.f);
        const float vb = sum16d(db[0] * db[0] + db[1] * db[1] + db[2] * db[2] + db[3] * db[3]) * (1.f / 64.f);
        const float rsa = rsqrtf(va + 64e-5f), rsb = rsqrtf(vb + 64e-5f);
        const f32x4 v = tshift(bf4_to_f4(vc), bf4_to_f4(vp), bf4_to_f4(vn), mv0, mv1);
        const f32x4 g = tshift(bf4_to_f4(gc), bf4_to_f4(gp), bf4_to_f4(gn), mg0, mg1);
        f32x4 res = (da * rsa + db * rsb) * w4 + 2.f * b4 + (bna + bnb) * v;
#pragma unroll
        for (int j = 0; j < 4; ++j) res[j] *= g[j] * sigmoidf_(g[j]);
        st_bf4(Y1 + (size_t)row * 2048 + c, res);
    }
}

#define XB_TMO      128
#define XB_XCNT(j)  (256  + 64 * (j))
#define XB_XSUB(j)  (1280 + 64 * (j))
#define XB_XGEN(j)  (2304 + 64 * (j))
#define XB_TOP      3328
#define XB_TOPGEN   3392
#define XCD_BAR_WORDS 3456
#define XB_SPIN_CAP (1u << 18)
DI unsigned xb_ld(unsigned* p)              { return __hip_atomic_load(p, __ATOMIC_RELAXED, __HIP_MEMORY_SCOPE_AGENT); }
DI unsigned xb_add(unsigned* p, unsigned v) { return __hip_atomic_fetch_add(p, v, __ATOMIC_RELAXED, __HIP_MEMORY_SCOPE_AGENT); }
DI unsigned xb_xcc_id() { return (unsigned)__builtin_amdgcn_s_getreg((3 << 11) | 20) & 0xFu; }
#define XB_SPIN(cond, bar) do { unsigned _sp = 0; while (cond) { __builtin_amdgcn_s_sleep(1); \
    if ((++_sp & 255u) == 0u) { if (xb_ld(&(bar)[XB_TMO])) break; if (_sp > XB_SPIN_CAP) { atomicAdd(&(bar)[XB_TMO], 1u); break; } } } } while (0)
struct XcdBarrier { unsigned* bar; unsigned x; volatile LAS unsigned* st; };
DI int ltid_(int wv) { return (wv << 6) | (int)__builtin_amdgcn_mbcnt_hi(~0u, __builtin_amdgcn_mbcnt_lo(~0u, 0u)); }
DI XcdBarrier xcd_barrier_post(unsigned* bar, volatile LAS unsigned* st, const int wv__) {
    XcdBarrier b; b.bar = bar; b.x = xb_xcc_id(); b.st = st;
    if (otid() == 0) (void)xb_add(&bar[XB_XCNT(b.x)], 1u);
    return b;
}
DI void xcd_barrier_complete(unsigned* bar, unsigned x, unsigned& nloc, unsigned& nx) {
    const unsigned G = gridDim.x * gridDim.y * gridDim.z;
    unsigned sum, cnt, mine, sp = 0u;
    for (;;) {
        sum = 0u; cnt = 0u; mine = 0u;
#pragma unroll
        for (unsigned j = 0; j < 16; ++j) { const unsigned c = xb_ld(&bar[XB_XCNT(j)]); sum += c; cnt += (c > 0u) ? 1u : 0u; mine = (j == x) ? c : mine; }
        if (sum == G) break;
        __builtin_amdgcn_s_sleep(1);
        if ((++sp & 255u) == 0u) { if (xb_ld(&bar[XB_TMO])) break; if (sp > XB_SPIN_CAP) { atomicAdd(&bar[XB_TMO], 1u); break; } }
    }
    nloc = mine > 0u ? mine : 1u; nx = cnt > 0u ? cnt : 1u;
}
DI void xcd_barrier(const XcdBarrier& b, const int wv__) {
    asm volatile("s_waitcnt vmcnt(0)" ::: "memory");
    __syncthreads();
    if (otid() == 0) {
        unsigned* bar = b.bar;
        __builtin_amdgcn_s_waitcnt(0);
        unsigned nloc = b.st[0], nx = b.st[1];
        if (nloc == 0u) { xcd_barrier_complete(bar, b.x, nloc, nx); b.st[0] = nloc; b.st[1] = nx; }
        const unsigned old = xb_add(&bar[XB_XSUB(b.x)], 1u);
        const unsigned gen = old / nloc;
        if (old + 1u == (gen + 1u) * nloc) {
            __builtin_amdgcn_fence(__ATOMIC_RELEASE, "agent");
            asm volatile("s_waitcnt vmcnt(0)" ::: "memory");
            const unsigned og = xb_add(&bar[XB_TOP], 1u);
            const unsigned tg = og / nx;
            if (og + 1u == (tg + 1u) * nx) xb_add(&bar[XB_TOPGEN], 1u);
            else XB_SPIN(xb_ld(&bar[XB_TOPGEN]) == tg, bar);
            __builtin_amdgcn_fence(__ATOMIC_ACQUIRE, "agent");
            xb_add(&bar[XB_XGEN(b.x)], 1u);
            asm volatile("s_waitcnt vmcnt(0)" ::: "memory");
        } else {
            XB_SPIN(xb_ld(&bar[XB_XGEN(b.x)]) == gen, bar);
            __builtin_amdgcn_fence(__ATOMIC_ACQUIRE, "agent");
            asm volatile("s_waitcnt vmcnt(0)" ::: "memory");
        }
    }
    __syncthreads();
}

constexpr int NPHASE = 15;
#ifndef PHASE_MASK
#define PHASE_MASK 0x7fff
#endif
#ifndef PH_ORDER
#define PH_ORDER 0xEDCBA9876543210ull
#define PH_COUNT 15
#endif
#define PH_ON(n) (((PHASE_MASK) >> (n)) & 1)
__global__ void __launch_bounds__(NTHREADS) mega(KArgs ka, int ph_lo, int ph_hi) {
    cg::grid_group grid = cg::this_grid();
    const int wv__ = __builtin_amdgcn_readfirstlane((int)(threadIdx.x >> 6));
    LAS unsigned char* lds = (LAS unsigned char*)dyn_lds;
    __shared__ uint4 xb_words;
    if (otid() == 0) xb_words = make_uint4(0u, 0u, 0u, 0u);
    XcdBarrier xb; xb.bar = nullptr; xb.x = 0u; xb.st = (volatile LAS unsigned*)&xb_words;
    typedef void* vptr_t;
    const __attribute__((address_space(4))) vptr_t* kat = (const __attribute__((address_space(4))) vptr_t*)__builtin_amdgcn_kernarg_segment_ptr();
    for (int si = ph_lo; si < ph_hi; ++si) {
        const int ph = (int)((PH_ORDER >> (4 * si)) & 15ull);
        if (si == ph_lo) {
            unsigned* bar = (unsigned*)((unsigned char*)kat[35] + OFF_BAR);
            if (blockIdx.x == 0) { const int t0 = otid();
#pragma unroll 1
                for (int i = t0; i < XCD_BAR_WORDS; i += NTHREADS) bar[i] = 0u; }
            __syncthreads();
        } else if (si == ph_lo + 1) {
            grid.sync();
            xb = xcd_barrier_post((unsigned*)((unsigned char*)kat[35] + OFF_BAR), (volatile LAS unsigned*)&xb_words, wv__);
        } else xcd_barrier(xb, wv__);
        int oz = 0; asm volatile("" : "+s"(oz));
        Params p;
        p.in[0] = (const float*)kat[0 + oz];
        p.in[1] = (const float*)kat[1 + oz];
        p.in[2] = (const float*)kat[2 + oz];
        p.in[3] = (const float*)kat[3 + oz];
        p.in[4] = (const float*)kat[4 + oz];
        p.in[5] = (const float*)kat[5 + oz];
        p.in[6] = (const float*)kat[6 + oz];
        p.in[7] = (const float*)kat[7 + oz];
        p.in[8] = (const float*)kat[8 + oz];
        p.in[9] = (const float*)kat[9 + oz];
        p.in[10] = (const float*)kat[10 + oz];
        p.in[11] = (const float*)kat[11 + oz];
        p.in[12] = (const float*)kat[12 + oz];
        p.in[13] = (const float*)kat[13 + oz];
        p.in[14] = (const float*)kat[14 + oz];
        p.in[15] = (const float*)kat[15 + oz];
        p.in[16] = (const float*)kat[16 + oz];
        p.in[17] = (const float*)kat[17 + oz];
        p.in[18] = (const float*)kat[18 + oz];
        p.in[19] = (const float*)kat[19 + oz];
        p.in[20] = (const float*)kat[20 + oz];
        p.in[21] = (const float*)kat[21 + oz];
        p.in[22] = (const float*)kat[22 + oz];
        p.in[23] = (const float*)kat[23 + oz];
        p.in[24] = (const float*)kat[24 + oz];
        p.in[25] = (const float*)kat[25 + oz];
        p.in[26] = (const float*)kat[26 + oz];
        p.in[27] = (const float*)kat[27 + oz];
        p.in[28] = (const float*)kat[28 + oz];
        p.in[29] = (const float*)kat[29 + oz];
        p.in[30] = (const float*)kat[30 + oz];
        p.in[31] = (const float*)kat[31 + oz];
        p.in[32] = (const float*)kat[32 + oz];
        p.in[33] = (const float*)kat[33 + oz];
        p.out = (float*)kat[34 + oz]; p.ws = (unsigned char*)kat[35 + oz];
        unsigned char* ws = p.ws;
        float* mod = (float*)(ws + OFF_MOD);
        const f32x2* rope = (const f32x2*)(ws + OFF_ROPE);
        switch (ph) {
        case 0: if (PH_ON(0)) prep_phase(p, lds, wv__); break;
        case 1: if (PH_ON(1)) norm_mod_phase(p.in[0], p.in[1], p.in[12], mod, (bf16_t*)(ws + OFF_H), wv__); break;
        case 2: if (PH_ON(2)) {
            Epi0 e; e.QD = (bf16_t*)(ws + OFF_QD); e.KD = (bf16_t*)(ws + OFF_KD); e.VD = (bf16_t*)(ws + OFF_VD); e.CQR = (bf16_t*)(ws + OFF_CQR); e.KPE = (bf16_t*)(ws + OFF_KPE);
            e.SG = (bf16_t*)(ws + OFF_SG0); e.CKVR = (float*)(ws + OFF_CKVR); e.oak = p.out + OUT_AK; e.oav = p.out + OUT_AV; e.okpe = p.out + OUT_KPE; e.rope = rope;
            gemm_phase(lds, (const bf16_t*)(ws + OFF_H), (const bf16_t*)(ws + OFF_WT0), 8192, 6144, 2048, e, wv__);
        } break;
        case 3: if (PH_ON(3)) lat_norm_phase(p, wv__); break;
        case 4: if (PH_ON(4)) {
            EpiQ eq; eq.QB = (bf16_t*)(ws + OFF_QB); eq.rope = rope;
            gemm_phase(lds, (const bf16_t*)(ws + OFF_CQN), (const bf16_t*)(ws + OFF_WUQ), 8192, 1536, 512, eq, wv__);
            EpiBf ek; ek.O = (bf16_t*)(ws + OFF_KVB); ek.ldc = 2048; ek.ncols = 2048;
            gemm_phase(lds, (const bf16_t*)(ws + OFF_CKVA), (const bf16_t*)(ws + OFF_WUKV), 10240, 2048, 256, ek, wv__);
        } break;
        case 5: if (PH_ON(5)) attn_phase(p, lds, wv__); break;
        case 6: if (PH_ON(6)) {
            EpiOut e; e.xp = p.in[0]; e.xs = p.in[1]; e.xo = p.out + OUT_Y; e.modg = mod + 4096;
            gemm_phase(lds, (const bf16_t*)(ws + OFF_H), (const bf16_t*)(ws + OFF_WOT0), 8192, 2048, 2048, e, wv__);
        } break;
        case 7: if (PH_ON(7)) norm_mod_phase(p.out + OUT_Y, p.out + OUT_Y + (size_t)4096 * 2048, p.in[12] + 2048, mod + 5 * 6144, (bf16_t*)(ws + OFF_H), wv__); break;
        case 8: if (PH_ON(8)) {
            EpiBf e; e.O = (bf16_t*)(ws + OFF_C); e.ldc = 8576; e.ncols = 8192;
            gemm_phase(lds, (const bf16_t*)(ws + OFF_H), (const bf16_t*)(ws + OFF_WT1), 8192, 8192, 2048, e, wv__);
            EpiBf e2; e2.O = (bf16_t*)(ws + OFF_PART); e2.ldc = 2048; e2.ncols = 2048;
            gemm_phase(lds, (const bf16_t*)(ws + OFF_H), (const bf16_t*)(ws + OFF_WT1) + (size_t)8192 * 2048, 8192, 512, 512, e2, wv__, 2048, 4);
        } break;
        case 9: if (PH_ON(9)) lora_in_phase(p, wv__); break;
        case 10: if (PH_ON(10)) {
#pragma unroll 1
            for (int z = 0; z < 2; ++z) {
                EpiDecay ew; ew.O = (bf16_t*)(ws + OFF_EZ) + (size_t)z * 8192 * 2048; ew.bias = p.in[25] + z * 2048; ew.rev = z;
                gemm_phase(lds, (const bf16_t*)(ws + OFF_WDT) + (size_t)z * 8192 * 128, (const bf16_t*)(ws + OFF_W2T) + (size_t)z * 2048 * 128, 8192, 2048, 128, ew, wv__);
                EpiLora ea; ea.O = (bf16_t*)(ws + OFF_AZ) + (size_t)z * 8192 * 2048; ea.bias = p.in[27] + z * 2048; ea.mul = 1.f;
                gemm_phase(lds, (const bf16_t*)(ws + OFF_ADT) + (size_t)z * 8192 * 128, (const bf16_t*)(ws + OFF_A2T) + (size_t)z * 2048 * 128, 8192, 2048, 128, ea, wv__);
            }
        } break;
        case 11: if (PH_ON(11)) scan_phase(p, lds, wv__); break;
        case 12: if (PH_ON(12)) post_phase(p, wv__); break;
        case 13: if (PH_ON(13)) {
            EpiGate e; e.O = (bf16_t*)(ws + OFF_C); e.modg = mod + 5 * 6144 + 4096;
            gemm_phase(lds, (const bf16_t*)(ws + OFF_H), (const bf16_t*)(ws + OFF_WOT1), 8192, 2048, 2048, e, wv__);
        } break;
        case 14: if (PH_ON(14)) final_norm_phase(p.out + OUT_Y, (const bf16_t*)(ws + OFF_C), p.in[13], wv__); break;
        }
    }
}

extern "C" void kernel_launch(void* const* d_in, const int* in_sizes, int n_in, void* d_out, int out_size, void* d_ws, size_t ws_size, hipStream_t stream) {
    static int grid_blocks = 0;
    if (!grid_blocks) {
        hipFuncSetAttribute((const void*)mega, hipFuncAttributeMaxDynamicSharedMemorySize, LDS_BYTES);
        int dev = 0, cus = 0, per_cu = 0;
        hipGetDevice(&dev);
        hipDeviceGetAttribute(&cus, hipDeviceAttributeMultiprocessorCount, dev);
        hipOccupancyMaxActiveBlocksPerMultiprocessor(&per_cu, mega, NTHREADS, LDS_BYTES);
        if (per_cu < 1) per_cu = 1;
        grid_blocks = cus * per_cu;
        if (grid_blocks > 256) grid_blocks = 256;
    }
    KArgs p{};
    for (int i = 0; i < 34; ++i) p.a[i] = d_in[i];
    p.a[34] = d_out;
    p.a[35] = d_ws;
    int lo = 0, hi = PH_COUNT;
    void* args[] = {&p, &lo, &hi};
    hipError_t e = hipLaunchCooperativeKernel((const void*)mega, dim3(grid_blocks), dim3(NTHREADS), args, LDS_BYTES, stream);
    if (e != hipSuccess) fprintf(stderr, "cooperative launch failed: %s (grid %d, ws %zu need %zu)\n", hipGetErrorString(e), grid_blocks, ws_size, (size_t)WS_NEEDED);
}
```

```cpp
#include <hip/hip_runtime.h>
#include <hip/hip_cooperative_groups.h>
#include <cstdio>
namespace cg = cooperative_groups;

#define DI __device__ __forceinline__
#define LAS __attribute__((address_space(3)))
typedef unsigned short bf16_t;
typedef short bf16x8 __attribute__((ext_vector_type(8)));
typedef short s16x4 __attribute__((ext_vector_type(4)));
typedef float f32x4 __attribute__((ext_vector_type(4)));
typedef float f32x2 __attribute__((ext_vector_type(2)));
typedef unsigned u32x4 __attribute__((ext_vector_type(4)));
typedef unsigned u32x2 __attribute__((ext_vector_type(2)));
typedef __bf16 nbf2 __attribute__((ext_vector_type(2)));

extern __shared__ __attribute__((aligned(16))) unsigned char dyn_lds[];
constexpr int LDS_BYTES = 131072;
constexpr int NTHREADS = 512;

constexpr size_t SZ_H    = (size_t)8192 * 2048 * 2;
constexpr size_t OFF_WOT1 = 0;
constexpr size_t OFF_WT0  = OFF_WOT1 + (size_t)2048 * 2048 * 2;
constexpr size_t OFF_WT1  = OFF_WT0 + (size_t)6144 * 2048 * 2;
constexpr size_t OFF_WOT0 = OFF_WT1 + (size_t)8704 * 2048 * 2;
constexpr size_t OFF_WUQ  = OFF_WOT0 + (size_t)2048 * 2048 * 2;
constexpr size_t OFF_WUKV = OFF_WUQ + (size_t)1536 * 512 * 2;
constexpr size_t OFF_W2T  = OFF_WUKV + (size_t)2048 * 256 * 2;
constexpr size_t OFF_A2T  = OFF_W2T + (size_t)2 * 2048 * 128 * 2;
constexpr size_t END_W    = OFF_A2T + (size_t)2 * 2048 * 128 * 2;
constexpr size_t OFF_YZ   = OFF_WT0;
static_assert(OFF_YZ + 2 * SZ_H <= END_W, "yz alias");
constexpr size_t OFF_MOD  = END_W;
constexpr size_t OFF_ROPE = OFF_MOD + (size_t)2 * 5 * 6144 * 4;
constexpr size_t OFF_BN   = OFF_ROPE + 64 * 16 * 8;
constexpr size_t OFF_H    = OFF_BN + (size_t)2 * 8192 * 32 * 4;
constexpr size_t OFF_C    = OFF_H + SZ_H;
constexpr size_t SZ_C     = (size_t)8192 * 8576 * 2;
constexpr size_t OFF_QD   = OFF_C;
constexpr size_t OFF_KD   = OFF_QD + (size_t)8192 * 1024 * 2;
constexpr size_t OFF_VD   = OFF_KD + (size_t)10240 * 1024 * 2;
constexpr size_t OFF_CQR  = OFF_VD + (size_t)10240 * 1024 * 2;
constexpr size_t OFF_CKVR = OFF_CQR + (size_t)8192 * 512 * 2;
constexpr size_t OFF_KPE  = OFF_CKVR + (size_t)8192 * 256 * 4;
constexpr size_t OFF_SG0  = OFF_KPE + (size_t)10240 * 64 * 2;
static_assert(OFF_SG0 + SZ_H <= OFF_C + SZ_C, "region C");
constexpr size_t OFF_E    = OFF_C + SZ_C;
constexpr size_t OFF_PART = OFF_E;
constexpr size_t OFF_AZ   = OFF_E;
constexpr size_t OFF_EZ   = OFF_E + 2 * SZ_H;
constexpr size_t SZ_E     = 4 * SZ_H;
constexpr size_t OFF_CQN  = OFF_E;
constexpr size_t OFF_CKVA = OFF_CQN + (size_t)8192 * 512 * 2;
constexpr size_t OFF_QB   = OFF_CKVA + (size_t)10240 * 256 * 2;
constexpr size_t OFF_KVB  = OFF_QB + (size_t)8192 * 1536 * 2;
static_assert(OFF_KVB + (size_t)10240 * 2048 * 2 <= OFF_E + SZ_E, "region E");
constexpr size_t OFF_BAR = OFF_E + SZ_E;
constexpr size_t WS_NEEDED = OFF_BAR + 16384;
constexpr size_t OFF_WDT = OFF_H;
constexpr size_t OFF_ADT = OFF_H + (size_t)2 * 8192 * 128 * 2;

constexpr size_t OUT_Y = 0, OUT_AK = 16777216, OUT_AV = 20971520, OUT_CKV = 25165824, OUT_KPE = 26214400, OUT_SF = 26476544, OUT_SB = 28573696;

struct Params {
    const float* in[34];
    float* out;
    unsigned char* ws;
};
struct KArgs { const void* a[36]; };

DI unsigned pk2(float a, float b) { f32x2 v = {a, b}; nbf2 r = __builtin_convertvector(v, nbf2); return __builtin_bit_cast(unsigned, r); }
DI float bflo(unsigned u) { return __uint_as_float(u << 16); }
DI float bfhi(unsigned u) { return __uint_as_float(u & 0xffff0000u); }
DI void st_bf4(bf16_t* p, f32x4 v) { u32x2 r = {pk2(v[0], v[1]), pk2(v[2], v[3])}; *(u32x2*)p = r; }
DI void st_f4(float* p, f32x4 v) { *(f32x4*)p = v; }
DI void st_f4_nt(float* p, f32x4 v) { __builtin_nontemporal_store(v, (f32x4*)p); }
DI f32x4 ld_f4(const float* p) { return *(const f32x4*)p; }
DI f32x4 ld_f4_nt(const float* p) { return __builtin_nontemporal_load((const f32x4*)p); }
DI f32x4 bf4_to_f4(u32x2 u) { f32x4 r = {bflo(u[0]), bfhi(u[0]), bflo(u[1]), bfhi(u[1])}; return r; }
DI float dpp_xor1(float x) { return __int_as_float(__builtin_amdgcn_mov_dpp(__float_as_int(x), 0xB1, 0xF, 0xF, true)); }
DI float dpp_xor2(float x) { return __int_as_float(__builtin_amdgcn_mov_dpp(__float_as_int(x), 0x4E, 0xF, 0xF, true)); }
DI float dpp_hmirror(float x) { return __int_as_float(__builtin_amdgcn_mov_dpp(__float_as_int(x), 0x141, 0xF, 0xF, true)); }
DI float dpp_mirror(float x) { return __int_as_float(__builtin_amdgcn_mov_dpp(__float_as_int(x), 0x140, 0xF, 0xF, true)); }
DI float shx(float x, int m, int lane) { return __int_as_float(__builtin_amdgcn_ds_bpermute((lane ^ m) << 2, __float_as_int(x))); }
DI float wave_sum(float x, int lane) {
    x += dpp_xor1(x); x += dpp_xor2(x); x += dpp_hmirror(x); x += dpp_mirror(x); x += shx(x, 16, lane); x += shx(x, 32, lane); return x;
}
DI float sum16d(float x) { x += dpp_xor1(x); x += dpp_xor2(x); x += dpp_hmirror(x); x += dpp_mirror(x); return x; }
DI float sigmoidf_(float x) { return __builtin_amdgcn_rcpf(1.f + __expf(-x)); }
DI int otid_(int wv) { int l; asm volatile("v_mbcnt_lo_u32_b32 %0, -1, 0\n\tv_mbcnt_hi_u32_b32 %0, -1, %0" : "=v"(l)); return (wv << 6) | l; }
#define otid() otid_(wv__)
DI int kvrow_of(int row) { return row < 4096 ? row : 4096 + ((row - 4096) >> 10) * 1536 + ((row - 4096) & 1023); }
DI int cond_of(int row) { return row < 4096 ? 0 : 1 + ((row - 4096) >> 10); }

constexpr int HTB = 128 * 64 * 2;
DI int lds_byte(int r, int c) { const int st = (r >> 4) * 2 + (c >> 5), rr = r & 15, cc = c & 31, ob = rr * 64 + cc * 2; return st * 1024 + (ob ^ (((ob >> 9) & 1) << 5)); }
DI void stage_rc(int b, int& R, int& C) { const int st = b / 1024, sb = b % 1024, swz = sb ^ (((sb >> 9) & 1) << 5); R = (st >> 1) * 16 + swz / 64; C = (st & 1) * 32 + (swz % 64) / 2; }

#define G_SA(b, h) (((b) * 2 + (h)) * HTB)
#define G_SB(b, h) ((4 + (b) * 2 + (h)) * HTB)
#define G_STAGE(bufoff, gbase) do { _Pragma("unroll") for (int _i = 0; _i < 2; ++_i) \
    __builtin_amdgcn_global_load_lds((const unsigned*)((const char*)(gbase) + voff[_i]), (LAS unsigned*)(lds + (bufoff) + ldsw + _i * 8192), 16, 0, 0); } while (0)
#define G_LDA(dst, b, h) do { _Pragma("unroll") for (int m = 0; m < 4; ++m) _Pragma("unroll") for (int k = 0; k < 2; ++k) dst[m][k] = *(const LAS bf16x8*)(lds + G_SA(b, h) + aoff + m * 2048 + k * 1024); } while (0)
#define G_LDB(dst, b, h) do { _Pragma("unroll") for (int n = 0; n < 2; ++n) _Pragma("unroll") for (int k = 0; k < 2; ++k) dst[n][k] = *(const LAS bf16x8*)(lds + G_SB(b, h) + boff + n * 2048 + k * 1024); } while (0)
#define G_MMA(ai, bj, At_, Bt_) do { __builtin_amdgcn_s_setprio(1); _Pragma("unroll") for (int m = 0; m < 4; ++m) _Pragma("unroll") for (int n = 0; n < 2; ++n) _Pragma("unroll") for (int k = 0; k < 2; ++k) \
    acc[ai][bj][m][n] = __builtin_amdgcn_mfma_f32_16x16x32_bf16(Bt_[n][k], At_[m][k], acc[ai][bj][m][n], 0, 0, 0); __builtin_amdgcn_s_setprio(0); } while (0)
#define G_WAIT_V(n) asm volatile("s_waitcnt vmcnt(" #n ")" ::: "memory")
#define G_WAIT_L(n) asm volatile("s_waitcnt lgkmcnt(" #n ")" ::: "memory")
#define G_BAR __builtin_amdgcn_s_barrier()
#define G_SCHED __builtin_amdgcn_sched_barrier(0)

template <class Epi>
DI void gemm_phase(LAS unsigned char* lds, const bf16_t* A, const bf16_t* Bt, int M, int N, int K, const Epi& E, const int wv__, int pitch = 0, int nsplit = 1) {
    if (pitch == 0) pitch = K;
    const int tid = otid(), wid = __builtin_amdgcn_readfirstlane(tid >> 6), lane = tid & 63, wr = wid >> 2, wc = wid & 3, fr = lane & 15, fq = lane >> 4;
    const int nt = K / 64, nM = M / 256, nN = N / 256, ntiles = nM * nN * nsplit;
    unsigned voff[2];
#pragma unroll
    for (int i = 0; i < 2; ++i) { int R, C; stage_rc(tid * 16 + i * 8192, R, C); voff[i] = (unsigned)(R * pitch + C) * 2u; }
    const size_t kstep = 128, hstep = (size_t)128 * pitch * 2;
    const unsigned ldsw = (unsigned)wid * 1024u;
    const int aoff = lds_byte(wr * 64 + fr, fq * 8), boff = lds_byte(wc * 32 + fr, fq * 8);
    int tile = blockIdx.x;
    if (tile >= ntiles) return;
    const char* cA; const char* cB; int pm, pnq;
#define G_TILE_PTRS(tl) do { const int ks_ = (tl) % nsplit, t2_ = (tl) / nsplit; pm = t2_ % nM; const int pn_ = t2_ / nM; pnq = pn_ + ks_ * nN; \
        cA = (const char*)A + (size_t)pm * 2 * hstep + (size_t)ks_ * K * 2; cB = (const char*)Bt + (size_t)pn_ * 2 * hstep + (size_t)ks_ * K * 2; } while (0)
    G_TILE_PTRS(tile);
    G_STAGE(G_SB(0, 0), cB); G_STAGE(G_SA(0, 0), cA); G_STAGE(G_SB(0, 1), cB + hstep); G_STAGE(G_SA(0, 1), cA + hstep);
    for (;;) {
        const int pm_cur = pm, pnq_cur = pnq;
        f32x4 acc[2][2][4][2];
#pragma unroll
        for (int a = 0; a < 2; ++a)
#pragma unroll
            for (int b = 0; b < 2; ++b)
#pragma unroll
                for (int m = 0; m < 4; ++m)
#pragma unroll
                    for (int n = 0; n < 2; ++n) acc[a][b][m][n] = (f32x4){0.f, 0.f, 0.f, 0.f};
        bf16x8 At[4][2], B0[2][2], B1[2][2];
        if (wr == 1) G_BAR;
        G_WAIT_V(4); G_BAR;
        G_STAGE(G_SB(1, 0), cB + kstep); G_STAGE(G_SA(1, 0), cA + kstep); G_STAGE(G_SB(1, 1), cB + hstep + kstep);
        G_WAIT_V(6); G_BAR;
        for (int t = 0; t < nt - 2; t += 2) {
            const char* a1 = cA + (size_t)(t + 1) * kstep;
            const char* a2 = cA + (size_t)(t + 2) * kstep; const char* b2 = cB + (size_t)(t + 2) * kstep;
            const char* a3 = a2 + kstep; const char* b3 = b2 + kstep;
            G_LDB(B0, 0, 0); G_SCHED; G_LDA(At, 0, 0); G_STAGE(G_SA(1, 1), a1 + hstep);
            G_WAIT_L(8); G_BAR; G_WAIT_L(0); G_MMA(0, 0, At, B0); G_BAR; G_SCHED;
            G_LDB(B1, 0, 1); G_STAGE(G_SB(0, 0), b2);
            G_BAR; G_WAIT_L(0); G_MMA(0, 1, At, B1); G_BAR;
            G_LDA(At, 0, 1); G_STAGE(G_SA(0, 0), a2);
            G_BAR; G_WAIT_L(0); G_MMA(1, 0, At, B0); G_BAR; G_SCHED;
            G_STAGE(G_SB(0, 1), b2 + hstep);
            G_WAIT_V(6); G_BAR; G_MMA(1, 1, At, B1); G_BAR;
            G_LDB(B0, 1, 0); G_SCHED; G_LDA(At, 1, 0); G_STAGE(G_SA(0, 1), a2 + hstep);
            G_WAIT_L(8); G_BAR; G_WAIT_L(0); G_MMA(0, 0, At, B0); G_BAR; G_SCHED;
            G_LDB(B1, 1, 1); G_STAGE(G_SB(1, 0), b3);
            G_BAR; G_WAIT_L(0); G_MMA(0, 1, At, B1); G_BAR;
            G_LDA(At, 1, 1); G_STAGE(G_SA(1, 0), a3);
            G_BAR; G_WAIT_L(0); G_MMA(1, 0, At, B0); G_BAR; G_SCHED;
            G_STAGE(G_SB(1, 1), b3 + hstep);
            G_WAIT_V(6); G_BAR; G_MMA(1, 1, At, B1); G_BAR;
        }
        {
            const char* a1 = cA + (size_t)(nt - 1) * kstep;
            G_LDB(B0, 0, 0); G_LDA(At, 0, 0); G_STAGE(G_SA(1, 1), a1 + hstep);
            G_BAR; G_WAIT_L(0); G_MMA(0, 0, At, B0); G_BAR;
            G_LDB(B1, 0, 1); G_BAR; G_WAIT_L(0); G_MMA(0, 1, At, B1); G_BAR;
            G_LDA(At, 0, 1); G_WAIT_V(4); G_BAR; G_WAIT_L(0); G_MMA(1, 0, At, B0); G_MMA(1, 1, At, B1); G_BAR;
        }
        {
            G_LDB(B0, 1, 0); G_LDA(At, 1, 0); G_WAIT_V(2); G_BAR; G_WAIT_L(0); G_MMA(0, 0, At, B0); G_BAR;
            G_LDB(B1, 1, 1); G_WAIT_V(0); G_BAR; G_WAIT_L(0); G_MMA(0, 1, At, B1); G_BAR;
            G_LDA(At, 1, 1); G_BAR; G_WAIT_L(0); G_MMA(1, 0, At, B0); G_MMA(1, 1, At, B1); G_BAR;
        }
        if (wr == 0) G_BAR;
        const int next = tile + (int)gridDim.x;
        if (next < ntiles) { G_TILE_PTRS(next); G_STAGE(G_SB(0, 0), cB); G_STAGE(G_SA(0, 0), cA); G_STAGE(G_SB(0, 1), cB + hstep); G_STAGE(G_SA(0, 1), cA + hstep); }
        E.run(acc, pm_cur, pnq_cur, wr, wc, fr, fq);
        if (next >= ntiles) break;
        tile = next;
    }
#undef G_TILE_PTRS
}

typedef f32x4 acc_t[2][2][4][2];
#define EPI_LOOP(...) _Pragma("unroll") for (int ai = 0; ai < 2; ++ai) _Pragma("unroll") for (int m = 0; m < 4; ++m) { const int row = pm * 256 + ai * 128 + wr * 64 + m * 16 + fr; \
    _Pragma("unroll") for (int bj = 0; bj < 2; ++bj) { const int col0 = pn * 256 + bj * 128 + wc * 32 + fq * 4; f32x4 v0 = acc[ai][bj][m][0], v1 = acc[ai][bj][m][1]; __VA_ARGS__ } }
struct RopeRegs { float fr[4]; };
DI void rope_preload(RopeRegs& R, int fq) {
#pragma unroll
    for (int j = 0; j < 4; ++j) R.fr[j] = __builtin_amdgcn_exp2f(-(float)(fq * 4 + j) * (13.287712379549449f / 16.f)) * 0.15915494309189535f;
}
DI void rope_rot(const RopeRegs& R, int pos, f32x4& a, f32x4& b) {
    const float pf = (float)pos;
#pragma unroll
    for (int j = 0; j < 4; ++j) {
        const float rev = pf * R.fr[j];
        const float c = __builtin_amdgcn_cosf(rev), sn = __builtin_amdgcn_sinf(rev);
        const float x1 = a[j], x2 = b[j]; a[j] = x1 * c - x2 * sn; b[j] = x1 * sn + x2 * c;
    }
}
struct Epi0 {
    bf16_t *QD, *KD, *VD, *CQR, *KPE, *SG; float *CKVR, *oak, *oav, *okpe; const f32x2* rope;
    DI void run(const acc_t& acc, int pm, int pn, int wr, int wc, int fr, int fq) const {
        const bool samp = pm >= 16;
        const int cb = pn * 256;
        const bool ropey = samp && (cb < 2048 || cb == 3840);
        RopeRegs RR; rope_preload(RR, fq); (void)ropey;
        const int prow0 = (((pm * 256) & 1023) >> 6) + wr;
        EPI_LOOP(
            const int kvr = kvrow_of(row);
            if (col0 < 2048 || (col0 >= 3840 && col0 < 3904)) {
                f32x4 r0 = v0, r1 = v1;
                if (samp) rope_rot(RR, ((col0 >> 5) & 1) ? (m * 16 + fr) : (prow0 + 2 * ai), r0, r1);
                if (col0 < 1024) { bf16_t* q = QD + (size_t)row * 1024 + col0; st_bf4(q, r0); st_bf4(q + 16, r1); }
                else if (col0 < 2048) {
                    const int c = col0 - 1024; bf16_t* q = KD + (size_t)kvr * 1024 + c; st_bf4(q, r0); st_bf4(q + 16, r1);
                    if (!samp) { float* o = oak + (size_t)row * 1024 + c; st_f4_nt(o, v0); st_f4_nt(o + 16, v1); }
                } else {
                    const int c = col0 - 3840; bf16_t* q = KPE + (size_t)kvr * 64 + c; st_bf4(q, r0); st_bf4(q + 16, r1);
                    if (!samp) { float* o = okpe + (size_t)row * 64 + c; st_f4_nt(o, v0); st_f4_nt(o + 16, v1); }
                }
            } else if (col0 < 3072) {
                const int c = col0 - 2048; bf16_t* q = VD + (size_t)kvr * 1024 + c; st_bf4(q, v0); st_bf4(q + 16, v1);
                if (!samp) { float* o = oav + (size_t)row * 1024 + c; st_f4_nt(o, v0); st_f4_nt(o + 16, v1); }
            } else if (col0 < 3584) {
                bf16_t* q = CQR + (size_t)row * 512 + (col0 - 3072); st_bf4(q, v0); st_bf4(q + 16, v1);
            } else if (col0 < 3840) {
                float* o = CKVR + (size_t)row * 256 + (col0 - 3584); st_f4(o, v0); st_f4(o + 16, v1);
            } else if (col0 < 5952) {
                f32x4 s0, s1;
                _Pragma("unroll") for (int j = 0; j < 4; ++j) { s0[j] = v0[j] * sigmoidf_(v0[j]); s1[j] = v1[j] * sigmoidf_(v1[j]); }
                bf16_t* q = SG + (size_t)row * 2048 + (col0 - 3904); st_bf4(q, s0); st_bf4(q + 16, s1);
            }
        )
    }
};
struct EpiQ {
    bf16_t* QB; const f32x2* rope;
    DI void run(const acc_t& acc, int pm, int pn, int wr, int wc, int fr, int fq) const {
        const bool samp = pm >= 16;
        RopeRegs RR; rope_preload(RR, fq);
        const int prow0 = (((pm * 256) & 1023) >> 6) + wr;
        EPI_LOOP(
            const int hh = col0 / 192; const int w = col0 - hh * 192;
            if (samp && w >= 128) rope_rot(RR, (((w - 128) >> 5) & 1) ? (m * 16 + fr) : (prow0 + 2 * ai), v0, v1);
            bf16_t* q = QB + (size_t)row * 1536 + col0; st_bf4(q, v0); st_bf4(q + 16, v1);
        )
    }
};
struct EpiBf {
    bf16_t* O; int ldc; int ncols;
    DI void run(const acc_t& acc, int pm, int pn, int wr, int wc, int fr, int fq) const {
        EPI_LOOP(
            if (col0 < ncols) { bf16_t* q = O + (size_t)row * ldc + col0; st_bf4(q, v0); st_bf4(q + 16, v1); }
        )
    }
};
struct EpiOut {
    const float* xp; const float* xs; float* xo; const float* modg;
    DI void run(const acc_t& acc, int pm, int pn, int wr, int wc, int fr, int fq) const {
        const int brow = pm * 256, cbase = pn * 256 + wc * 32 + fq * 4;
        const float* g = modg + cond_of(brow) * 6144 + cbase;
        f32x4 gg[2][2];
#pragma unroll
        for (int bj = 0; bj < 2; ++bj) { gg[bj][0] = ld_f4(g + bj * 128); gg[bj][1] = ld_f4(g + bj * 128 + 16); }
        const float* xi = (brow < 4096 ? xp + (size_t)brow * 2048 : xs + (size_t)(brow - 4096) * 2048) + (size_t)(wr * 64 + fr) * 2048 + cbase;
        float* xob = xo + (size_t)(brow + wr * 64 + fr) * 2048 + cbase;
        f32x4 xv[4][2][2][2];
#define EO_LOAD(b) _Pragma("unroll") for (int mm = 0; mm < 2; ++mm) _Pragma("unroll") for (int bj = 0; bj < 2; ++bj) { \
            const float* q = xi + (size_t)(((b) >> 1) * 128 + (((b) & 1) * 2 + mm) * 16) * 2048 + bj * 128; xv[b][mm][bj][0] = ld_f4_nt(q); xv[b][mm][bj][1] = ld_f4_nt(q + 16); }
#define EO_STORE(b) _Pragma("unroll") for (int mm = 0; mm < 2; ++mm) _Pragma("unroll") for (int bj = 0; bj < 2; ++bj) { \
            float* o = xob + (size_t)(((b) >> 1) * 128 + (((b) & 1) * 2 + mm) * 16) * 2048 + bj * 128; \
            st_f4(o, xv[b][mm][bj][0] + gg[bj][0] * acc[(b) >> 1][bj][((b) & 1) * 2 + mm][0]); st_f4(o + 16, xv[b][mm][bj][1] + gg[bj][1] * acc[(b) >> 1][bj][((b) & 1) * 2 + mm][1]); }
        EO_LOAD(0) EO_LOAD(1) EO_STORE(0) EO_LOAD(2) EO_STORE(1) EO_LOAD(3) EO_STORE(2) EO_STORE(3)
#undef EO_LOAD
#undef EO_STORE
    }
};
struct EpiGate {
    bf16_t* O; const float* modg;
    DI void run(const acc_t& acc, int pm, int pn, int wr, int wc, int fr, int fq) const {
        const float* g = modg + cond_of(pm * 256) * 6144 + pn * 256 + wc * 32 + fq * 4;
        f32x4 gg[2][2];
#pragma unroll
        for (int bj = 0; bj < 2; ++bj) { gg[bj][0] = ld_f4(g + bj * 128); gg[bj][1] = ld_f4(g + bj * 128 + 16); }
        EPI_LOOP(
            bf16_t* q = O + (size_t)row * 2048 + col0; st_bf4(q, gg[bj][0] * v0); st_bf4(q + 16, gg[bj][1] * v1);
        )
    }
};
typedef _Float16 h16x2 __attribute__((ext_vector_type(2)));
DI unsigned pkh2(float a, float b) { f32x2 v = {a, b}; h16x2 r = __builtin_convertvector(v, h16x2); return __builtin_bit_cast(unsigned, r); }
DI float h2f_(unsigned short h) { return (float)__builtin_bit_cast(_Float16, h); }
DI f32x4 h4_to_f4(u32x2 u) { const unsigned u0 = u[0], u1 = u[1]; f32x4 r = {h2f_((unsigned short)(u0 & 0xffffu)), h2f_((unsigned short)(u0 >> 16)), h2f_((unsigned short)(u1 & 0xffffu)), h2f_((unsigned short)(u1 >> 16))}; return r; }
template <int CTRL> DI float dpp_rowshift0(float x) { return __int_as_float(__builtin_amdgcn_update_dpp(0, __float_as_int(x), CTRL, 0xF, 0xF, true)); }
struct EpiDecay {
    bf16_t* O; const float* bias; int rev;
    DI void run(const acc_t& acc, int pm, int pn, int wr, int wc, int fr, int fq) const {
        const float* bp = bias + pn * 256 + wc * 32 + fq * 4;
        f32x4 bb[2][2];
#pragma unroll
        for (int bj = 0; bj < 2; ++bj) { bb[bj][0] = ld_f4(bp + bj * 128); bb[bj][1] = ld_f4(bp + bj * 128 + 16); }
        EPI_LOOP(
            f32x4 r0; f32x4 r1;
            _Pragma("unroll") for (int j = 0; j < 4; ++j) {
                float a = 0.6065306597126334f * sigmoidf_(bb[bj][0][j] + v0[j]); float b = 0.6065306597126334f * sigmoidf_(bb[bj][1][j] + v1[j]);
                if (rev) {
                    a += dpp_rowshift0<0x101>(a); a += dpp_rowshift0<0x102>(a); a += dpp_rowshift0<0x104>(a); a += dpp_rowshift0<0x108>(a);
                    b += dpp_rowshift0<0x101>(b); b += dpp_rowshift0<0x102>(b); b += dpp_rowshift0<0x104>(b); b += dpp_rowshift0<0x108>(b);
                } else {
                    a += dpp_rowshift0<0x111>(a); a += dpp_rowshift0<0x112>(a); a += dpp_rowshift0<0x114>(a); a += dpp_rowshift0<0x118>(a);
                    b += dpp_rowshift0<0x111>(b); b += dpp_rowshift0<0x112>(b); b += dpp_rowshift0<0x114>(b); b += dpp_rowshift0<0x118>(b);
                }
                r0[j] = a; r1[j] = b;
            }
            bf16_t* q = O + (size_t)row * 2048 + col0;
            { u32x2 u = {pkh2(r0[0], r0[1]), pkh2(r0[2], r0[3])}; *(u32x2*)q = u; }
            { u32x2 u = {pkh2(r1[0], r1[1]), pkh2(r1[2], r1[3])}; *(u32x2*)(q + 16) = u; }
        )
    }
};
struct EpiLora {
    bf16_t* O; const float* bias; float mul;
    DI void run(const acc_t& acc, int pm, int pn, int wr, int wc, int fr, int fq) const {
        const float* bp = bias + pn * 256 + wc * 32 + fq * 4;
        f32x4 bb[2][2];
#pragma unroll
        for (int bj = 0; bj < 2; ++bj) { bb[bj][0] = ld_f4(bp + bj * 128); bb[bj][1] = ld_f4(bp + bj * 128 + 16); }
        EPI_LOOP(
            f32x4 r0, r1;
            _Pragma("unroll") for (int j = 0; j < 4; ++j) { r0[j] = mul * sigmoidf_(bb[bj][0][j] + v0[j]); r1[j] = mul * sigmoidf_(bb[bj][1][j] + v1[j]); }
            bf16_t* q = O + (size_t)row * 2048 + col0; st_bf4(q, r0); st_bf4(q + 16, r1);
        )
    }
};

DI void transpose_tile(LAS float* tl, const float* src, int K, int N, bf16_t* dst, int Kpad, int kt, int ntile, const int wv__) {
    const int tid = otid(), k0 = kt * 64, n0 = ntile * 256;
    const int kr = tid >> 6, nc = (tid & 63) * 4;
    f32x4 v[8];
#pragma unroll
    for (int i = 0; i < 8; ++i) {
        const int k = k0 + kr + i * 8;
        v[i] = (f32x4){0.f, 0.f, 0.f, 0.f};
        if (k < K && n0 + nc < N) v[i] = ld_f4_nt(src + (size_t)k * N + n0 + nc);
    }
#pragma unroll
    for (int i = 0; i < 8; ++i) {
        LAS float* t = tl + (kr + i * 8) * 257 + nc;
        t[0] = v[i][0]; t[1] = v[i][1]; t[2] = v[i][2]; t[3] = v[i][3];
    }
    __syncthreads();
    const int kc = (tid & 7) * 8;
#pragma unroll
    for (int i = 0; i < 4; ++i) {
        const int n = (tid >> 3) + i * 64;
        float e[8];
#pragma unroll
        for (int j = 0; j < 8; ++j) e[j] = tl[(kc + j) * 257 + n];
        u32x4 o = {pk2(e[0], e[1]), pk2(e[2], e[3]), pk2(e[4], e[5]), pk2(e[6], e[7])};
        *(u32x4*)(dst + (size_t)(n0 + n) * Kpad + k0 + kc) = o;
    }
    __syncthreads();
}
DI void cvt_cache(const float* src, bf16_t* dst, int W, int item, const int wv__) {
    const size_t e = (size_t)item * 4096 + otid() * 8;
    const int srow = (int)(e / W), c = (int)(e % W);
    const int b = srow >> 9, s = srow & 511;
    const int drow = 4096 + b * 1536 + 1024 + s;
    const f32x4 a = ld_f4_nt(src + e), bb = ld_f4_nt(src + e + 4);
    u32x4 o = {pk2(a[0], a[1]), pk2(a[2], a[3]), pk2(bb[0], bb[1]), pk2(bb[2], bb[3])};
    *(u32x4*)(dst + (size_t)drow * W + c) = o;
}
DI void mod_job(const Params& p, LAS unsigned char* lds, int item, const int wv__) {
    LAS float* sl = (LAS float*)lds;
    LAS float* red = sl + 5 * 2048;
    const int tid = otid();
    const float* cc = p.in[8]; const float* cctx = p.in[9];
    for (int i = tid; i < 5 * 2048; i += NTHREADS) { const int cnd = i >> 11, k = i & 2047; const float c = cnd == 0 ? cctx[k] : cc[(cnd - 1) * 2048 + k]; sl[i] = c * sigmoidf_(c); }
    __syncthreads();
    const int l = item / 192, n0 = (item % 192) * 32;
    const int kg = tid >> 3, cl = (tid & 7) * 4;
    const float* W = p.in[10] + (size_t)l * 2048 * 6144 + n0 + cl;
    f32x4 acc[5];
#pragma unroll
    for (int c = 0; c < 5; ++c) acc[c] = (f32x4){0.f, 0.f, 0.f, 0.f};
#pragma unroll 8
    for (int pass = 0; pass < 32; ++pass) {
        const int k = pass * 64 + kg;
        const f32x4 w = ld_f4_nt(W + (size_t)k * 6144);
#pragma unroll
        for (int c = 0; c < 5; ++c) acc[c] += sl[c * 2048 + k] * w;
    }
#pragma unroll
    for (int c = 0; c < 5; ++c)
#pragma unroll
        for (int j = 0; j < 4; ++j) red[kg * 160 + c * 32 + cl + j] = acc[c][j];
    __syncthreads();
    if (tid < 160) {
        float s = 0.f;
        for (int g = 0; g < 64; ++g) s += red[g * 160 + tid];
        const int cnd = tid >> 5, c = tid & 31;
        float* mod = (float*)(p.ws + OFF_MOD);
        mod[(size_t)(l * 5 + cnd) * 6144 + n0 + c] = s + p.in[11][l * 6144 + n0 + c];
    }
    __syncthreads();
}
DI void prep_phase(const Params& p, LAS unsigned char* lds, const int wv__) {
    constexpr int J_MOD = 384;
    constexpr int J_T0 = 32 * 24, J_T1 = 32 * 34, J_TO = 32 * 8, J_TUQ = 8 * 6, J_TUKV = 4 * 8, J_TL = 2 * 8;
    constexpr int J_CK = 512, J_CV = 512, J_CC = 128, J_CP = 32;
    constexpr int TOTAL = J_MOD + J_T0 + J_T1 + 2 * J_TO + J_TUQ + J_TUKV + 4 * J_TL + J_CK + J_CV + J_CC + J_CP + 1;
    LAS float* tl = (LAS float*)lds;
    for (int job = blockIdx.x; job < TOTAL + 384; job += gridDim.x) {
        int j = job;
        if (gridDim.x == 256) {
            if (job >= 512 && job < 1280) { if ((job & 255) < 128) continue; j = job - (((job - 512) >> 8) * 128 + 128); }
            else if (job >= 1280) j = job - 384;
        } else if (job >= TOTAL) continue;
        if (j < J_MOD) { mod_job(p, lds, j, wv__); continue; } j -= J_MOD;
        if (j < J_T0) { transpose_tile(tl, p.in[14], 2048, 5952, (bf16_t*)(p.ws + OFF_WT0), 2048, j % 32, j / 32, wv__); continue; } j -= J_T0;
        if (j < J_T1) { transpose_tile(tl, p.in[22], 2048, 8576, (bf16_t*)(p.ws + OFF_WT1), 2048, j % 32, j / 32, wv__); continue; } j -= J_T1;
        if (j < J_TO) { transpose_tile(tl, p.in[15], 2048, 2048, (bf16_t*)(p.ws + OFF_WOT0), 2048, j % 32, j / 32, wv__); continue; } j -= J_TO;
        if (j < J_TO) { transpose_tile(tl, p.in[23], 2048, 2048, (bf16_t*)(p.ws + OFF_WOT1), 2048, j % 32, j / 32, wv__); continue; } j -= J_TO;
        if (j < J_TUQ) { transpose_tile(tl, p.in[19], 512, 1536, (bf16_t*)(p.ws + OFF_WUQ), 512, j % 8, j / 8, wv__); continue; } j -= J_TUQ;
        if (j < J_TUKV) { transpose_tile(tl, p.in[21], 256, 2048, (bf16_t*)(p.ws + OFF_WUKV), 256, j % 4, j / 4, wv__); continue; } j -= J_TUKV;
        if (j < 4 * J_TL) {
            const int which = j / J_TL, jj = j % J_TL, z = which & 1;
            const float* src = (which < 2 ? p.in[26] : p.in[28]) + (size_t)z * 96 * 2048;
            bf16_t* dst = (bf16_t*)(p.ws + (which < 2 ? OFF_W2T : OFF_A2T)) + (size_t)z * 2048 * 128;
            transpose_tile(tl, src, 96, 2048, dst, 128, jj % 2, jj / 2, wv__); continue;
        } j -= 4 * J_TL;
        if (j < J_CK) { cvt_cache(p.in[2], (bf16_t*)(p.ws + OFF_KD), 1024, j, wv__); continue; } j -= J_CK;
        if (j < J_CV) { cvt_cache(p.in[3], (bf16_t*)(p.ws + OFF_VD), 1024, j, wv__); continue; } j -= J_CV;
        if (j < J_CC) { cvt_cache(p.in[4], (bf16_t*)(p.ws + OFF_CKVA), 256, j, wv__); continue; } j -= J_CC;
        if (j < J_CP) { cvt_cache(p.in[5], (bf16_t*)(p.ws + OFF_KPE), 64, j, wv__); continue; } j -= J_CP;
        {
            f32x2* tab = (f32x2*)(p.ws + OFF_ROPE);
            for (int i = otid(); i < 1024; i += NTHREADS) {
                const int pos = i >> 4, fi = i & 15;
                const float f = powf(10000.f, -(float)fi / 16.f);
                const float ang = (float)pos * f;
                f32x2 t = {cosf(ang), sinf(ang)};
                tab[i] = t;
            }
        }
    }
}

DI void norm_mod_phase(const float* xp, const float* xs, const float* g, const float* modl, bf16_t* H, const int wv__) {
    const int tid_ = otid(), lane = tid_ & 63, wg = blockIdx.x * 8 + (tid_ >> 6), nw = gridDim.x * 8;
    for (int row = wg; row < 8192; row += nw) {
        const float* x = row < 4096 ? xp + (size_t)row * 2048 : xs + (size_t)(row - 4096) * 2048;
        const float* md = modl + cond_of(row) * 6144;
        f32x4 v[8]; float ss = 0.f;
#pragma unroll
        for (int i = 0; i < 8; ++i) { v[i] = ld_f4_nt(x + i * 256 + lane * 4); ss += v[i][0] * v[i][0] + v[i][1] * v[i][1] + v[i][2] * v[i][2] + v[i][3] * v[i][3]; }
        f32x4 gs[8], sh[8];
#pragma unroll
        for (int i = 0; i < 8; ++i) { const int c = i * 256 + lane * 4; gs[i] = ld_f4(g + c) * (1.f + ld_f4(md + 2048 + c)); sh[i] = ld_f4(md + c); }
        ss = wave_sum(ss, lane);
        const float rstd = rsqrtf(ss * (1.f / 2048.f) + 1e-6f);
#pragma unroll
        for (int i = 0; i < 8; ++i) {
            const int c = i * 256 + lane * 4;
            const f32x4 h = v[i] * rstd * gs[i] + sh[i];
            st_bf4(H + (size_t)row * 2048 + c, h);
        }
    }
}
DI void final_norm_phase(float* x, const bf16_t* O2, const float* g, const int wv__) {
    const int tid_ = otid(), lane = tid_ & 63, wg = blockIdx.x * 8 + (tid_ >> 6), nw = gridDim.x * 8;
    for (int row = wg; row < 8192; row += nw) {
        float* xr = x + (size_t)row * 2048;
        f32x4 v[8]; float ss = 0.f;
#pragma unroll
        for (int i = 0; i < 8; ++i) { v[i] = ld_f4_nt(xr + i * 256 + lane * 4) + bf4_to_f4(__builtin_nontemporal_load((const u32x2*)(O2 + (size_t)row * 2048 + i * 256 + lane * 4))); ss += v[i][0] * v[i][0] + v[i][1] * v[i][1] + v[i][2] * v[i][2] + v[i][3] * v[i][3]; }
        ss = wave_sum(ss, lane);
        const float rstd = rsqrtf(ss * (1.f / 2048.f) + 1e-6f);
#pragma unroll
        for (int i = 0; i < 8; ++i) { const int c = i * 256 + lane * 4; st_f4_nt(xr + c, v[i] * rstd * ld_f4(g + c)); }
    }
}
DI void lat_norm_phase(const Params& p, const int wv__) {
    const int tid_ = otid(), lane = tid_ & 63, wg = blockIdx.x * 8 + (tid_ >> 6), nw = gridDim.x * 8;
    const bf16_t* CQR = (const bf16_t*)(p.ws + OFF_CQR); const float* CKVR = (const float*)(p.ws + OFF_CKVR);
    bf16_t* CQN = (bf16_t*)(p.ws + OFF_CQN); bf16_t* CKVA = (bf16_t*)(p.ws + OFF_CKVA);
    const float* qg = p.in[18]; const float* kg = p.in[20];
    for (int row = wg; row < 8192; row += nw) {
        const u32x4 u = __builtin_nontemporal_load((const u32x4*)(CQR + (size_t)row * 512 + lane * 8));
        float q[8] = {bflo(u[0]), bfhi(u[0]), bflo(u[1]), bfhi(u[1]), bflo(u[2]), bfhi(u[2]), bflo(u[3]), bfhi(u[3])};
        float ss = 0.f;
#pragma unroll
        for (int i = 0; i < 8; ++i) ss += q[i] * q[i];
        ss = wave_sum(ss, lane);
        float rstd = rsqrtf(ss * (1.f / 512.f) + 1e-6f);
        const f32x4 g0 = ld_f4(qg + lane * 8), g1 = ld_f4(qg + lane * 8 + 4);
        u32x4 o = {pk2(q[0] * rstd * g0[0], q[1] * rstd * g0[1]), pk2(q[2] * rstd * g0[2], q[3] * rstd * g0[3]),
                   pk2(q[4] * rstd * g1[0], q[5] * rstd * g1[1]), pk2(q[6] * rstd * g1[2], q[7] * rstd * g1[3])};
        *(u32x4*)(CQN + (size_t)row * 512 + lane * 8) = o;
        const f32x4 kv = ld_f4_nt(CKVR + (size_t)row * 256 + lane * 4);
        float s2 = kv[0] * kv[0] + kv[1] * kv[1] + kv[2] * kv[2] + kv[3] * kv[3];
        s2 = wave_sum(s2, lane);
        rstd = rsqrtf(s2 * (1.f / 256.f) + 1e-6f);
        const f32x4 r = kv * rstd * ld_f4(kg + lane * 4);
        if (row < 4096) st_f4_nt(p.out + OUT_CKV + (size_t)row * 256 + lane * 4, r);
        st_bf4(CKVA + (size_t)kvrow_of(row) * 256 + lane * 4, r);
    }
}

template <int TYPE>
DI void attn_unit(const Params& p, LAS unsigned char* lds, int samp, int b, int h, int qb, float lam, const int wv__) {
    constexpr int NC = TYPE == 0 ? 2 : 1, KS = TYPE == 0 ? 2 : 6, KDIM = TYPE == 0 ? 128 : 192;
    constexpr int KP = KDIM * 2 + 16, VP = 288, CPK = KDIM / 8, NKC = 64 * CPK / NTHREADS;
    LAS unsigned char* Ks = lds; LAS unsigned char* Vs = lds + 64 * KP;
    const int tid = otid(), wid = tid >> 6, lane = tid & 63, fr = lane & 15, fq = lane >> 4;
    const int row0 = samp ? 4096 + b * 1024 + qb * 128 : b * 256 + qb * 128, qrow = row0 + wid * 16 + fr;
    const int kv0 = samp ? 4096 + b * 1536 : b * 256, ntile = samp ? 24 : 4;
    const bf16_t* QD = (const bf16_t*)(p.ws + OFF_QD); const bf16_t* KD = (const bf16_t*)(p.ws + OFF_KD); const bf16_t* VD = (const bf16_t*)(p.ws + OFF_VD);
    const bf16_t* QB = (const bf16_t*)(p.ws + OFF_QB); const bf16_t* KVB = (const bf16_t*)(p.ws + OFF_KVB); const bf16_t* KPE = (const bf16_t*)(p.ws + OFF_KPE);
    bf16x8 qf[NC * KS];
#pragma unroll
    for (int i = 0; i < NC * KS; ++i)
        qf[i] = TYPE == 0 ? *(const bf16x8*)(QD + (size_t)qrow * 1024 + h * 128 + i * 32 + fq * 8) : *(const bf16x8*)(QB + (size_t)qrow * 1536 + h * 192 + i * 32 + fq * 8);
    f32x4 o[NC][8];
    float mrun[NC], lrun[NC];
#pragma unroll
    for (int c = 0; c < NC; ++c) { mrun[c] = -1e30f; lrun[c] = 0.f;
#pragma unroll
        for (int v = 0; v < 8; ++v) o[c][v] = (f32x4){0.f, 0.f, 0.f, 0.f}; }
    const float sl2 = (TYPE == 0 ? 0.125f : 0.07216878364870322f) * 1.4426950408889634f;
    u32x4 kreg[NKC], vreg[2];
    auto prefetch = [&](int t) {
#pragma unroll
        for (int i = 0; i < NKC; ++i) {
            const int q = tid + i * NTHREADS, key = q / CPK, ch = q % CPK; const size_t r = (size_t)(kv0 + t * 64 + key);
            const bf16_t* src;
            if (TYPE == 0) src = KD + r * 1024 + h * 128 + ch * 8;
            else src = ch < 16 ? KVB + r * 2048 + h * 256 + ch * 8 : KPE + r * 64 + (ch - 16) * 8;
            kreg[i] = *(const u32x4*)src;
        }
#pragma unroll
        for (int i = 0; i < 2; ++i) {
            const int q = tid + i * NTHREADS, key = q >> 4, ch = q & 15; const size_t r = (size_t)(kv0 + t * 64 + key);
            const bf16_t* src = TYPE == 0 ? VD + r * 1024 + h * 128 + ch * 8 : KVB + r * 2048 + h * 256 + 128 + ch * 8;
            vreg[i] = *(const u32x4*)src;
        }
    };
    constexpr int BUFB = 64 * KP + 64 * VP;
    auto lds_write = [&](int buf) {
        LAS unsigned char* Kb = lds + buf * BUFB; LAS unsigned char* Vb = Kb + 64 * KP;
#pragma unroll
        for (int i = 0; i < NKC; ++i) { const int q = tid + i * NTHREADS, key = q / CPK, ch = q % CPK; *(LAS u32x4*)(Kb + key * KP + ch * 16) = kreg[i]; }
#pragma unroll
        for (int i = 0; i < 2; ++i) { const int q = tid + i * NTHREADS, key = q >> 4, ch = q & 15; *(LAS u32x4*)(Vb + key * VP + ch * 16) = vreg[i]; }
    };
    prefetch(0);
    lds_write(0);
    if (ntile > 1) prefetch(1);
    __syncthreads();
    const int qq = (lane & 15) >> 2, pp = lane & 3;
    for (int t = 0; t < ntile; ++t) {
        if (t + 1 < ntile) lds_write((t + 1) & 1);
        if (t + 2 < ntile) prefetch(t + 2);
        LAS unsigned char* Kc = lds + (t & 1) * BUFB; LAS unsigned char* Vc = Kc + 64 * KP;
        f32x4 s[NC][4];
#pragma unroll
        for (int c = 0; c < NC; ++c)
#pragma unroll
            for (int nt = 0; nt < 4; ++nt) {
                s[c][nt] = (f32x4){0.f, 0.f, 0.f, 0.f};
#pragma unroll
                for (int ks = 0; ks < KS; ++ks) {
                    const bf16x8 kf = *(const LAS bf16x8*)(Kc + (nt * 16 + fr) * KP + (c * KS + ks) * 64 + fq * 16);
                    s[c][nt] = __builtin_amdgcn_mfma_f32_16x16x32_bf16(kf, qf[c * KS + ks], s[c][nt], 0, 0, 0);
                }
                if (nt & 1) __builtin_amdgcn_sched_barrier(0);
            }
        __builtin_amdgcn_sched_barrier(0);
        bf16x8 pb[NC][2];
#pragma unroll
        for (int c = 0; c < NC; ++c) {
            float mx = -1e30f;
#pragma unroll
            for (int nt = 0; nt < 4; ++nt)
#pragma unroll
                for (int j = 0; j < 4; ++j) mx = fmaxf(mx, s[c][nt][j]);
            mx = fmaxf(mx, shx(mx, 16, lane)); mx = fmaxf(mx, shx(mx, 32, lane));
            const float mnew = fmaxf(mrun[c], mx);
            const float alpha = __builtin_amdgcn_exp2f((mrun[c] - mnew) * sl2);
            mrun[c] = mnew;
            const float nm = -mnew * sl2;
            float ls = 0.f;
#pragma unroll
            for (int nt = 0; nt < 4; ++nt)
#pragma unroll
                for (int j = 0; j < 4; ++j) { const float e = __builtin_amdgcn_exp2f(fmaf(s[c][nt][j], sl2, nm)); s[c][nt][j] = e; ls += e; }
            lrun[c] = lrun[c] * alpha + ls;
            if (__builtin_amdgcn_ballot_w64(alpha != 1.f) != 0ull) {
#pragma unroll
                for (int v = 0; v < 8; ++v) o[c][v] *= alpha;
            }
#pragma unroll
            for (int s2 = 0; s2 < 2; ++s2) {
                u32x4 u = {pk2(s[c][2 * s2][0], s[c][2 * s2][1]), pk2(s[c][2 * s2][2], s[c][2 * s2][3]), pk2(s[c][2 * s2 + 1][0], s[c][2 * s2 + 1][1]), pk2(s[c][2 * s2 + 1][2], s[c][2 * s2 + 1][3])};
                pb[c][s2] = __builtin_bit_cast(bf16x8, u);
            }
        }
#pragma unroll
        for (int s2 = 0; s2 < 2; ++s2)
#pragma unroll
            for (int v = 0; v < 8; ++v) {
                LAS unsigned char* a0 = Vc + (32 * s2 + 4 * fq + qq) * VP + v * 32 + 8 * pp;
                const s16x4 lo = __builtin_amdgcn_ds_read_tr16_b64_v4i16((LAS s16x4*)a0);
                const s16x4 hi = __builtin_amdgcn_ds_read_tr16_b64_v4i16((LAS s16x4*)(a0 + 16 * VP));
                const bf16x8 va = __builtin_shufflevector(lo, hi, 0, 1, 2, 3, 4, 5, 6, 7);
#pragma unroll
                for (int c = 0; c < NC; ++c) o[c][v] = __builtin_amdgcn_mfma_f32_16x16x32_bf16(va, pb[c][s2], o[c][v], 0, 0, 0);
                if ((v & 1) == 1) __builtin_amdgcn_sched_barrier(0);
            }
        __syncthreads();
    }
    float linv[NC];
#pragma unroll
    for (int c = 0; c < NC; ++c) { float l = lrun[c]; l += shx(l, 16, lane); l += shx(l, 32, lane); linv[c] = 1.f / l; }
    const bf16_t* SG = (const bf16_t*)(p.ws + OFF_SG0);
    bf16_t* Y = (bf16_t*)(p.ws + OFF_H);
    if (TYPE == 0) {
        float ss = 0.f;
#pragma unroll
        for (int v = 0; v < 8; ++v)
#pragma unroll
            for (int j = 0; j < 4; ++j) { const float x = o[0][v][j] * linv[0] - lam * o[NC - 1][v][j] * linv[NC - 1]; o[0][v][j] = x; ss += x * x; }
        ss += shx(ss, 16, lane); ss += shx(ss, 32, lane);
        const float rstd = rsqrtf(ss * (1.f / 128.f) + 1e-6f) * 0.8f;
        const float* sg = p.in[17];
#pragma unroll
        for (int v = 0; v < 8; ++v) {
            const int d = v * 16 + fq * 4;
            const f32x4 g = ld_f4(sg + d);
            const f32x4 gt = bf4_to_f4(*(const u32x2*)(SG + (size_t)qrow * 2048 + h * 128 + d));
            st_bf4(Y + (size_t)qrow * 2048 + h * 128 + d, o[0][v] * rstd * g * gt);
        }
    } else {
#pragma unroll
        for (int v = 0; v < 8; ++v) {
            const int d = v * 16 + fq * 4;
            const f32x4 gt = bf4_to_f4(*(const u32x2*)(SG + (size_t)qrow * 2048 + 1024 + h * 128 + d));
            st_bf4(Y + (size_t)qrow * 2048 + 1024 + h * 128 + d, o[0][v] * linv[0] * gt);
        }
    }
}
DI void attn_phase(const Params& p, LAS unsigned char* lds, const int wv__) {
    const float* lp = p.in[16];
    const int lane = otid() & 63;
    const float s01 = wave_sum(lp[lane] * lp[64 + lane], lane), s23 = wave_sum(lp[128 + lane] * lp[192 + lane], lane);
    const float lam = __expf(s01) - __expf(s23) + 0.2f;
    for (int u = blockIdx.x; u < 1024; u += gridDim.x) {
        const int grp = u >> 8, i = u & 255;
        if (grp == 0) attn_unit<0>(p, lds, 1, i >> 6, (i >> 3) & 7, i & 7, lam, wv__);
        else if (grp == 1) attn_unit<1>(p, lds, 1, i >> 6, (i >> 3) & 7, i & 7, lam, wv__);
        else if (grp == 2) attn_unit<0>(p, lds, 0, i >> 4, (i >> 1) & 7, i & 1, lam, wv__);
        else attn_unit<1>(p, lds, 0, i >> 4, (i >> 1) & 7, i & 1, lam, wv__);
    }
}

DI f32x4 tshift(f32x4 x, f32x4 pv, f32x4 nx, f32x4 m0, f32x4 m1) { return x + m0 * (pv - x) + m1 * (nx - x); }
DI void seq_pos(int row, int& t, int& T) { if (row < 4096) { t = row & 255; T = 256; } else { t = (row - 4096) & 1023; T = 1024; } }

DI void lora_in_phase(const Params& p, const int wv__) {
    const int tid_ = otid(), lane = tid_ & 63, wg = blockIdx.x * 8 + (tid_ >> 6), nw = gridDim.x * 8;
    const bf16_t* PART = (const bf16_t*)(p.ws + OFF_PART);
    const float* mu = p.in[24];
    const int o = lane * 8, arr = o >> 7, idx = o & 127;
    bf16_t* dstb = (bf16_t*)(p.ws + (arr < 2 ? OFF_WDT : OFF_ADT)) + (size_t)(arr & 1) * 8192 * 128 + idx;
    for (int row = wg; row < 8192; row += nw) {
        u32x4 res = {0u, 0u, 0u, 0u};
        if (idx < 96) {
            int t, T; seq_pos(row, t, T);
            const int col = 8192 + arr * 96 + idx;
            const bf16_t* c = PART + (size_t)row * 2048 + arr * 96 + idx;
            float xc[8], xp[8], xn[8];
#pragma unroll
            for (int e = 0; e < 8; ++e) { xc[e] = 0.f; xp[e] = 0.f; xn[e] = 0.f; }
#pragma unroll
            for (int ks = 0; ks < 4; ++ks) {
                const u32x4 uc = *(const u32x4*)(c + ks * 512);
#pragma unroll
                for (int e = 0; e < 4; ++e) { xc[2 * e] += bflo(uc[e]); xc[2 * e + 1] += bfhi(uc[e]); }
                if (t > 0) { const u32x4 up = *(const u32x4*)(c + ks * 512 - 2048);
#pragma unroll
                    for (int e = 0; e < 4; ++e) { xp[2 * e] += bflo(up[e]); xp[2 * e + 1] += bfhi(up[e]); } }
                if (t < T - 1) { const u32x4 un = *(const u32x4*)(c + ks * 512 + 2048);
#pragma unroll
                    for (int e = 0; e < 4; ++e) { xn[2 * e] += bflo(un[e]); xn[2 * e + 1] += bfhi(un[e]); } }
            }
            float r[8];
#pragma unroll
            for (int e = 0; e < 4; ++e) {
                const f32x2 m0 = *(const f32x2*)(mu + col + 2 * e), m1 = *(const f32x2*)(mu + 8576 + col + 2 * e);
                r[2 * e] = xc[2 * e] + m0[0] * (xp[2 * e] - xc[2 * e]) + m1[0] * (xn[2 * e] - xc[2 * e]);
                r[2 * e + 1] = xc[2 * e + 1] + m0[1] * (xp[2 * e + 1] - xc[2 * e + 1]) + m1[1] * (xn[2 * e + 1] - xc[2 * e + 1]);
            }
            if (arr < 2) {
#pragma unroll
                for (int e = 0; e < 8; ++e) r[e] = tanhf(r[e]);
            }
            res = (u32x4){pk2(r[0], r[1]), pk2(r[2], r[3]), pk2(r[4], r[5]), pk2(r[6], r[7])};
        }
        *(u32x4*)(dstb + (size_t)row * 128) = res;
    }
}

struct StageRegs { u32x2 raw[9], ra, re, rep; int row; };
DI void scan_stage_load(StageRegs& R, const bf16_t* C1, const bf16_t* AZ, const bf16_t* EZ, const float* mu, const float* kkw, const float* kaw, const float* rkw,
                        int row, int t, int T, int h, int z, int c4, bool first  ) {
    (void)mu; (void)kkw; (void)kaw; (void)rkw;
    R.row = row;
    const bf16_t* c = C1 + (size_t)row * 8576 + h * 64 + c4;
    const u32x2 zero = {0u, 0u};
#pragma unroll
    for (int g = 0; g < 3; ++g) {
        R.raw[g * 3 + 1] = *(const u32x2*)(c + g * 2048);
        R.raw[g * 3 + 0] = t > 0 ? *(const u32x2*)(c + g * 2048 - 8576) : zero;
        R.raw[g * 3 + 2] = t < T - 1 ? *(const u32x2*)(c + g * 2048 + 8576) : zero;
    }
    R.ra = __builtin_nontemporal_load((const u32x2*)(AZ + ((size_t)z * 8192 + row) * 2048 + h * 64 + c4));
    R.re = *(const u32x2*)(EZ + ((size_t)z * 8192 + row) * 2048 + h * 64 + c4);
    R.rep = first ? zero : *(const u32x2*)(EZ + ((size_t)z * 8192 + row + (z ? 1 : -1)) * 2048 + h * 64 + c4);
}
DI void scan_stage_store(const StageRegs& R, LAS float* sb, float* BN, bool lead, int h, int z, const LAS float* pt, bool wlast, LAS float* plast  ) {
    f32x4 x[3];
#pragma unroll
    for (int g = 0; g < 3; ++g) x[g] = tshift(bf4_to_f4(R.raw[g * 3 + 1]), bf4_to_f4(R.raw[g * 3 + 0]), bf4_to_f4(R.raw[g * 3 + 2]), *(const LAS f32x4*)(pt + (2 * g) * 64), *(const LAS f32x4*)(pt + (2 * g + 1) * 64));
    const f32x4 a = bf4_to_f4(R.ra), cs = h4_to_f4(R.re), cp = h4_to_f4(R.rep);
    const f32x4 kkr = x[1] * *(const LAS f32x4*)(pt + 6 * 64);
    float ss = kkr[0] * kkr[0] + kkr[1] * kkr[1] + kkr[2] * kkr[2] + kkr[3] * kkr[3];
    ss = sum16d(ss);
    const f32x4 kk = kkr * rsqrtf(fmaxf(ss, 1e-12f));
    const f32x4 kz = x[1] * (1.f + (a - 1.f) * *(const LAS f32x4*)(pt + 7 * 64));
    const f32x4 kka = kk * a;
    f32x4 pc, ip, pp;
#pragma unroll
    for (int j = 0; j < 4; ++j) { pc[j] = __expf(-cs[j]); ip[j] = __expf(cs[j]); pp[j] = __expf(-cp[j]); }
    const f32x4 rk = *(const LAS f32x4*)(pt + 8 * 64);
    float bn = x[0][0] * kz[0] * rk[0] + x[0][1] * kz[1] * rk[1] + x[0][2] * kz[2] * rk[2] + x[0][3] * kz[3] * rk[3];
    bn = sum16d(bn);
    if (lead) BN[((size_t)z * 8192 + R.row) * 32 + h] = bn;
    *(LAS f32x4*)(sb) = x[0] * pc; *(LAS f32x4*)(sb + 64) = kka * ip; *(LAS f32x4*)(sb + 128) = kz * ip; *(LAS f32x4*)(sb + 192) = -kk * pp; *(LAS f32x4*)(sb + 320) = x[2];
    if (wlast) *(LAS f32x4*)plast = pc;
}

DI void scan_phase(const Params& p, LAS unsigned char* lds, const int wv__) {
    const int tid = otid(), wid = __builtin_amdgcn_readfirstlane(tid >> 6), lane = tid & 63, half = wid >> 2, ht = tid & 255;
    const bf16_t* C1 = (const bf16_t*)(p.ws + OFF_C);
    const bf16_t* AZ = (const bf16_t*)(p.ws + OFF_AZ); const bf16_t* EZ = (const bf16_t*)(p.ws + OFF_EZ);
    bf16_t* YZ = (bf16_t*)(p.ws + OFF_YZ); float* BN = (float*)(p.ws + OFF_BN);
    const float* mu = p.in[24];
    LAS float* lf = (LAS float*)lds;
    for (int u = blockIdx.x; u < 256; u += gridDim.x) {
        if (half == 0) {
            const int rg = ht >> 3, cg8 = ht & 7, stt = ht >> 4, c4 = (ht & 15) * 4;
            const int b = u >> 6, h = (u >> 1) & 31, z = u & 1, T = 1024, rowbase = 4096 + b * 1024;
            LAS float* base = lf;
            LAS unsigned* ybase = (LAS unsigned*)(lf + 24576);
            f32x2 S[2][4];
            {
                const float* st = (z ? p.in[7] : p.in[6]) + (((size_t)b * 32 + h) * 64 + 2 * rg) * 64 + cg8 * 8;
#pragma unroll
                for (int rr = 0; rr < 2; ++rr) { const f32x4 v0 = ld_f4(st + rr * 64), v1 = ld_f4(st + rr * 64 + 4);
                    S[rr][0] = (f32x2){v0[0], v0[1]}; S[rr][1] = (f32x2){v0[2], v0[3]}; S[rr][2] = (f32x2){v1[0], v1[1]}; S[rr][3] = (f32x2){v1[2], v1[3]}; }
            }
            LAS float* ptab = lf + 26112;
            {
                if (ht < 16) {
                    const int hc = h * 64 + c4;
#pragma unroll
                    for (int g = 0; g < 3; ++g) { *(LAS f32x4*)(ptab + (2 * g) * 64 + c4) = ld_f4(mu + g * 2048 + hc); *(LAS f32x4*)(ptab + (2 * g + 1) * 64 + c4) = ld_f4(mu + 8576 + g * 2048 + hc); }
                    *(LAS f32x4*)(ptab + 6 * 64 + c4) = ld_f4(p.in[29] + hc); *(LAS f32x4*)(ptab + 7 * 64 + c4) = ld_f4(p.in[30] + hc); *(LAS f32x4*)(ptab + 8 * 64 + c4) = ld_f4(p.in[31] + hc);
                }
                __syncthreads();
            }
            StageRegs R;
            auto sload = [&](int ci, bool prm) { (void)prm; const int step = ci * 16 + stt, t = z ? T - 1 - step : step; scan_stage_load(R, C1, AZ, EZ, mu, p.in[29], p.in[30], p.in[31], rowbase + t, t, T, h, z, c4, stt == 0); };
            auto sstore = [&](int ci) { scan_stage_store(R, base + ((ci & 1) * 16 + stt) * 384 + c4, BN, (ht & 15) == 0, h, z, ptab + c4, stt == 15, base + (ci & 1) * 16 * 384 + 256 + c4); };
            auto flush = [&](int ci) {
                const LAS unsigned* yb = ybase + (ci & 1) * (16 * 32);
                const int fs = ht >> 4, fr4 = (ht & 15) * 2;
                const u32x2 yv = *(const LAS u32x2*)(yb + fs * 32 + fr4);
                const int step = ci * 16 + fs, t = z ? T - 1 - step : step;
                *(u32x2*)(YZ + ((size_t)z * 8192 + rowbase + t) * 2048 + h * 64 + fr4 * 2) = yv;
            };
            sload(0, true); sstore(0);
            __syncthreads();
            for (int ci = 0; ci < 64; ++ci) {
                if (ci > 0) flush(ci - 1);
                if (ci + 1 < 64) sload(ci + 1, false);
                const LAS float* cb = base + (ci & 1) * 16 * 384;
                LAS unsigned* ybuf = ybase + (ci & 1) * (16 * 32);
                f32x4 cur[8], nxt[8]; f32x2 vcur, vnxt;
                {
                    const LAS float* sb = cb + cg8 * 8;
#pragma unroll
                    for (int q = 0; q < 4; ++q) { cur[2 * q] = *(const LAS f32x4*)(sb + q * 64); cur[2 * q + 1] = *(const LAS f32x4*)(sb + q * 64 + 4); }
                    vcur = *(const LAS f32x2*)(cb + 320 + 2 * rg);
                }
#pragma unroll
                for (int s = 0; s < 16; ++s) {
                    if (s < 15) {
                        const LAS float* sb = cb + (s + 1) * 384 + cg8 * 8;
#pragma unroll
                        for (int q = 0; q < 4; ++q) { nxt[2 * q] = *(const LAS f32x4*)(sb + q * 64); nxt[2 * q + 1] = *(const LAS f32x4*)(sb + q * 64 + 4); }
                        vnxt = *(const LAS f32x2*)(cb + (s + 1) * 384 + 320 + 2 * rg);
                    }
                    f32x2 dp[4], bp[4], cp[4], ap[4];
#pragma unroll
                    for (int q = 0; q < 2; ++q) {
                        dp[2 * q] = (f32x2){cur[q][0], cur[q][1]}; dp[2 * q + 1] = (f32x2){cur[q][2], cur[q][3]};
                        bp[2 * q] = (f32x2){cur[2 + q][0], cur[2 + q][1]}; bp[2 * q + 1] = (f32x2){cur[2 + q][2], cur[2 + q][3]};
                        cp[2 * q] = (f32x2){cur[4 + q][0], cur[4 + q][1]}; cp[2 * q + 1] = (f32x2){cur[4 + q][2], cur[4 + q][3]};
                        ap[2 * q] = (f32x2){cur[6 + q][0], cur[6 + q][1]}; ap[2 * q + 1] = (f32x2){cur[6 + q][2], cur[6 + q][3]};
                    }
                    float sa[2], yy[2];
#pragma unroll
                    for (int rr = 0; rr < 2; ++rr) {
                        f32x2 a2 = S[rr][0] * ap[0] + S[rr][1] * ap[1];
                        f32x2 b2 = S[rr][2] * ap[2] + S[rr][3] * ap[3];
                        a2 += b2;
                        float x = a2[0] + a2[1];
                        x += dpp_xor1(x); x += dpp_xor2(x); x += dpp_hmirror(x);
                        sa[rr] = x;
                    }
#pragma unroll
                    for (int rr = 0; rr < 2; ++rr) {
                        const f32x2 sa2 = {sa[rr], sa[rr]}, v2 = {vcur[rr], vcur[rr]};
                        f32x2 y2 = {0.f, 0.f}, y3 = {0.f, 0.f};
#pragma unroll
                        for (int q = 0; q < 4; ++q) {
                            S[rr][q] = sa2 * bp[q] + (v2 * cp[q] + S[rr][q]);
                            if (q & 1) y3 += S[rr][q] * dp[q]; else y2 += S[rr][q] * dp[q];
                        }
                        y2 += y3;
                        float x = y2[0] + y2[1];
                        x += dpp_xor1(x); x += dpp_xor2(x); x += dpp_hmirror(x);
                        yy[rr] = x;
                    }
                    ybuf[s * 32 + rg] = pk2(yy[0], yy[1]);
                    if (s < 15) {
#pragma unroll
                        for (int q = 0; q < 8; ++q) cur[q] = nxt[q];
                        vcur = vnxt;
                    }
                }
                {
                    const f32x4 p0 = *(const LAS f32x4*)(cb + 256 + cg8 * 8), p1 = *(const LAS f32x4*)(cb + 256 + cg8 * 8 + 4);
                    const f32x2 pl[4] = {(f32x2){p0[0], p0[1]}, (f32x2){p0[2], p0[3]}, (f32x2){p1[0], p1[1]}, (f32x2){p1[2], p1[3]}};
#pragma unroll
                    for (int rr = 0; rr < 2; ++rr)
#pragma unroll
                        for (int q = 0; q < 4; ++q) S[rr][q] *= pl[q];
                }
                if (ci + 1 < 64) sstore(ci + 1);
                __syncthreads();
            }
            flush(63);
            __syncthreads();
        } else {
            const int pw = wid - 4, pu = 4 * u + pw;
            const int b = pu >> 6, h = (pu >> 1) & 31, z = pu & 1, T = 256, rowbase = b * 256;
            const int rg = lane >> 2, cg = lane & 3, stt = lane >> 4, c4 = (lane & 15) * 4;
            LAS float* base = lf + 12288 + pw * (2 * 4 * 384);
            LAS unsigned* ybuf = (LAS unsigned*)(lf + 25600) + pw * (4 * 32);
            f32x2 S[4][8];
#pragma unroll
            for (int rr = 0; rr < 4; ++rr)
#pragma unroll
                for (int q = 0; q < 8; ++q) S[rr][q] = (f32x2){0.f, 0.f};
            LAS float* ptab = lf + 26688 + pw * 576;
            {
                if (lane < 16) {
                    const int hc = h * 64 + c4;
#pragma unroll
                    for (int g = 0; g < 3; ++g) { *(LAS f32x4*)(ptab + (2 * g) * 64 + c4) = ld_f4(mu + g * 2048 + hc); *(LAS f32x4*)(ptab + (2 * g + 1) * 64 + c4) = ld_f4(mu + 8576 + g * 2048 + hc); }
                    *(LAS f32x4*)(ptab + 6 * 64 + c4) = ld_f4(p.in[29] + hc); *(LAS f32x4*)(ptab + 7 * 64 + c4) = ld_f4(p.in[30] + hc); *(LAS f32x4*)(ptab + 8 * 64 + c4) = ld_f4(p.in[31] + hc);
                }
                __syncthreads();
            }
            StageRegs R;
            auto sload = [&](int it, bool prm) { (void)prm; const int step = it * 4 + stt, t = z ? T - 1 - step : step; scan_stage_load(R, C1, AZ, EZ, mu, p.in[29], p.in[30], p.in[31], rowbase + t, t, T, h, z, c4, (step & 15) == 0); };
            auto sstore = [&](int it) { scan_stage_store(R, base + ((it & 1) * 4 + stt) * 384 + c4, BN, (lane & 15) == 0, h, z, ptab + c4, (it & 3) == 3 && stt == 3, base + (it & 1) * 4 * 384 + 256 + c4); };
            sload(0, true); sstore(0);
            __syncthreads();
            for (int it = 0; it < 64; ++it) {
                if (it + 1 < 64) sload(it + 1, false);
                const LAS float* cb = base + (it & 1) * 4 * 384;
#pragma unroll 1
                for (int s = 0; s < 4; ++s) {
                    const LAS float* sb = cb + s * 384 + cg * 16;
                    f32x2 dp[8], bp[8], cp[8], ap[8];
#pragma unroll
                    for (int q = 0; q < 4; ++q) {
                        const f32x4 a4 = *(const LAS f32x4*)(sb + 192 + q * 4);
                        ap[2 * q] = (f32x2){a4[0], a4[1]}; ap[2 * q + 1] = (f32x2){a4[2], a4[3]};
                    }
                    const f32x4 vv = *(const LAS f32x4*)(cb + s * 384 + 320 + 4 * rg);
                    float yy[4], sav[4];
#pragma unroll
                    for (int rr = 0; rr < 4; ++rr) {
                        f32x2 a2 = S[rr][0] * ap[0] + S[rr][1] * ap[1];
                        f32x2 b2 = S[rr][2] * ap[2] + S[rr][3] * ap[3];
                        a2 += S[rr][4] * ap[4] + S[rr][5] * ap[5];
                        b2 += S[rr][6] * ap[6] + S[rr][7] * ap[7];
                        a2 += b2;
                        float sa = a2[0] + a2[1];
                        sa += dpp_xor1(sa); sa += dpp_xor2(sa);
                        sav[rr] = sa;
                    }
                    __builtin_amdgcn_sched_barrier(0);
#pragma unroll
                    for (int q = 0; q < 4; ++q) {
                        const f32x4 a0 = *(const LAS f32x4*)(sb + q * 4), a1 = *(const LAS f32x4*)(sb + 64 + q * 4), a2 = *(const LAS f32x4*)(sb + 128 + q * 4);
                        dp[2 * q] = (f32x2){a0[0], a0[1]}; dp[2 * q + 1] = (f32x2){a0[2], a0[3]};
                        bp[2 * q] = (f32x2){a1[0], a1[1]}; bp[2 * q + 1] = (f32x2){a1[2], a1[3]};
                        cp[2 * q] = (f32x2){a2[0], a2[1]}; cp[2 * q + 1] = (f32x2){a2[2], a2[3]};
                    }
#pragma unroll
                    for (int rr = 0; rr < 4; ++rr) {
                        const f32x2 sa2 = {sav[rr], sav[rr]}, v2 = {vv[rr], vv[rr]};
                        f32x2 y2 = {0.f, 0.f}, y3 = {0.f, 0.f};
#pragma unroll
                        for (int q = 0; q < 8; ++q) {
                            S[rr][q] = sa2 * bp[q] + (v2 * cp[q] + S[rr][q]);
                            if (q & 1) y3 += S[rr][q] * dp[q]; else y2 += S[rr][q] * dp[q];
                        }
                        y2 += y3;
                        float x = y2[0] + y2[1];
                        x += dpp_xor1(x); x += dpp_xor2(x);
                        yy[rr] = x;
                    }
                    const u32x2 yo = {pk2(yy[0], yy[1]), pk2(yy[2], yy[3])};
                    *(LAS u32x2*)(ybuf + s * 32 + rg * 2) = yo;
                }
                {
                    const int fs = lane >> 4, fr4 = (lane & 15) * 2;
                    const u32x2 yv = *(const LAS u32x2*)(ybuf + fs * 32 + fr4);
                    const int step = it * 4 + fs, t = z ? T - 1 - step : step;
                    *(u32x2*)(YZ + ((size_t)z * 8192 + rowbase + t) * 2048 + h * 64 + fr4 * 2) = yv;
                }
                if ((it & 3) == 3) {
#pragma unroll
                    for (int q = 0; q < 4; ++q) {
                        const f32x4 pv = *(const LAS f32x4*)(cb + 256 + cg * 16 + q * 4);
                        const f32x2 pa = {pv[0], pv[1]}, pb2 = {pv[2], pv[3]};
#pragma unroll
                        for (int rr = 0; rr < 4; ++rr) { S[rr][2 * q] *= pa; S[rr][2 * q + 1] *= pb2; }
                    }
                }
                if (it + 1 < 64) sstore(it + 1);
                __syncthreads();
            }
            {
                float* st = p.out + (z ? OUT_SB : OUT_SF) + (((size_t)b * 32 + h) * 64 + 4 * rg) * 64 + cg * 16;
#pragma unroll
                for (int rr = 0; rr < 4; ++rr)
#pragma unroll
                    for (int q = 0; q < 4; ++q) { const f32x4 v = {S[rr][2 * q][0], S[rr][2 * q][1], S[rr][2 * q + 1][0], S[rr][2 * q + 1][1]}; st_f4(st + rr * 64 + q * 4, v); }
            }
            __syncthreads();
        }
    }
}

DI void post_phase(const Params& p, const int wv__) {
    const int tid_ = otid(), lane = tid_ & 63, wg = blockIdx.x * 8 + (tid_ >> 6), nw = gridDim.x * 8;
    const bf16_t* C1 = (const bf16_t*)(p.ws + OFF_C);
    const bf16_t* YZ = (const bf16_t*)(p.ws + OFF_YZ); const float* BN = (const float*)(p.ws + OFF_BN);
    bf16_t* Y1 = (bf16_t*)(p.ws + OFF_H);
    const float* mu = p.in[24]; const float* lnw = p.in[32]; const float* lnb = p.in[33];
    const int cb = wg & 7, c = cb * 256 + lane * 4, hd = c >> 6;
    const f32x4 mv0 = ld_f4(mu + 4096 + c), mv1 = ld_f4(mu + 8576 + 4096 + c), mg0 = ld_f4(mu + 6144 + c), mg1 = ld_f4(mu + 8576 + 6144 + c);
    const f32x4 w4 = ld_f4(lnw + c), b4 = ld_f4(lnb + c);
#pragma unroll 4
    for (int row = wg >> 3; row < 8192; row += nw >> 3) {
        int t, T; seq_pos(row, t, T);
        const bf16_t* cr = C1 + (size_t)row * 8576;
        const bool hp = t > 0, hn = t < T - 1;
        const f32x4 ya = bf4_to_f4(__builtin_nontemporal_load((const u32x2*)(YZ + (size_t)row * 2048 + c)));
        const f32x4 yb = bf4_to_f4(__builtin_nontemporal_load((const u32x2*)(YZ + ((size_t)8192 + row) * 2048 + c)));
        const u32x2 zero = {0u, 0u};
        const u32x2 vc = *(const u32x2*)(cr + 4096 + c), gc = *(const u32x2*)(cr + 6144 + c);
        const u32x2 vp = hp ? *(const u32x2*)(cr - 8576 + 4096 + c) : zero, gp = hp ? *(const u32x2*)(cr - 8576 + 6144 + c) : zero;
        const u32x2 vn = hn ? *(const u32x2*)(cr + 8576 + 4096 + c) : zero, gn = hn ? *(const u32x2*)(cr + 8576 + 6144 + c) : zero;
        const float bna = BN[(size_t)row * 32 + hd], bnb = BN[((size_t)8192 + row) * 32 + hd];
        const float ma = sum16d(ya[0] + ya[1] + ya[2] + ya[3]) * (1.f / 64.f), mb = sum16d(yb[0] + yb[1] + yb[2] + yb[3]) * (1.f / 64.f);
        const f32x4 da = ya - ma, db = yb - mb;
        const float va = sum16d(da[0] * da[0] + da[1] * da[1] + da[2] * da[2] + da[3] * da[3]) * (1.f / 64.f);
        const float vb = sum16d(db[0] * db[0] + db[1] * db[1] + db[2] * db[2] + db[3] * db[3]) * (1.f / 64.f);
        const float rsa = rsqrtf(va + 64e-5f), rsb = rsqrtf(vb + 64e-5f);
        const f32x4 v = tshift(bf4_to_f4(vc), bf4_to_f4(vp), bf4_to_f4(vn), mv0, mv1);
        const f32x4 g = tshift(bf4_to_f4(gc), bf4_to_f4(gp), bf4_to_f4(gn), mg0, mg1);
        f32x4 res = (da * rsa + db * rsb) * w4 + 2.f * b4 + (bna + bnb) * v;
#pragma unroll
        for (int j = 0; j < 4; ++j) res[j] *= g[j] * sigmoidf_(g[j]);
        st_bf4(Y1 + (size_t)row * 2048 + c, res);
    }
}

#define XB_TMO      128
#define XB_XCNT(j)  (256  + 64 * (j))
#define XB_XSUB(j)  (1280 + 64 * (j))
#define XB_XGEN(j)  (2304 + 64 * (j))
#define XB_TOP      3328
#define XB_TOPGEN   3392
#define XCD_BAR_WORDS 3456
#define XB_SPIN_CAP (1u << 18)
DI unsigned xb_ld(unsigned* p)              { return __hip_atomic_load(p, __ATOMIC_RELAXED, __HIP_MEMORY_SCOPE_AGENT); }
DI unsigned xb_add(unsigned* p, unsigned v) { return __hip_atomic_fetch_add(p, v, __ATOMIC_RELAXED, __HIP_MEMORY_SCOPE_AGENT); }
DI unsigned xb_xcc_id() { return (unsigned)__builtin_amdgcn_s_getreg((3 << 11) | 20) & 0xFu; }
#define XB_SPIN(cond, bar) do { unsigned _sp = 0; while (cond) { __builtin_amdgcn_s_sleep(1); \
    if ((++_sp & 255u) == 0u) { if (xb_ld(&(bar)[XB_TMO])) break; if (_sp > XB_SPIN_CAP) { atomicAdd(&(bar)[XB_TMO], 1u); break; } } } } while (0)
struct XcdBarrier { unsigned* bar; unsigned x; volatile LAS unsigned* st; };
DI int ltid_(int wv) { return (wv << 6) | (int)__builtin_amdgcn_mbcnt_hi(~0u, __builtin_amdgcn_mbcnt_lo(~0u, 0u)); }
DI XcdBarrier xcd_barrier_post(unsigned* bar, volatile LAS unsigned* st, const int wv__) {
    XcdBarrier b; b.bar = bar; b.x = xb_xcc_id(); b.st = st;
    if (otid() == 0) (void)xb_add(&bar[XB_XCNT(b.x)], 1u);
    return b;
}
DI void xcd_barrier_complete(unsigned* bar, unsigned x, unsigned& nloc, unsigned& nx) {
    const unsigned G = gridDim.x * gridDim.y * gridDim.z;
    unsigned sum, cnt, mine, sp = 0u;
    for (;;) {
        sum = 0u; cnt = 0u; mine = 0u;
#pragma unroll
        for (unsigned j = 0; j < 16; ++j) { const unsigned c = xb_ld(&bar[XB_XCNT(j)]); sum += c; cnt += (c > 0u) ? 1u : 0u; mine = (j == x) ? c : mine; }
        if (sum == G) break;
        __builtin_amdgcn_s_sleep(1);
        if ((++sp & 255u) == 0u) { if (xb_ld(&bar[XB_TMO])) break; if (sp > XB_SPIN_CAP) { atomicAdd(&bar[XB_TMO], 1u); break; } }
    }
    nloc = mine > 0u ? mine : 1u; nx = cnt > 0u ? cnt : 1u;
}
DI void xcd_barrier(const XcdBarrier& b, const int wv__) {
    asm volatile("s_waitcnt vmcnt(0)" ::: "memory");
    __syncthreads();
    if (otid() == 0) {
        unsigned* bar = b.bar;
        __builtin_amdgcn_s_waitcnt(0);
        unsigned nloc = b.st[0], nx = b.st[1];
        if (nloc == 0u) { xcd_barrier_complete(bar, b.x, nloc, nx); b.st[0] = nloc; b.st[1] = nx; }
        const unsigned old = xb_add(&bar[XB_XSUB(b.x)], 1u);
        const unsigned gen = old / nloc;
        if (old + 1u == (gen + 1u) * nloc) {
            __builtin_amdgcn_fence(__ATOMIC_RELEASE, "agent");
            asm volatile("s_waitcnt vmcnt(0)" ::: "memory");
            const unsigned og = xb_add(&bar[XB_TOP], 1u);
            const unsigned tg = og / nx;
            if (og + 1u == (tg + 1u) * nx) xb_add(&bar[XB_TOPGEN], 1u);
            else XB_SPIN(xb_ld(&bar[XB_TOPGEN]) == tg, bar);
            __builtin_amdgcn_fence(__ATOMIC_ACQUIRE, "agent");
            xb_add(&bar[XB_XGEN(b.x)], 1u);
            asm volatile("s_waitcnt vmcnt(0)" ::: "memory");
        } else {
            XB_SPIN(xb_ld(&bar[XB_XGEN(b.x)]) == gen, bar);
            __builtin_amdgcn_fence(__ATOMIC_ACQUIRE, "agent");
            asm volatile("s_waitcnt vmcnt(0)" ::: "memory");
        }
    }
    __syncthreads();
}

constexpr int NPHASE = 15;
#ifndef PHASE_MASK
#define PHASE_MASK 0x7fff
#endif
#ifndef PH_ORDER
#define PH_ORDER 0xEDCBA9876543210ull
#define PH_COUNT 15
#endif
#define PH_ON(n) (((PHASE_MASK) >> (n)) & 1)
__global__ void __launch_bounds__(NTHREADS) mega(KArgs ka, int ph_lo, int ph_hi) {
    cg::grid_group grid = cg::this_grid();
    const int wv__ = __builtin_amdgcn_readfirstlane((int)(threadIdx.x >> 6));
    LAS unsigned char* lds = (LAS unsigned char*)dyn_lds;
    __shared__ uint4 xb_words;
    if (otid() == 0) xb_words = make_uint4(0u, 0u, 0u, 0u);
    XcdBarrier xb; xb.bar = nullptr; xb.x = 0u; xb.st = (volatile LAS unsigned*)&xb_words;
    typedef void* vptr_t;
    const __attribute__((address_space(4))) vptr_t* kat = (const __attribute__((address_space(4))) vptr_t*)__builtin_amdgcn_kernarg_segment_ptr();
    for (int si = ph_lo; si < ph_hi; ++si) {
        const int ph = (int)((PH_ORDER >> (4 * si)) & 15ull);
        if (si == ph_lo) {
            unsigned* bar = (unsigned*)((unsigned char*)kat[35] + OFF_BAR);
            if (blockIdx.x == 0) { const int t0 = otid();
#pragma unroll 1
                for (int i = t0; i < XCD_BAR_WORDS; i += NTHREADS) bar[i] = 0u; }
            __syncthreads();
        } else if (si == ph_lo + 1) {
            grid.sync();
            xb = xcd_barrier_post((unsigned*)((unsigned char*)kat[35] + OFF_BAR), (volatile LAS unsigned*)&xb_words, wv__);
        } else xcd_barrier(xb, wv__);
        int oz = 0; asm volatile("" : "+s"(oz));
        Params p;
        p.in[0] = (const float*)kat[0 + oz];
        p.in[1] = (const float*)kat[1 + oz];
        p.in[2] = (const float*)kat[2 + oz];
        p.in[3] = (const float*)kat[3 + oz];
        p.in[4] = (const float*)kat[4 + oz];
        p.in[5] = (const float*)kat[5 + oz];
        p.in[6] = (const float*)kat[6 + oz];
        p.in[7] = (const float*)kat[7 + oz];
        p.in[8] = (const float*)kat[8 + oz];
        p.in[9] = (const float*)kat[9 + oz];
        p.in[10] = (const float*)kat[10 + oz];
        p.in[11] = (const float*)kat[11 + oz];
        p.in[12] = (const float*)kat[12 + oz];
        p.in[13] = (const float*)kat[13 + oz];
        p.in[14] = (const float*)kat[14 + oz];
        p.in[15] = (const float*)kat[15 + oz];
        p.in[16] = (const float*)kat[16 + oz];
        p.in[17] = (const float*)kat[17 + oz];
        p.in[18] = (const float*)kat[18 + oz];
        p.in[19] = (const float*)kat[19 + oz];
        p.in[20] = (const float*)kat[20 + oz];
        p.in[21] = (const float*)kat[21 + oz];
        p.in[22] = (const float*)kat[22 + oz];
        p.in[23] = (const float*)kat[23 + oz];
        p.in[24] = (const float*)kat[24 + oz];
        p.in[25] = (const float*)kat[25 + oz];
        p.in[26] = (const float*)kat[26 + oz];
        p.in[27] = (const float*)kat[27 + oz];
        p.in[28] = (const float*)kat[28 + oz];
        p.in[29] = (const float*)kat[29 + oz];
        p.in[30] = (const float*)kat[30 + oz];
        p.in[31] = (const float*)kat[31 + oz];
        p.in[32] = (const float*)kat[32 + oz];
        p.in[33] = (const float*)kat[33 + oz];
        p.out = (float*)kat[34 + oz]; p.ws = (unsigned char*)kat[35 + oz];
        unsigned char* ws = p.ws;
        float* mod = (float*)(ws + OFF_MOD);
        const f32x2* rope = (const f32x2*)(ws + OFF_ROPE);
        switch (ph) {
        case 0: if (PH_ON(0)) prep_phase(p, lds, wv__); break;
        case 1: if (PH_ON(1)) norm_mod_phase(p.in[0], p.in[1], p.in[12], mod, (bf16_t*)(ws + OFF_H), wv__); break;
        case 2: if (PH_ON(2)) {
            Epi0 e; e.QD = (bf16_t*)(ws + OFF_QD); e.KD = (bf16_t*)(ws + OFF_KD); e.VD = (bf16_t*)(ws + OFF_VD); e.CQR = (bf16_t*)(ws + OFF_CQR); e.KPE = (bf16_t*)(ws + OFF_KPE);
            e.SG = (bf16_t*)(ws + OFF_SG0); e.CKVR = (float*)(ws + OFF_CKVR); e.oak = p.out + OUT_AK; e.oav = p.out + OUT_AV; e.okpe = p.out + OUT_KPE; e.rope = rope;
            gemm_phase(lds, (const bf16_t*)(ws + OFF_H), (const bf16_t*)(ws + OFF_WT0), 8192, 6144, 2048, e, wv__);
        } break;
        case 3: if (PH_ON(3)) lat_norm_phase(p, wv__); break;
        case 4: if (PH_ON(4)) {
            EpiQ eq; eq.QB = (bf16_t*)(ws + OFF_QB); eq.rope = rope;
            gemm_phase(lds, (const bf16_t*)(ws + OFF_CQN), (const bf16_t*)(ws + OFF_WUQ), 8192, 1536, 512, eq, wv__);
            EpiBf ek; ek.O = (bf16_t*)(ws + OFF_KVB); ek.ldc = 2048; ek.ncols = 2048;
            gemm_phase(lds, (const bf16_t*)(ws + OFF_CKVA), (const bf16_t*)(ws + OFF_WUKV), 10240, 2048, 256, ek, wv__);
        } break;
        case 5: if (PH_ON(5)) attn_phase(p, lds, wv__); break;
        case 6: if (PH_ON(6)) {
            EpiOut e; e.xp = p.in[0]; e.xs = p.in[1]; e.xo = p.out + OUT_Y; e.modg = mod + 4096;
            gemm_phase(lds, (const bf16_t*)(ws + OFF_H), (const bf16_t*)(ws + OFF_WOT0), 8192, 2048, 2048, e, wv__);
        } break;
        case 7: if (PH_ON(7)) norm_mod_phase(p.out + OUT_Y, p.out + OUT_Y + (size_t)4096 * 2048, p.in[12] + 2048, mod + 5 * 6144, (bf16_t*)(ws + OFF_H), wv__); break;
        case 8: if (PH_ON(8)) {
            EpiBf e; e.O = (bf16_t*)(ws + OFF_C); e.ldc = 8576; e.ncols = 8192;
            gemm_phase(lds, (const bf16_t*)(ws + OFF_H), (const bf16_t*)(ws + OFF_WT1), 8192, 8192, 2048, e, wv__);
            EpiBf e2; e2.O = (bf16_t*)(ws + OFF_PART); e2.ldc = 2048; e2.ncols = 2048;
            gemm_phase(lds, (const bf16_t*)(ws + OFF_H), (const bf16_t*)(ws + OFF_WT1) + (size_t)8192 * 2048, 8192, 512, 512, e2, wv__, 2048, 4);
        } break;
        case 9: if (PH_ON(9)) lora_in_phase(p, wv__); break;
        case 10: if (PH_ON(10)) {
#pragma unroll 1
            for (int z = 0; z < 2; ++z) {
                EpiDecay ew; ew.O = (bf16_t*)(ws + OFF_EZ) + (size_t)z * 8192 * 2048; ew.bias = p.in[25] + z * 2048; ew.rev = z;
                gemm_phase(lds, (const bf16_t*)(ws + OFF_WDT) + (size_t)z * 8192 * 128, (const bf16_t*)(ws + OFF_W2T) + (size_t)z * 2048 * 128, 8192, 2048, 128, ew, wv__);
                EpiLora ea; ea.O = (bf16_t*)(ws + OFF_AZ) + (size_t)z * 8192 * 2048; ea.bias = p.in[27] + z * 2048; ea.mul = 1.f;
                gemm_phase(lds, (const bf16_t*)(ws + OFF_ADT) + (size_t)z * 8192 * 128, (const bf16_t*)(ws + OFF_A2T) + (size_t)z * 2048 * 128, 8192, 2048, 128, ea, wv__);
            }
        } break;
        case 11: if (PH_ON(11)) scan_phase(p, lds, wv__); break;
        case 12: if (PH_ON(12)) post_phase(p, wv__); break;
        case 13: if (PH_ON(13)) {
            EpiGate e; e.O = (bf16_t*)(ws + OFF_C); e.modg = mod + 5 * 6144 + 4096;
            gemm_phase(lds, (const bf16_t*)(ws + OFF_H), (const bf16_t*)(ws + OFF_WOT1), 8192, 2048, 2048, e, wv__);
        } break;
        case 14: if (PH_ON(14)) final_norm_phase(p.out + OUT_Y, (const bf16_t*)(ws + OFF_C), p.in[13], wv__); break;
        }
    }
}

extern "C" void kernel_launch(void* const* d_in, const int* in_sizes, int n_in, void* d_out, int out_size, void* d_ws, size_t ws_size, hipStream_t stream) {
    static int grid_blocks = 0;
    if (!grid_blocks) {
        hipFuncSetAttribute((const void*)mega, hipFuncAttributeMaxDynamicSharedMemorySize, LDS_BYTES);
        int dev = 0, cus = 0, per_cu = 0;
        hipGetDevice(&dev);
        hipDeviceGetAttribute(&cus, hipDeviceAttributeMultiprocessorCount, dev);
        hipOccupancyMaxActiveBlocksPerMultiprocessor(&per_cu, mega, NTHREADS, LDS_BYTES);
        if (per_cu < 1) per_cu = 1;
        grid_blocks = cus * per_cu;
        if (grid_blocks > 256) grid_blocks = 256;
    }
    KArgs p{};
    for (int i = 0; i < 34; ++i) p.a[i] = d_in[i];
    p.a[34] = d_out;
    p.a[35] = d_ws;
    int lo = 0, hi = PH_COUNT;
    void* args[] = {&p, &lo, &hi};
    hipError_t e = hipLaunchCooperativeKernel((const void*)mega, dim3(grid_blocks), dim3(NTHREADS), args, LDS_BYTES, stream);
    if (e != hipSuccess) fprintf(stderr, "cooperative launch failed: %s (grid %d, ws %zu need %zu)\n", hipGetErrorString(e), grid_blocks, ws_size, (size_t)WS_NEEDED);
}
```

```cpp
#include <hip/hip_runtime.h>
#include <hip/hip_cooperative_groups.h>
#include <cstdio>
namespace cg = cooperative_groups;

#define DI __device__ __forceinline__
#define LAS __attribute__((address_space(3)))
typedef unsigned short bf16_t;
typedef short bf16x8 __attribute__((ext_vector_type(8)));
typedef short s16x4 __attribute__((ext_vector_type(4)));
typedef float f32x4 __attribute__((ext_vector_type(4)));
typedef float f32x2 __attribute__((ext_vector_type(2)));
typedef unsigned u32x4 __attribute__((ext_vector_type(4)));
typedef unsigned u32x2 __attribute__((ext_vector_type(2)));
typedef __bf16 nbf2 __attribute__((ext_vector_type(2)));

extern __shared__ __attribute__((aligned(16))) unsigned char dyn_lds[];
constexpr int LDS_BYTES = 131072;
constexpr int NTHREADS = 512;

constexpr size_t SZ_H    = (size_t)8192 * 2048 * 2;
constexpr size_t OFF_WOT1 = 0;
constexpr size_t OFF_WT0  = OFF_WOT1 + (size_t)2048 * 2048 * 2;
constexpr size_t OFF_WT1  = OFF_WT0 + (size_t)6144 * 2048 * 2;
constexpr size_t OFF_WOT0 = OFF_WT1 + (size_t)8704 * 2048 * 2;
constexpr size_t OFF_WUQ  = OFF_WOT0 + (size_t)2048 * 2048 * 2;
constexpr size_t OFF_WUKV = OFF_WUQ + (size_t)1536 * 512 * 2;
constexpr size_t OFF_W2T  = OFF_WUKV + (size_t)2048 * 256 * 2;
constexpr size_t OFF_A2T  = OFF_W2T + (size_t)2 * 2048 * 128 * 2;
constexpr size_t END_W    = OFF_A2T + (size_t)2 * 2048 * 128 * 2;
constexpr size_t OFF_YZ   = OFF_WT0;
static_assert(OFF_YZ + 2 * SZ_H <= END_W, "yz alias");
constexpr size_t OFF_MOD  = END_W;
constexpr size_t OFF_ROPE = OFF_MOD + (size_t)2 * 5 * 6144 * 4;
constexpr size_t OFF_BN   = OFF_ROPE + 64 * 16 * 8;
constexpr size_t OFF_H    = OFF_BN + (size_t)2 * 8192 * 32 * 4;
constexpr size_t OFF_C    = OFF_H + SZ_H;
constexpr size_t SZ_C     = (size_t)8192 * 8576 * 2;
constexpr size_t OFF_QD   = OFF_C;
constexpr size_t OFF_KD   = OFF_QD + (size_t)8192 * 1024 * 2;
constexpr size_t OFF_VD   = OFF_KD + (size_t)10240 * 1024 * 2;
constexpr size_t OFF_CQR  = OFF_VD + (size_t)10240 * 1024 * 2;
constexpr size_t OFF_CKVR = OFF_CQR + (size_t)8192 * 512 * 2;
constexpr size_t OFF_KPE  = OFF_CKVR + (size_t)8192 * 256 * 4;
constexpr size_t OFF_SG0  = OFF_KPE + (size_t)10240 * 64 * 2;
static_assert(OFF_SG0 + SZ_H <= OFF_C + SZ_C, "region C");
constexpr size_t OFF_E    = OFF_C + SZ_C;
constexpr size_t OFF_PART = OFF_E;
constexpr size_t OFF_AZ   = OFF_E;
constexpr size_t OFF_EZ   = OFF_E + 2 * SZ_H;
constexpr size_t SZ_E     = 4 * SZ_H;
constexpr size_t OFF_CQN  = OFF_E;
constexpr size_t OFF_CKVA = OFF_CQN + (size_t)8192 * 512 * 2;
constexpr size_t OFF_QB   = OFF_CKVA + (size_t)10240 * 256 * 2;
constexpr size_t OFF_KVB  = OFF_QB + (size_t)8192 * 1536 * 2;
static_assert(OFF_KVB + (size_t)10240 * 2048 * 2 <= OFF_E + SZ_E, "region E");
constexpr size_t OFF_BAR = OFF_E + SZ_E;
constexpr size_t WS_NEEDED = OFF_BAR + 16384;
constexpr size_t OFF_WDT = OFF_H;
constexpr size_t OFF_ADT = OFF_H + (size_t)2 * 8192 * 128 * 2;

constexpr size_t OUT_Y = 0, OUT_AK = 16777216, OUT_AV = 20971520, OUT_CKV = 25165824, OUT_KPE = 26214400, OUT_SF = 26476544, OUT_SB = 28573696;

struct Params {
    const float* in[34];
    float* out;
    unsigned char* ws;
};
struct KArgs { const void* a[36]; };

DI unsigned pk2(float a, float b) { f32x2 v = {a, b}; nbf2 r = __builtin_convertvector(v, nbf2); return __builtin_bit_cast(unsigned, r); }
DI float bflo(unsigned u) { return __uint_as_float(u << 16); }
DI float bfhi(unsigned u) { return __uint_as_float(u & 0xffff0000u); }
DI void st_bf4(bf16_t* p, f32x4 v) { u32x2 r = {pk2(v[0], v[1]), pk2(v[2], v[3])}; *(u32x2*)p = r; }
DI void st_f4(float* p, f32x4 v) { *(f32x4*)p = v; }
DI void st_f4_nt(float* p, f32x4 v) { __builtin_nontemporal_store(v, (f32x4*)p); }
DI f32x4 ld_f4(const float* p) { return *(const f32x4*)p; }
DI f32x4 ld_f4_nt(const float* p) { return __builtin_nontemporal_load((const f32x4*)p); }
DI f32x4 bf4_to_f4(u32x2 u) { f32x4 r = {bflo(u[0]), bfhi(u[0]), bflo(u[1]), bfhi(u[1])}; return r; }
DI float dpp_xor1(float x) { return __int_as_float(__builtin_amdgcn_mov_dpp(__float_as_int(x), 0xB1, 0xF, 0xF, true)); }
DI float dpp_xor2(float x) { return __int_as_float(__builtin_amdgcn_mov_dpp(__float_as_int(x), 0x4E, 0xF, 0xF, true)); }
DI float dpp_hmirror(float x) { return __int_as_float(__builtin_amdgcn_mov_dpp(__float_as_int(x), 0x141, 0xF, 0xF, true)); }
DI float dpp_mirror(float x) { return __int_as_float(__builtin_amdgcn_mov_dpp(__float_as_int(x), 0x140, 0xF, 0xF, true)); }
DI float shx(float x, int m, int lane) { return __int_as_float(__builtin_amdgcn_ds_bpermute((lane ^ m) << 2, __float_as_int(x))); }
DI float wave_sum(float x, int lane) {
    x += dpp_xor1(x); x += dpp_xor2(x); x += dpp_hmirror(x); x += dpp_mirror(x); x += shx(x, 16, lane); x += shx(x, 32, lane); return x;
}
DI float sum16d(float x) { x += dpp_xor1(x); x += dpp_xor2(x); x += dpp_hmirror(x); x += dpp_mirror(x); return x; }
DI float sigmoidf_(float x) { return __builtin_amdgcn_rcpf(1.f + __expf(-x)); }
DI int otid_(int wv) { int l; asm volatile("v_mbcnt_lo_u32_b32 %0, -1, 0\n\tv_mbcnt_hi_u32_b32 %0, -1, %0" : "=v"(l)); return (wv << 6) | l; }
#define otid() otid_(wv__)
DI int kvrow_of(int row) { return row < 4096 ? row : 4096 + ((row - 4096) >> 10) * 1536 + ((row - 4096) & 1023); }
DI int cond_of(int row) { return row < 4096 ? 0 : 1 + ((row - 4096) >> 10); }

constexpr int HTB = 128 * 64 * 2;
DI int lds_byte(int r, int c) { const int st = (r >> 4) * 2 + (c >> 5), rr = r & 15, cc = c & 31, ob = rr * 64 + cc * 2; return st * 1024 + (ob ^ (((ob >> 9) & 1) << 5)); }
DI void stage_rc(int b, int& R, int& C) { const int st = b / 1024, sb = b % 1024, swz = sb ^ (((sb >> 9) & 1) << 5); R = (st >> 1) * 16 + swz / 64; C = (st & 1) * 32 + (swz % 64) / 2; }

#define G_SA(b, h) (((b) * 2 + (h)) * HTB)
#define G_SB(b, h) ((4 + (b) * 2 + (h)) * HTB)
#define G_STAGE(bufoff, gbase) do { _Pragma("unroll") for (int _i = 0; _i < 2; ++_i) \
    __builtin_amdgcn_global_load_lds((const unsigned*)((const char*)(gbase) + voff[_i]), (LAS unsigned*)(lds + (bufoff) + ldsw + _i * 8192), 16, 0, 0); } while (0)
#define G_LDA(dst, b, h) do { _Pragma("unroll") for (int m = 0; m < 4; ++m) _Pragma("unroll") for (int k = 0; k < 2; ++k) dst[m][k] = *(const LAS bf16x8*)(lds + G_SA(b, h) + aoff + m * 2048 + k * 1024); } while (0)
#define G_LDB(dst, b, h) do { _Pragma("unroll") for (int n = 0; n < 2; ++n) _Pragma("unroll") for (int k = 0; k < 2; ++k) dst[n][k] = *(const LAS bf16x8*)(lds + G_SB(b, h) + boff + n * 2048 + k * 1024); } while (0)
#define G_MMA(ai, bj, At_, Bt_) do { __builtin_amdgcn_s_setprio(1); _Pragma("unroll") for (int m = 0; m < 4; ++m) _Pragma("unroll") for (int n = 0; n < 2; ++n) _Pragma("unroll") for (int k = 0; k < 2; ++k) \
    acc[ai][bj][m][n] = __builtin_amdgcn_mfma_f32_16x16x32_bf16(Bt_[n][k], At_[m][k], acc[ai][bj][m][n], 0, 0, 0); __builtin_amdgcn_s_setprio(0); } while (0)
#define G_WAIT_V(n) asm volatile("s_waitcnt vmcnt(" #n ")" ::: "memory")
#define G_WAIT_L(n) asm volatile("s_waitcnt lgkmcnt(" #n ")" ::: "memory")
#define G_BAR __builtin_amdgcn_s_barrier()
#define G_SCHED __builtin_amdgcn_sched_barrier(0)

template <class Epi>
DI void gemm_phase(LAS unsigned char* lds, const bf16_t* A, const bf16_t* Bt, int M, int N, int K, const Epi& E, const int wv__, int pitch = 0, int nsplit = 1) {
    if (pitch == 0) pitch = K;
    const int tid = otid(), wid = __builtin_amdgcn_readfirstlane(tid >> 6), lane = tid & 63, wr = wid >> 2, wc = wid & 3, fr = lane & 15, fq = lane >> 4;
    const int nt = K / 64, nM = M / 256, nN = N / 256, ntiles = nM * nN * nsplit;
    unsigned voff[2];
#pragma unroll
    for (int i = 0; i < 2; ++i) { int R, C; stage_rc(tid * 16 + i * 8192, R, C); voff[i] = (unsigned)(R * pitch + C) * 2u; }
    const size_t kstep = 128, hstep = (size_t)128 * pitch * 2;
    const unsigned ldsw = (unsigned)wid * 1024u;
    const int aoff = lds_byte(wr * 64 + fr, fq * 8), boff = lds_byte(wc * 32 + fr, fq * 8);
    int tile = blockIdx.x;
    if (tile >= ntiles) return;
    const char* cA; const char* cB; int pm, pnq;
#define G_TILE_PTRS(tl) do { const int ks_ = (tl) % nsplit, t2_ = (tl) / nsplit; pm = t2_ % nM; const int pn_ = t2_ / nM; pnq = pn_ + ks_ * nN; \
        cA = (const char*)A + (size_t)pm * 2 * hstep + (size_t)ks_ * K * 2; cB = (const char*)Bt + (size_t)pn_ * 2 * hstep + (size_t)ks_ * K * 2; } while (0)
    G_TILE_PTRS(tile);
    G_STAGE(G_SB(0, 0), cB); G_STAGE(G_SA(0, 0), cA); G_STAGE(G_SB(0, 1), cB + hstep); G_STAGE(G_SA(0, 1), cA + hstep);
    for (;;) {
        const int pm_cur = pm, pnq_cur = pnq;
        f32x4 acc[2][2][4][2];
#pragma unroll
        for (int a = 0; a < 2; ++a)
#pragma unroll
            for (int b = 0; b < 2; ++b)
#pragma unroll
                for (int m = 0; m < 4; ++m)
#pragma unroll
                    for (int n = 0; n < 2; ++n) acc[a][b][m][n] = (f32x4){0.f, 0.f, 0.f, 0.f};
        bf16x8 At[4][2], B0[2][2], B1[2][2];
        if (wr == 1) G_BAR;
        G_WAIT_V(4); G_BAR;
        G_STAGE(G_SB(1, 0), cB + kstep); G_STAGE(G_SA(1, 0), cA + kstep); G_STAGE(G_SB(1, 1), cB + hstep + kstep);
        G_WAIT_V(6); G_BAR;
        for (int t = 0; t < nt - 2; t += 2) {
            const char* a1 = cA + (size_t)(t + 1) * kstep;
            const char* a2 = cA + (size_t)(t + 2) * kstep; const char* b2 = cB + (size_t)(t + 2) * kstep;
            const char* a3 = a2 + kstep; const char* b3 = b2 + kstep;
            G_LDB(B0, 0, 0); G_SCHED; G_LDA(At, 0, 0); G_STAGE(G_SA(1, 1), a1 + hstep);
            G_WAIT_L(8); G_BAR; G_WAIT_L(0); G_MMA(0, 0, At, B0); G_BAR; G_SCHED;
            G_LDB(B1, 0, 1); G_STAGE(G_SB(0, 0), b2);
            G_BAR; G_WAIT_L(0); G_MMA(0, 1, At, B1); G_BAR;
            G_LDA(At, 0, 1); G_STAGE(G_SA(0, 0), a2);
            G_BAR; G_WAIT_L(0); G_MMA(1, 0, At, B0); G_BAR; G_SCHED;
            G_STAGE(G_SB(0, 1), b2 + hstep);
            G_WAIT_V(6); G_BAR; G_MMA(1, 1, At, B1); G_BAR;
            G_LDB(B0, 1, 0); G_SCHED; G_LDA(At, 1, 0); G_STAGE(G_SA(0, 1), a2 + hstep);
            G_WAIT_L(8); G_BAR; G_WAIT_L(0); G_MMA(0, 0, At, B0); G_BAR; G_SCHED;
            G_LDB(B1, 1, 1); G_STAGE(G_SB(1, 0), b3);
            G_BAR; G_WAIT_L(0); G_MMA(0, 1, At, B1); G_BAR;
            G_LDA(At, 1, 1); G_STAGE(G_SA(1, 0), a3);
            G_BAR; G_WAIT_L(0); G_MMA(1, 0, At, B0); G_BAR; G_SCHED;
            G_STAGE(G_SB(1, 1), b3 + hstep);
            G_WAIT_V(6); G_BAR; G_MMA(1, 1, At, B1); G_BAR;
        }
        {
            const char* a1 = cA + (size_t)(nt - 1) * kstep;
            G_LDB(B0, 0, 0); G_LDA(At, 0, 0); G_STAGE(G_SA(1, 1), a1 + hstep);
            G_BAR; G_WAIT_L(0); G_MMA(0, 0, At, B0); G_BAR;
            G_LDB(B1, 0, 1); G_BAR; G_WAIT_L(0); G_MMA(0, 1, At, B1); G_BAR;
            G_LDA(At, 0, 1); G_WAIT_V(4); G_BAR; G_WAIT_L(0); G_MMA(1, 0, At, B0); G_MMA(1, 1, At, B1); G_BAR;
        }
        {
            G_LDB(B0, 1, 0); G_LDA(At, 1, 0); G_WAIT_V(2); G_BAR; G_WAIT_L(0); G_MMA(0, 0, At, B0); G_BAR;
            G_LDB(B1, 1, 1); G_WAIT_V(0); G_BAR; G_WAIT_L(0); G_MMA(0, 1, At, B1); G_BAR;
            G_LDA(At, 1, 1); G_BAR; G_WAIT_L(0); G_MMA(1, 0, At, B0); G_MMA(1, 1, At, B1); G_BAR;
        }
        if (wr == 0) G_BAR;
        const int next = tile + (int)gridDim.x;
        if (next < ntiles) { G_TILE_PTRS(next); G_STAGE(G_SB(0, 0), cB); G_STAGE(G_SA(0, 0), cA); G_STAGE(G_SB(0, 1), cB + hstep); G_STAGE(G_SA(0, 1), cA + hstep); }
        E.run(acc, pm_cur, pnq_cur, wr, wc, fr, fq);
        if (next >= ntiles) break;
        tile = next;
    }
#undef G_TILE_PTRS
}

typedef f32x4 acc_t[2][2][4][2];
#define EPI_LOOP(...) _Pragma("unroll") for (int ai = 0; ai < 2; ++ai) _Pragma("unroll") for (int m = 0; m < 4; ++m) { const int row = pm * 256 + ai * 128 + wr * 64 + m * 16 + fr; \
    _Pragma("unroll") for (int bj = 0; bj < 2; ++bj) { const int col0 = pn * 256 + bj * 128 + wc * 32 + fq * 4; f32x4 v0 = acc[ai][bj][m][0], v1 = acc[ai][bj][m][1]; __VA_ARGS__ } }
struct RopeRegs { float fr[4]; };
DI void rope_preload(RopeRegs& R, int fq) {
#pragma unroll
    for (int j = 0; j < 4; ++j) R.fr[j] = __builtin_amdgcn_exp2f(-(float)(fq * 4 + j) * (13.287712379549449f / 16.f)) * 0.15915494309189535f;
}
DI void rope_rot(const RopeRegs& R, int pos, f32x4& a, f32x4& b) {
    const float pf = (float)pos;
#pragma unroll
    for (int j = 0; j < 4; ++j) {
        const float rev = pf * R.fr[j];
        const float c = __builtin_amdgcn_cosf(rev), sn = __builtin_amdgcn_sinf(rev);
        const float x1 = a[j], x2 = b[j]; a[j] = x1 * c - x2 * sn; b[j] = x1 * sn + x2 * c;
    }
}
struct Epi0 {
    bf16_t *QD, *KD, *VD, *CQR, *KPE, *SG; float *CKVR, *oak, *oav, *okpe; const f32x2* rope;
    DI void run(const acc_t& acc, int pm, int pn, int wr, int wc, int fr, int fq) const {
        const bool samp = pm >= 16;
        const int cb = pn * 256;
        const bool ropey = samp && (cb < 2048 || cb == 3840);
        RopeRegs RR; rope_preload(RR, fq); (void)ropey;
        const int prow0 = (((pm * 256) & 1023) >> 6) + wr;
        EPI_LOOP(
            const int kvr = kvrow_of(row);
            if (col0 < 2048 || (col0 >= 3840 && col0 < 3904)) {
                f32x4 r0 = v0, r1 = v1;
                if (samp) rope_rot(RR, ((col0 >> 5) & 1) ? (m * 16 + fr) : (prow0 + 2 * ai), r0, r1);
                if (col0 < 1024) { bf16_t* q = QD + (size_t)row * 1024 + col0; st_bf4(q, r0); st_bf4(q + 16, r1); }
                else if (col0 < 2048) {
                    const int c = col0 - 1024; bf16_t* q = KD + (size_t)kvr * 1024 + c; st_bf4(q, r0); st_bf4(q + 16, r1);
                    if (!samp) { float* o = oak + (size_t)row * 1024 + c; st_f4_nt(o, v0); st_f4_nt(o + 16, v1); }
                } else {
                    const int c = col0 - 3840; bf16_t* q = KPE + (size_t)kvr * 64 + c; st_bf4(q, r0); st_bf4(q + 16, r1);
                    if (!samp) { float* o = okpe + (size_t)row * 64 + c; st_f4_nt(o, v0); st_f4_nt(o + 16, v1); }
                }
            } else if (col0 < 3072) {
                const int c = col0 - 2048; bf16_t* q = VD + (size_t)kvr * 1024 + c; st_bf4(q, v0); st_bf4(q + 16, v1);
                if (!samp) { float* o = oav + (size_t)row * 1024 + c; st_f4_nt(o, v0); st_f4_nt(o + 16, v1); }
            } else if (col0 < 3584) {
                bf16_t* q = CQR + (size_t)row * 512 + (col0 - 3072); st_bf4(q, v0); st_bf4(q + 16, v1);
            } else if (col0 < 3840) {
                float* o = CKVR + (size_t)row * 256 + (col0 - 3584); st_f4(o, v0); st_f4(o + 16, v1);
            } else if (col0 < 5952) {
                f32x4 s0, s1;
                _Pragma("unroll") for (int j = 0; j < 4; ++j) { s0[j] = v0[j] * sigmoidf_(v0[j]); s1[j] = v1[j] * sigmoidf_(v1[j]); }
                bf16_t* q = SG + (size_t)row * 2048 + (col0 - 3904); st_bf4(q, s0); st_bf4(q + 16, s1);
            }
        )
    }
};
struct EpiQ {
    bf16_t* QB; const f32x2* rope;
    DI void run(const acc_t& acc, int pm, int pn, int wr, int wc, int fr, int fq) const {
        const bool samp = pm >= 16;
        RopeRegs RR; rope_preload(RR, fq);
        const int prow0 = (((pm * 256) & 1023) >> 6) + wr;
        EPI_LOOP(
            const int hh = col0 / 192; const int w = col0 - hh * 192;
            if (samp && w >= 128) rope_rot(RR, (((w - 128) >> 5) & 1) ? (m * 16 + fr) : (prow0 + 2 * ai), v0, v1);
            bf16_t* q = QB + (size_t)row * 1536 + col0; st_bf4(q, v0); st_bf4(q + 16, v1);
        )
    }
};
struct EpiBf {
    bf16_t* O; int ldc; int ncols;
    DI void run(const acc_t& acc, int pm, int pn, int wr, int wc, int fr, int fq) const {
        EPI_LOOP(
            if (col0 < ncols) { bf16_t* q = O + (size_t)row * ldc + col0; st_bf4(q, v0); st_bf4(q + 16, v1); }
        )
    }
};
struct EpiOut {
    const float* xp; const float* xs; float* xo; const float* modg;
    DI void run(const acc_t& acc, int pm, int pn, int wr, int wc, int fr, int fq) const {
        const int brow = pm * 256, cbase = pn * 256 + wc * 32 + fq * 4;
        const float* g = modg + cond_of(brow) * 6144 + cbase;
        f32x4 gg[2][2];
#pragma unroll
        for (int bj = 0; bj < 2; ++bj) { gg[bj][0] = ld_f4(g + bj * 128); gg[bj][1] = ld_f4(g + bj * 128 + 16); }
        const float* xi = (brow < 4096 ? xp + (size_t)brow * 2048 : xs + (size_t)(brow - 4096) * 2048) + (size_t)(wr * 64 + fr) * 2048 + cbase;
        float* xob = xo + (size_t)(brow + wr * 64 + fr) * 2048 + cbase;
        f32x4 xv[4][2][2][2];
#define EO_LOAD(b) _Pragma("unroll") for (int mm = 0; mm < 2; ++mm) _Pragma("unroll") for (int bj = 0; bj < 2; ++bj) { \
            const float* q = xi + (size_t)(((b) >> 1) * 128 + (((b) & 1) * 2 + mm) * 16) * 2048 + bj * 128; xv[b][mm][bj][0] = ld_f4_nt(q); xv[b][mm][bj][1] = ld_f4_nt(q + 16); }
#define EO_STORE(b) _Pragma("unroll") for (int mm = 0; mm < 2; ++mm) _Pragma("unroll") for (int bj = 0; bj < 2; ++bj) { \
            float* o = xob + (size_t)(((b) >> 1) * 128 + (((b) & 1) * 2 + mm) * 16) * 2048 + bj * 128; \
            st_f4(o, xv[b][mm][bj][0] + gg[bj][0] * acc[(b) >> 1][bj][((b) & 1) * 2 + mm][0]); st_f4(o + 16, xv[b][mm][bj][1] + gg[bj][1] * acc[(b) >> 1][bj][((b) & 1) * 2 + mm][1]); }
        EO_LOAD(0) EO_LOAD(1) EO_STORE(0) EO_LOAD(2) EO_STORE(1) EO_LOAD(3) EO_STORE(2) EO_STORE(3)
#undef EO_LOAD
#undef EO_STORE
    }
};
struct EpiGate {
    bf16_t* O; const float* modg;
    DI void run(const acc_t& acc, int pm, int pn, int wr, int wc, int fr, int fq) const {
        const float* g = modg + cond_of(pm * 256) * 6144 + pn * 256 + wc * 32 + fq * 4;
        f32x4 gg[2][2];
#pragma unroll
        for (int bj = 0; bj < 2; ++bj) { gg[bj][0] = ld_f4(g + bj * 128); gg[bj][1] = ld_f4(g + bj * 128 + 16); }
        EPI_LOOP(
            bf16_t* q = O + (size_t)row * 2048 + col0; st_bf4(q, gg[bj][0] * v0); st_bf4(q + 16, gg[bj][1] * v1);
        )
    }
};
typedef _Float16 h16x2 __attribute__((ext_vector_type(2)));
DI unsigned pkh2(float a, float b) { f32x2 v = {a, b}; h16x2 r = __builtin_convertvector(v, h16x2); return __builtin_bit_cast(unsigned, r); }
DI float h2f_(unsigned short h) { return (float)__builtin_bit_cast(_Float16, h); }
DI f32x4 h4_to_f4(u32x2 u) { const unsigned u0 = u[0], u1 = u[1]; f32x4 r = {h2f_((unsigned short)(u0 & 0xffffu)), h2f_((unsigned short)(u0 >> 16)), h2f_((unsigned short)(u1 & 0xffffu)), h2f_((unsigned short)(u1 >> 16))}; return r; }
template <int CTRL> DI float dpp_rowshift0(float x) { return __int_as_float(__builtin_amdgcn_update_dpp(0, __float_as_int(x), CTRL, 0xF, 0xF, true)); }
struct EpiDecay {
    bf16_t* O; const float* bias; int rev;
    DI void run(const acc_t& acc, int pm, int pn, int wr, int wc, int fr, int fq) const {
        const float* bp = bias + pn * 256 + wc * 32 + fq * 4;
        f32x4 bb[2][2];
#pragma unroll
        for (int bj = 0; bj < 2; ++bj) { bb[bj][0] = ld_f4(bp + bj * 128); bb[bj][1] = ld_f4(bp + bj * 128 + 16); }
        EPI_LOOP(
            f32x4 r0; f32x4 r1;
            _Pragma("unroll") for (int j = 0; j < 4; ++j) {
                float a = 0.6065306597126334f * sigmoidf_(bb[bj][0][j] + v0[j]); float b = 0.6065306597126334f * sigmoidf_(bb[bj][1][j] + v1[j]);
                if (rev) {
                    a += dpp_rowshift0<0x101>(a); a += dpp_rowshift0<0x102>(a); a += dpp_rowshift0<0x104>(a); a += dpp_rowshift0<0x108>(a);
                    b += dpp_rowshift0<0x101>(b); b += dpp_rowshift0<0x102>(b); b += dpp_rowshift0<0x104>(b); b += dpp_rowshift0<0x108>(b);
                } else {
                    a += dpp_rowshift0<0x111>(a); a += dpp_rowshift0<0x112>(a); a += dpp_rowshift0<0x114>(a); a += dpp_rowshift0<0x118>(a);
                    b += dpp_rowshift0<0x111>(b); b += dpp_rowshift0<0x112>(b); b += dpp_rowshift0<0x114>(b); b += dpp_rowshift0<0x118>(b);
                }
                r0[j] = a; r1[j] = b;
            }
            bf16_t* q = O + (size_t)row * 2048 + col0;
            { u32x2 u = {pkh2(r0[0], r0[1]), pkh2(r0[2], r0[3])}; *(u32x2*)q = u; }
            { u32x2 u = {pkh2(r1[0], r1[1]), pkh2(r1[2], r1[3])}; *(u32x2*)(q + 16) = u; }
        )
    }
};
struct EpiLora {
    bf16_t* O; const float* bias; float mul;
    DI void run(const acc_t& acc, int pm, int pn, int wr, int wc, int fr, int fq) const {
        const float* bp = bias + pn * 256 + wc * 32 + fq * 4;
        f32x4 bb[2][2];
#pragma unroll
        for (int bj = 0; bj < 2; ++bj) { bb[bj][0] = ld_f4(bp + bj * 128); bb[bj][1] = ld_f4(bp + bj * 128 + 16); }
        EPI_LOOP(
            f32x4 r0, r1;
            _Pragma("unroll") for (int j = 0; j < 4; ++j) { r0[j] = mul * sigmoidf_(bb[bj][0][j] + v0[j]); r1[j] = mul * sigmoidf_(bb[bj][1][j] + v1[j]); }
            bf16_t* q = O + (size_t)row * 2048 + col0; st_bf4(q, r0); st_bf4(q + 16, r1);
        )
    }
};

DI void transpose_tile(LAS float* tl, const float* src, int K, int N, bf16_t* dst, int Kpad, int kt, int ntile, const int wv__) {
    const int tid = otid(), k0 = kt * 64, n0 = ntile * 256;
    const int kr = tid >> 6, nc = (tid & 63) * 4;
    f32x4 v[8];
#pragma unroll
    for (int i = 0; i < 8; ++i) {
        const int k = k0 + kr + i * 8;
        v[i] = (f32x4){0.f, 0.f, 0.f, 0.f};
        if (k < K && n0 + nc < N) v[i] = ld_f4_nt(src + (size_t)k * N + n0 + nc);
    }
#pragma unroll
    for (int i = 0; i < 8; ++i) {
        LAS float* t = tl + (kr + i * 8) * 257 + nc;
        t[0] = v[i][0]; t[1] = v[i][1]; t[2] = v[i][2]; t[3] = v[i][3];
    }
    __syncthreads();
    const int kc = (tid & 7) * 8;
#pragma unroll
    for (int i = 0; i < 4; ++i) {
        const int n = (tid >> 3) + i * 64;
        float e[8];
#pragma unroll
        for (int j = 0; j < 8; ++j) e[j] = tl[(kc + j) * 257 + n];
        u32x4 o = {pk2(e[0], e[1]), pk2(e[2], e[3]), pk2(e[4], e[5]), pk2(e[6], e[7])};
        *(u32x4*)(dst + (size_t)(n0 + n) * Kpad + k0 + kc) = o;
    }
    __syncthreads();
}
DI void cvt_cache(const float* src, bf16_t* dst, int W, int item, const int wv__) {
    const size_t e = (size_t)item * 4096 + otid() * 8;
    const int srow = (int)(e / W), c = (int)(e % W);
    const int b = srow >> 9, s = srow & 511;
    const int drow = 4096 + b * 1536 + 1024 + s;
    const f32x4 a = ld_f4_nt(src + e), bb = ld_f4_nt(src + e + 4);
    u32x4 o = {pk2(a[0], a[1]), pk2(a[2], a[3]), pk2(bb[0], bb[1]), pk2(bb[2], bb[3])};
    *(u32x4*)(dst + (size_t)drow * W + c) = o;
}
DI void mod_job(const Params& p, LAS unsigned char* lds, int item, const int wv__) {
    LAS float* sl = (LAS float*)lds;
    LAS float* red = sl + 5 * 2048;
    const int tid = otid();
    const float* cc = p.in[8]; const float* cctx = p.in[9];
    for (int i = tid; i < 5 * 2048; i += NTHREADS) { const int cnd = i >> 11, k = i & 2047; const float c = cnd == 0 ? cctx[k] : cc[(cnd - 1) * 2048 + k]; sl[i] = c * sigmoidf_(c); }
    __syncthreads();
    const int l = item / 192, n0 = (item % 192) * 32;
    const int kg = tid >> 3, cl = (tid & 7) * 4;
    const float* W = p.in[10] + (size_t)l * 2048 * 6144 + n0 + cl;
    f32x4 acc[5];
#pragma unroll
    for (int c = 0; c < 5; ++c) acc[c] = (f32x4){0.f, 0.f, 0.f, 0.f};
#pragma unroll 8
    for (int pass = 0; pass < 32; ++pass) {
        const int k = pass * 64 + kg;
        const f32x4 w = ld_f4_nt(W + (size_t)k * 6144);
#pragma unroll
        for (int c = 0; c < 5; ++c) acc[c] += sl[c * 2048 + k] * w;
    }
#pragma unroll
    for (int c = 0; c < 5; ++c)
#pragma unroll
        for (int j = 0; j < 4; ++j) red[kg * 160 + c * 32 + cl + j] = acc[c][j];
    __syncthreads();
    if (tid < 160) {
        float s = 0.f;
        for (int g = 0; g < 64; ++g) s += red[g * 160 + tid];
        const int cnd = tid >> 5, c = tid & 31;
        float* mod = (float*)(p.ws + OFF_MOD);
        mod[(size_t)(l * 5 + cnd) * 6144 + n0 + c] = s + p.in[11][l * 6144 + n0 + c];
    }
    __syncthreads();
}
DI void prep_phase(const Params& p, LAS unsigned char* lds, const int wv__) {
    constexpr int J_MOD = 384;
    constexpr int J_T0 = 32 * 24, J_T1 = 32 * 34, J_TO = 32 * 8, J_TUQ = 8 * 6, J_TUKV = 4 * 8, J_TL = 2 * 8;
    constexpr int J_CK = 512, J_CV = 512, J_CC = 128, J_CP = 32;
    constexpr int TOTAL = J_MOD + J_T0 + J_T1 + 2 * J_TO + J_TUQ + J_TUKV + 4 * J_TL + J_CK + J_CV + J_CC + J_CP + 1;
    LAS float* tl = (LAS float*)lds;
    for (int job = blockIdx.x; job < TOTAL + 384; job += gridDim.x) {
        int j = job;
        if (gridDim.x == 256) {
            if (job >= 512 && job < 1280) { if ((job & 255) < 128) continue; j = job - (((job - 512) >> 8) * 128 + 128); }
            else if (job >= 1280) j = job - 384;
        } else if (job >= TOTAL) continue;
        if (j < J_MOD) { mod_job(p, lds, j, wv__); continue; } j -= J_MOD;
        if (j < J_T0) { transpose_tile(tl, p.in[14], 2048, 5952, (bf16_t*)(p.ws + OFF_WT0), 2048, j % 32, j / 32, wv__); continue; } j -= J_T0;
        if (j < J_T1) { transpose_tile(tl, p.in[22], 2048, 8576, (bf16_t*)(p.ws + OFF_WT1), 2048, j % 32, j / 32, wv__); continue; } j -= J_T1;
        if (j < J_TO) { transpose_tile(tl, p.in[15], 2048, 2048, (bf16_t*)(p.ws + OFF_WOT0), 2048, j % 32, j / 32, wv__); continue; } j -= J_TO;
        if (j < J_TO) { transpose_tile(tl, p.in[23], 2048, 2048, (bf16_t*)(p.ws + OFF_WOT1), 2048, j % 32, j / 32, wv__); continue; } j -= J_TO;
        if (j < J_TUQ) { transpose_tile(tl, p.in[19], 512, 1536, (bf16_t*)(p.ws + OFF_WUQ), 512, j % 8, j / 8, wv__); continue; } j -= J_TUQ;
        if (j < J_TUKV) { transpose_tile(tl, p.in[21], 256, 2048, (bf16_t*)(p.ws + OFF_WUKV), 256, j % 4, j / 4, wv__); continue; } j -= J_TUKV;
        if (j < 4 * J_TL) {
            const int which = j / J_TL, jj = j % J_TL, z = which & 1;
            const float* src = (which < 2 ? p.in[26] : p.in[28]) + (size_t)z * 96 * 2048;
            bf16_t* dst = (bf16_t*)(p.ws + (which < 2 ? OFF_W2T : OFF_A2T)) + (size_t)z * 2048 * 128;
            transpose_tile(tl, src, 96, 2048, dst, 128, jj % 2, jj / 2, wv__); continue;
        } j -= 4 * J_TL;
        if (j < J_CK) { cvt_cache(p.in[2], (bf16_t*)(p.ws + OFF_KD), 1024, j, wv__); continue; } j -= J_CK;
        if (j < J_CV) { cvt_cache(p.in[3], (bf16_t*)(p.ws + OFF_VD), 1024, j, wv__); continue; } j -= J_CV;
        if (j < J_CC) { cvt_cache(p.in[4], (bf16_t*)(p.ws + OFF_CKVA), 256, j, wv__); continue; } j -= J_CC;
        if (j < J_CP) { cvt_cache(p.in[5], (bf16_t*)(p.ws + OFF_KPE), 64, j, wv__); continue; } j -= J_CP;
        {
            f32x2* tab = (f32x2*)(p.ws + OFF_ROPE);
            for (int i = otid(); i < 1024; i += NTHREADS) {
                const int pos = i >> 4, fi = i & 15;
                const float f = powf(10000.f, -(float)fi / 16.f);
                const float ang = (float)pos * f;
                f32x2 t = {cosf(ang), sinf(ang)};
                tab[i] = t;
            }
        }
    }
}

DI void norm_mod_phase(const float* xp, const float* xs, const float* g, const float* modl, bf16_t* H, const int wv__) {
    const int tid_ = otid(), lane = tid_ & 63, wg = blockIdx.x * 8 + (tid_ >> 6), nw = gridDim.x * 8;
    for (int row = wg; row < 8192; row += nw) {
        const float* x = row < 4096 ? xp + (size_t)row * 2048 : xs + (size_t)(row - 4096) * 2048;
        const float* md = modl + cond_of(row) * 6144;
        f32x4 v[8]; float ss = 0.f;
#pragma unroll
        for (int i = 0; i < 8; ++i) { v[i] = ld_f4_nt(x + i * 256 + lane * 4); ss += v[i][0] * v[i][0] + v[i][1] * v[i][1] + v[i][2] * v[i][2] + v[i][3] * v[i][3]; }
        f32x4 gs[8], sh[8];
#pragma unroll
        for (int i = 0; i < 8; ++i) { const int c = i * 256 + lane * 4; gs[i] = ld_f4(g + c) * (1.f + ld_f4(md + 2048 + c)); sh[i] = ld_f4(md + c); }
        ss = wave_sum(ss, lane);
        const float rstd = rsqrtf(ss * (1.f / 2048.f) + 1e-6f);
#pragma unroll
        for (int i = 0; i < 8; ++i) {
            const int c = i * 256 + lane * 4;
            const f32x4 h = v[i] * rstd * gs[i] + sh[i];
            st_bf4(H + (size_t)row * 2048 + c, h);
        }
    }
}
DI void final_norm_phase(float* x, const bf16_t* O2, const float* g, const int wv__) {
    const int tid_ = otid(), lane = tid_ & 63, wg = blockIdx.x * 8 + (tid_ >> 6), nw = gridDim.x * 8;
    for (int row = wg; row < 8192; row += nw) {
        float* xr = x + (size_t)row * 2048;
        f32x4 v[8]; float ss = 0.f;
#pragma unroll
        for (int i = 0; i < 8; ++i) { v[i] = ld_f4_nt(xr + i * 256 + lane * 4) + bf4_to_f4(__builtin_nontemporal_load((const u32x2*)(O2 + (size_t)row * 2048 + i * 256 + lane * 4))); ss += v[i][0] * v[i][0] + v[i][1] * v[i][1] + v[i][2] * v[i][2] + v[i][3] * v[i][3]; }
        ss = wave_sum(ss, lane);
        const float rstd = rsqrtf(ss * (1.f / 2048.f) + 1e-6f);
#pragma unroll
        for (int i = 0; i < 8; ++i) { const int c = i * 256 + lane * 4; st_f4_nt(xr + c, v[i] * rstd * ld_f4(g + c)); }
    }
}
DI void lat_norm_phase(const Params& p, const int wv__) {
    const int tid_ = otid(), lane = tid_ & 63, wg = blockIdx.x * 8 + (tid_ >> 6), nw = gridDim.x * 8;
    const bf16_t* CQR = (const bf16_t*)(p.ws + OFF_CQR); const float* CKVR = (const float*)(p.ws + OFF_CKVR);
    bf16_t* CQN = (bf16_t*)(p.ws + OFF_CQN); bf16_t* CKVA = (bf16_t*)(p.ws + OFF_CKVA);
    const float* qg = p.in[18]; const float* kg = p.in[20];
    for (int row = wg; row < 8192; row += nw) {
        const u32x4 u = __builtin_nontemporal_load((const u32x4*)(CQR + (size_t)row * 512 + lane * 8));
        float q[8] = {bflo(u[0]), bfhi(u[0]), bflo(u[1]), bfhi(u[1]), bflo(u[2]), bfhi(u[2]), bflo(u[3]), bfhi(u[3])};
        float ss = 0.f;
#pragma unroll
        for (int i = 0; i < 8; ++i) ss += q[i] * q[i];
        ss = wave_sum(ss, lane);
        float rstd = rsqrtf(ss * (1.f / 512.f) + 1e-6f);
        const f32x4 g0 = ld_f4(qg + lane * 8), g1 = ld_f4(qg + lane * 8 + 4);
        u32x4 o = {pk2(q[0] * rstd * g0[0], q[1] * rstd * g0[1]), pk2(q[2] * rstd * g0[2], q[3] * rstd * g0[3]),
                   pk2(q[4] * rstd * g1[0], q[5] * rstd * g1[1]), pk2(q[6] * rstd * g1[2], q[7] * rstd * g1[3])};
        *(u32x4*)(CQN + (size_t)row * 512 + lane * 8) = o;
        const f32x4 kv = ld_f4_nt(CKVR + (size_t)row * 256 + lane * 4);
        float s2 = kv[0] * kv[0] + kv[1] * kv[1] + kv[2] * kv[2] + kv[3] * kv[3];
        s2 = wave_sum(s2, lane);
        rstd = rsqrtf(s2 * (1.f / 256.f) + 1e-6f);
        const f32x4 r = kv * rstd * ld_f4(kg + lane * 4);
        if (row < 4096) st_f4_nt(p.out + OUT_CKV + (size_t)row * 256 + lane * 4, r);
        st_bf4(CKVA + (size_t)kvrow_of(row) * 256 + lane * 4, r);
    }
}

template <int TYPE>
DI void attn_unit(const Params& p, LAS unsigned char* lds, int samp, int b, int h, int qb, float lam, const int wv__) {
    constexpr int NC = TYPE == 0 ? 2 : 1, KS = TYPE == 0 ? 2 : 6, KDIM = TYPE == 0 ? 128 : 192;
    constexpr int KP = KDIM * 2 + 16, VP = 288, CPK = KDIM / 8, NKC = 64 * CPK / NTHREADS;
    LAS unsigned char* Ks = lds; LAS unsigned char* Vs = lds + 64 * KP;
    const int tid = otid(), wid = tid >> 6, lane = tid & 63, fr = lane & 15, fq = lane >> 4;
    const int row0 = samp ? 4096 + b * 1024 + qb * 128 : b * 256 + qb * 128, qrow = row0 + wid * 16 + fr;
    const int kv0 = samp ? 4096 + b * 1536 : b * 256, ntile = samp ? 24 : 4;
    const bf16_t* QD = (const bf16_t*)(p.ws + OFF_QD); const bf16_t* KD = (const bf16_t*)(p.ws + OFF_KD); const bf16_t* VD = (const bf16_t*)(p.ws + OFF_VD);
    const bf16_t* QB = (const bf16_t*)(p.ws + OFF_QB); const bf16_t* KVB = (const bf16_t*)(p.ws + OFF_KVB); const bf16_t* KPE = (const bf16_t*)(p.ws + OFF_KPE);
    bf16x8 qf[NC * KS];
#pragma unroll
    for (int i = 0; i < NC * KS; ++i)
        qf[i] = TYPE == 0 ? __builtin_nontemporal_load((const bf16x8*)(QD + (size_t)qrow * 1024 + h * 128 + i * 32 + fq * 8)) : __builtin_nontemporal_load((const bf16x8*)(QB + (size_t)qrow * 1536 + h * 192 + i * 32 + fq * 8));
    f32x4 o[NC][8];
    float mrun[NC], lrun[NC];
#pragma unroll
    for (int c = 0; c < NC; ++c) { mrun[c] = -1e30f; lrun[c] = 0.f;
#pragma unroll
        for (int v = 0; v < 8; ++v) o[c][v] = (f32x4){0.f, 0.f, 0.f, 0.f}; }
    const float sl2 = (TYPE == 0 ? 0.125f : 0.07216878364870322f) * 1.4426950408889634f;
    u32x4 kreg[NKC], vreg[2];
    auto prefetch = [&](int t) {
#pragma unroll
        for (int i = 0; i < NKC; ++i) {
            const int q = tid + i * NTHREADS, key = q / CPK, ch = q % CPK; const size_t r = (size_t)(kv0 + t * 64 + key);
            const bf16_t* src;
            if (TYPE == 0) src = KD + r * 1024 + h * 128 + ch * 8;
            else src = ch < 16 ? KVB + r * 2048 + h * 256 + ch * 8 : KPE + r * 64 + (ch - 16) * 8;
            kreg[i] = *(const u32x4*)src;
        }
#pragma unroll
        for (int i = 0; i < 2; ++i) {
            const int q = tid + i * NTHREADS, key = q >> 4, ch = q & 15; const size_t r = (size_t)(kv0 + t * 64 + key);
            const bf16_t* src = TYPE == 0 ? VD + r * 1024 + h * 128 + ch * 8 : KVB + r * 2048 + h * 256 + 128 + ch * 8;
            vreg[i] = *(const u32x4*)src;
        }
    };
    constexpr int BUFB = 64 * KP + 64 * VP;
    auto lds_write = [&](int buf) {
        LAS unsigned char* Kb = lds + buf * BUFB; LAS unsigned char* Vb = Kb + 64 * KP;
#pragma unroll
        for (int i = 0; i < NKC; ++i) { const int q = tid + i * NTHREADS, key = q / CPK, ch = q % CPK; *(LAS u32x4*)(Kb + key * KP + ch * 16) = kreg[i]; }
#pragma unroll
        for (int i = 0; i < 2; ++i) { const int q = tid + i * NTHREADS, key = q >> 4, ch = q & 15; *(LAS u32x4*)(Vb + key * VP + ch * 16) = vreg[i]; }
    };
    prefetch(0);
    lds_write(0);
    if (ntile > 1) prefetch(1);
    __syncthreads();
    const int qq = (lane & 15) >> 2, pp = lane & 3;
    for (int t = 0; t < ntile; ++t) {
        if (t + 1 < ntile) lds_write((t + 1) & 1);
        if (t + 2 < ntile) prefetch(t + 2);
        LAS unsigned char* Kc = lds + (t & 1) * BUFB; LAS unsigned char* Vc = Kc + 64 * KP;
        f32x4 s[NC][4];
#pragma unroll
        for (int c = 0; c < NC; ++c)
#pragma unroll
            for (int nt = 0; nt < 4; ++nt) {
                s[c][nt] = (f32x4){0.f, 0.f, 0.f, 0.f};
#pragma unroll
                for (int ks = 0; ks < KS; ++ks) {
                    const bf16x8 kf = *(const LAS bf16x8*)(Kc + (nt * 16 + fr) * KP + (c * KS + ks) * 64 + fq * 16);
                    s[c][nt] = __builtin_amdgcn_mfma_f32_16x16x32_bf16(kf, qf[c * KS + ks], s[c][nt], 0, 0, 0);
                }
                if (nt & 1) __builtin_amdgcn_sched_barrier(0);
            }
        __builtin_amdgcn_sched_barrier(0);
        bf16x8 pb[NC][2];
#pragma unroll
        for (int c = 0; c < NC; ++c) {
            float mx = -1e30f;
#pragma unroll
            for (int nt = 0; nt < 4; ++nt)
#pragma unroll
                for (int j = 0; j < 4; ++j) mx = fmaxf(mx, s[c][nt][j]);
            mx = fmaxf(mx, shx(mx, 16, lane)); mx = fmaxf(mx, shx(mx, 32, lane));
            const float mnew = fmaxf(mrun[c], mx);
            const float alpha = __builtin_amdgcn_exp2f((mrun[c] - mnew) * sl2);
            mrun[c] = mnew;
            const float nm = -mnew * sl2;
            float ls = 0.f;
#pragma unroll
            for (int nt = 0; nt < 4; ++nt)
#pragma unroll
                for (int j = 0; j < 4; ++j) { const float e = __builtin_amdgcn_exp2f(fmaf(s[c][nt][j], sl2, nm)); s[c][nt][j] = e; ls += e; }
            lrun[c] = lrun[c] * alpha + ls;
            if (__builtin_amdgcn_ballot_w64(alpha != 1.f) != 0ull) {
#pragma unroll
                for (int v = 0; v < 8; ++v) o[c][v] *= alpha;
            }
#pragma unroll
            for (int s2 = 0; s2 < 2; ++s2) {
                u32x4 u = {pk2(s[c][2 * s2][0], s[c][2 * s2][1]), pk2(s[c][2 * s2][2], s[c][2 * s2][3]), pk2(s[c][2 * s2 + 1][0], s[c][2 * s2 + 1][1]), pk2(s[c][2 * s2 + 1][2], s[c][2 * s2 + 1][3])};
                pb[c][s2] = __builtin_bit_cast(bf16x8, u);
            }
        }
#pragma unroll
        for (int s2 = 0; s2 < 2; ++s2)
#pragma unroll
            for (int v = 0; v < 8; ++v) {
                LAS unsigned char* a0 = Vc + (32 * s2 + 4 * fq + qq) * VP + v * 32 + 8 * pp;
                const s16x4 lo = __builtin_amdgcn_ds_read_tr16_b64_v4i16((LAS s16x4*)a0);
                const s16x4 hi = __builtin_amdgcn_ds_read_tr16_b64_v4i16((LAS s16x4*)(a0 + 16 * VP));
                const bf16x8 va = __builtin_shufflevector(lo, hi, 0, 1, 2, 3, 4, 5, 6, 7);
#pragma unroll
                for (int c = 0; c < NC; ++c) o[c][v] = __builtin_amdgcn_mfma_f32_16x16x32_bf16(va, pb[c][s2], o[c][v], 0, 0, 0);
                if ((v & 1) == 1) __builtin_amdgcn_sched_barrier(0);
            }
        __syncthreads();
    }
    float linv[NC];
#pragma unroll
    for (int c = 0; c < NC; ++c) { float l = lrun[c]; l += shx(l, 16, lane); l += shx(l, 32, lane); linv[c] = 1.f / l; }
    const bf16_t* SG = (const bf16_t*)(p.ws + OFF_SG0);
    bf16_t* Y = (bf16_t*)(p.ws + OFF_H);
    if (TYPE == 0) {
        float ss = 0.f;
#pragma unroll
        for (int v = 0; v < 8; ++v)
#pragma unroll
            for (int j = 0; j < 4; ++j) { const float x = o[0][v][j] * linv[0] - lam * o[NC - 1][v][j] * linv[NC - 1]; o[0][v][j] = x; ss += x * x; }
        ss += shx(ss, 16, lane); ss += shx(ss, 32, lane);
        const float rstd = rsqrtf(ss * (1.f / 128.f) + 1e-6f) * 0.8f;
        const float* sg = p.in[17];
#pragma unroll
        for (int v = 0; v < 8; ++v) {
            const int d = v * 16 + fq * 4;
            const f32x4 g = ld_f4(sg + d);
            const f32x4 gt = bf4_to_f4(*(const u32x2*)(SG + (size_t)qrow * 2048 + h * 128 + d));
            st_bf4(Y + (size_t)qrow * 2048 + h * 128 + d, o[0][v] * rstd * g * gt);
        }
    } else {
#pragma unroll
        for (int v = 0; v < 8; ++v) {
            const int d = v * 16 + fq * 4;
            const f32x4 gt = bf4_to_f4(*(const u32x2*)(SG + (size_t)qrow * 2048 + 1024 + h * 128 + d));
            st_bf4(Y + (size_t)qrow * 2048 + 1024 + h * 128 + d, o[0][v] * linv[0] * gt);
        }
    }
}
DI void attn_phase(const Params& p, LAS unsigned char* lds, const int wv__) {
    const float* lp = p.in[16];
    const int lane = otid() & 63;
    const float s01 = wave_sum(lp[lane] * lp[64 + lane], lane), s23 = wave_sum(lp[128 + lane] * lp[192 + lane], lane);
    const float lam = __expf(s01) - __expf(s23) + 0.2f;
    for (int u = blockIdx.x; u < 1024; u += gridDim.x) {
        const int grp = u >> 8, i = u & 255;
        if (grp == 0) attn_unit<0>(p, lds, 1, i >> 6, (i >> 3) & 7, i & 7, lam, wv__);
        else if (grp == 1) attn_unit<1>(p, lds, 1, i >> 6, (i >> 3) & 7, i & 7, lam, wv__);
        else if (grp == 2) attn_unit<0>(p, lds, 0, i >> 4, (i >> 1) & 7, i & 1, lam, wv__);
        else attn_unit<1>(p, lds, 0, i >> 4, (i >> 1) & 7, i & 1, lam, wv__);
    }
}

DI f32x4 tshift(f32x4 x, f32x4 pv, f32x4 nx, f32x4 m0, f32x4 m1) { return x + m0 * (pv - x) + m1 * (nx - x); }
DI void seq_pos(int row, int& t, int& T) { if (row < 4096) { t = row & 255; T = 256; } else { t = (row - 4096) & 1023; T = 1024; } }

DI void lora_in_phase(const Params& p, const int wv__) {
    const int tid_ = otid(), lane = tid_ & 63, wg = blockIdx.x * 8 + (tid_ >> 6), nw = gridDim.x * 8;
    const bf16_t* PART = (const bf16_t*)(p.ws + OFF_PART);
    const float* mu = p.in[24];
    const int o = lane * 8, arr = o >> 7, idx = o & 127;
    bf16_t* dstb = (bf16_t*)(p.ws + (arr < 2 ? OFF_WDT : OFF_ADT)) + (size_t)(arr & 1) * 8192 * 128 + idx;
    for (int row = wg; row < 8192; row += nw) {
        u32x4 res = {0u, 0u, 0u, 0u};
        if (idx < 96) {
            int t, T; seq_pos(row, t, T);
            const int col = 8192 + arr * 96 + idx;
            const bf16_t* c = PART + (size_t)row * 2048 + arr * 96 + idx;
            float xc[8], xp[8], xn[8];
#pragma unroll
            for (int e = 0; e < 8; ++e) { xc[e] = 0.f; xp[e] = 0.f; xn[e] = 0.f; }
#pragma unroll
            for (int ks = 0; ks < 4; ++ks) {
                const u32x4 uc = *(const u32x4*)(c + ks * 512);
#pragma unroll
                for (int e = 0; e < 4; ++e) { xc[2 * e] += bflo(uc[e]); xc[2 * e + 1] += bfhi(uc[e]); }
                if (t > 0) { const u32x4 up = *(const u32x4*)(c + ks * 512 - 2048);
#pragma unroll
                    for (int e = 0; e < 4; ++e) { xp[2 * e] += bflo(up[e]); xp[2 * e + 1] += bfhi(up[e]); } }
                if (t < T - 1) { const u32x4 un = *(const u32x4*)(c + ks * 512 + 2048);
#pragma unroll
                    for (int e = 0; e < 4; ++e) { xn[2 * e] += bflo(un[e]); xn[2 * e + 1] += bfhi(un[e]); } }
            }
            float r[8];
#pragma unroll
            for (int e = 0; e < 4; ++e) {
                const f32x2 m0 = *(const f32x2*)(mu + col + 2 * e), m1 = *(const f32x2*)(mu + 8576 + col + 2 * e);
                r[2 * e] = xc[2 * e] + m0[0] * (xp[2 * e] - xc[2 * e]) + m1[0] * (xn[2 * e] - xc[2 * e]);
                r[2 * e + 1] = xc[2 * e + 1] + m0[1] * (xp[2 * e + 1] - xc[2 * e + 1]) + m1[1] * (xn[2 * e + 1] - xc[2 * e + 1]);
            }
            if (arr < 2) {
#pragma unroll
                for (int e = 0; e < 8; ++e) r[e] = tanhf(r[e]);
            }
            res = (u32x4){pk2(r[0], r[1]), pk2(r[2], r[3]), pk2(r[4], r[5]), pk2(r[6], r[7])};
        }
        *(u32x4*)(dstb + (size_t)row * 128) = res;
    }
}

struct StageRegs { u32x2 raw[9], ra, re, rep; int row; };
DI void scan_stage_load(StageRegs& R, const bf16_t* C1, const bf16_t* AZ, const bf16_t* EZ, const float* mu, const float* kkw, const float* kaw, const float* rkw,
                        int row, int t, int T, int h, int z, int c4, bool first  ) {
    (void)mu; (void)kkw; (void)kaw; (void)rkw;
    R.row = row;
    const bf16_t* c = C1 + (size_t)row * 8576 + h * 64 + c4;
    const u32x2 zero = {0u, 0u};
#pragma unroll
    for (int g = 0; g < 3; ++g) {
        R.raw[g * 3 + 1] = *(const u32x2*)(c + g * 2048);
        R.raw[g * 3 + 0] = t > 0 ? *(const u32x2*)(c + g * 2048 - 8576) : zero;
        R.raw[g * 3 + 2] = t < T - 1 ? *(const u32x2*)(c + g * 2048 + 8576) : zero;
    }
    R.ra = __builtin_nontemporal_load((const u32x2*)(AZ + ((size_t)z * 8192 + row) * 2048 + h * 64 + c4));
    R.re = *(const u32x2*)(EZ + ((size_t)z * 8192 + row) * 2048 + h * 64 + c4);
    R.rep = first ? zero : __builtin_nontemporal_load((const u32x2*)(EZ + ((size_t)z * 8192 + row + (z ? 1 : -1)) * 2048 + h * 64 + c4));
}
DI void scan_stage_store(const StageRegs& R, LAS float* sb, float* BN, bool lead, int h, int z, const LAS float* pt, bool wlast, LAS float* plast  ) {
    f32x4 x[3];
#pragma unroll
    for (int g = 0; g < 3; ++g) x[g] = tshift(bf4_to_f4(R.raw[g * 3 + 1]), bf4_to_f4(R.raw[g * 3 + 0]), bf4_to_f4(R.raw[g * 3 + 2]), *(const LAS f32x4*)(pt + (2 * g) * 64), *(const LAS f32x4*)(pt + (2 * g + 1) * 64));
    const f32x4 a = bf4_to_f4(R.ra), cs = h4_to_f4(R.re), cp = h4_to_f4(R.rep);
    const f32x4 kkr = x[1] * *(const LAS f32x4*)(pt + 6 * 64);
    float ss = kkr[0] * kkr[0] + kkr[1] * kkr[1] + kkr[2] * kkr[2] + kkr[3] * kkr[3];
    ss = sum16d(ss);
    const f32x4 kk = kkr * rsqrtf(fmaxf(ss, 1e-12f));
    const f32x4 kz = x[1] * (1.f + (a - 1.f) * *(const LAS f32x4*)(pt + 7 * 64));
    const f32x4 kka = kk * a;
    f32x4 pc, ip, pp;
#pragma unroll
    for (int j = 0; j < 4; ++j) { pc[j] = __expf(-cs[j]); ip[j] = __expf(cs[j]); pp[j] = __expf(-cp[j]); }
    const f32x4 rk = *(const LAS f32x4*)(pt + 8 * 64);
    float bn = x[0][0] * kz[0] * rk[0] + x[0][1] * kz[1] * rk[1] + x[0][2] * kz[2] * rk[2] + x[0][3] * kz[3] * rk[3];
    bn = sum16d(bn);
    if (lead) BN[((size_t)z * 8192 + R.row) * 32 + h] = bn;
    *(LAS f32x4*)(sb) = x[0] * pc; *(LAS f32x4*)(sb + 64) = kka * ip; *(LAS f32x4*)(sb + 128) = kz * ip; *(LAS f32x4*)(sb + 192) = -kk * pp; *(LAS f32x4*)(sb + 320) = x[2];
    if (wlast) *(LAS f32x4*)plast = pc;
}

DI void scan_phase(const Params& p, LAS unsigned char* lds, const int wv__) {
    const int tid = otid(), wid = __builtin_amdgcn_readfirstlane(tid >> 6), lane = tid & 63, half = wid >> 2, ht = tid & 255;
    const bf16_t* C1 = (const bf16_t*)(p.ws + OFF_C);
    const bf16_t* AZ = (const bf16_t*)(p.ws + OFF_AZ); const bf16_t* EZ = (const bf16_t*)(p.ws + OFF_EZ);
    bf16_t* YZ = (bf16_t*)(p.ws + OFF_YZ); float* BN = (float*)(p.ws + OFF_BN);
    const float* mu = p.in[24];
    LAS float* lf = (LAS float*)lds;
    for (int u = blockIdx.x; u < 256; u += gridDim.x) {
        if (half == 0) {
            const int rg = ht >> 3, cg8 = ht & 7, stt = ht >> 4, c4 = (ht & 15) * 4;
            const int b = u >> 6, h = (u >> 1) & 31, z = u & 1, T = 1024, rowbase = 4096 + b * 1024;
            LAS float* base = lf;
            LAS unsigned* ybase = (LAS unsigned*)(lf + 24576);
            f32x2 S[2][4];
            {
                const float* st = (z ? p.in[7] : p.in[6]) + (((size_t)b * 32 + h) * 64 + 2 * rg) * 64 + cg8 * 8;
#pragma unroll
                for (int rr = 0; rr < 2; ++rr) { const f32x4 v0 = ld_f4(st + rr * 64), v1 = ld_f4(st + rr * 64 + 4);
                    S[rr][0] = (f32x2){v0[0], v0[1]}; S[rr][1] = (f32x2){v0[2], v0[3]}; S[rr][2] = (f32x2){v1[0], v1[1]}; S[rr][3] = (f32x2){v1[2], v1[3]}; }
            }
            LAS float* ptab = lf + 26112;
            {
                if (ht < 16) {
                    const int hc = h * 64 + c4;
#pragma unroll
                    for (int g = 0; g < 3; ++g) { *(LAS f32x4*)(ptab + (2 * g) * 64 + c4) = ld_f4(mu + g * 2048 + hc); *(LAS f32x4*)(ptab + (2 * g + 1) * 64 + c4) = ld_f4(mu + 8576 + g * 2048 + hc); }
                    *(LAS f32x4*)(ptab + 6 * 64 + c4) = ld_f4(p.in[29] + hc); *(LAS f32x4*)(ptab + 7 * 64 + c4) = ld_f4(p.in[30] + hc); *(LAS f32x4*)(ptab + 8 * 64 + c4) = ld_f4(p.in[31] + hc);
                }
                __syncthreads();
            }
            StageRegs R;
            auto sload = [&](int ci, bool prm) { (void)prm; const int step = ci * 16 + stt, t = z ? T - 1 - step : step; scan_stage_load(R, C1, AZ, EZ, mu, p.in[29], p.in[30], p.in[31], rowbase + t, t, T, h, z, c4, stt == 0); };
            auto sstore = [&](int ci) { scan_stage_store(R, base + ((ci & 1) * 16 + stt) * 384 + c4, BN, (ht & 15) == 0, h, z, ptab + c4, stt == 15, base + (ci & 1) * 16 * 384 + 256 + c4); };
            auto flush = [&](int ci) {
                const LAS unsigned* yb = ybase + (ci & 1) * (16 * 32);
                const int fs = ht >> 4, fr4 = (ht & 15) * 2;
                const u32x2 yv = *(const LAS u32x2*)(yb + fs * 32 + fr4);
                const int step = ci * 16 + fs, t = z ? T - 1 - step : step;
                *(u32x2*)(YZ + ((size_t)z * 8192 + rowbase + t) * 2048 + h * 64 + fr4 * 2) = yv;
            };
            sload(0, true); sstore(0);
            __syncthreads();
            for (int ci = 0; ci < 64; ++ci) {
                if (ci > 0) flush(ci - 1);
                if (ci + 1 < 64) sload(ci + 1, false);
                const LAS float* cb = base + (ci & 1) * 16 * 384;
                LAS unsigned* ybuf = ybase + (ci & 1) * (16 * 32);
                f32x4 cur[8], nxt[8]; f32x2 vcur, vnxt;
                {
                    const LAS float* sb = cb + cg8 * 8;
#pragma unroll
                    for (int q = 0; q < 4; ++q) { cur[2 * q] = *(const LAS f32x4*)(sb + q * 64); cur[2 * q + 1] = *(const LAS f32x4*)(sb + q * 64 + 4); }
                    vcur = *(const LAS f32x2*)(cb + 320 + 2 * rg);
                }
#pragma unroll
                for (int s = 0; s < 16; ++s) {
                    if (s < 15) {
                        const LAS float* sb = cb + (s + 1) * 384 + cg8 * 8;
#pragma unroll
                        for (int q = 0; q < 4; ++q) { nxt[2 * q] = *(const LAS f32x4*)(sb + q * 64); nxt[2 * q + 1] = *(const LAS f32x4*)(sb + q * 64 + 4); }
                        vnxt = *(const LAS f32x2*)(cb + (s + 1) * 384 + 320 + 2 * rg);
                    }
                    f32x2 dp[4], bp[4], cp[4], ap[4];
#pragma unroll
                    for (int q = 0; q < 2; ++q) {
                        dp[2 * q] = (f32x2){cur[q][0], cur[q][1]}; dp[2 * q + 1] = (f32x2){cur[q][2], cur[q][3]};
                        bp[2 * q] = (f32x2){cur[2 + q][0], cur[2 + q][1]}; bp[2 * q + 1] = (f32x2){cur[2 + q][2], cur[2 + q][3]};
                        cp[2 * q] = (f32x2){cur[4 + q][0], cur[4 + q][1]}; cp[2 * q + 1] = (f32x2){cur[4 + q][2], cur[4 + q][3]};
                        ap[2 * q] = (f32x2){cur[6 + q][0], cur[6 + q][1]}; ap[2 * q + 1] = (f32x2){cur[6 + q][2], cur[6 + q][3]};
                    }
                    float sa[2], yy[2];
#pragma unroll
                    for (int rr = 0; rr < 2; ++rr) {
                        f32x2 a2 = S[rr][0] * ap[0] + S[rr][1] * ap[1];
                        f32x2 b2 = S[rr][2] * ap[2] + S[rr][3] * ap[3];
                        a2 += b2;
                        float x = a2[0] + a2[1];
                        x += dpp_xor1(x); x += dpp_xor2(x); x += dpp_hmirror(x);
                        sa[rr] = x;
                    }
#pragma unroll
                    for (int rr = 0; rr < 2; ++rr) {
                        const f32x2 sa2 = {sa[rr], sa[rr]}, v2 = {vcur[rr], vcur[rr]};
                        f32x2 y2 = {0.f, 0.f}, y3 = {0.f, 0.f};
#pragma unroll
                        for (int q = 0; q < 4; ++q) {
                            S[rr][q] = sa2 * bp[q] + (v2 * cp[q] + S[rr][q]);
                            if (q & 1) y3 += S[rr][q] * dp[q]; else y2 += S[rr][q] * dp[q];
                        }
                        y2 += y3;
                        float x = y2[0] + y2[1];
                        x += dpp_xor1(x); x += dpp_xor2(x); x += dpp_hmirror(x);
                        yy[rr] = x;
                    }
                    ybuf[s * 32 + rg] = pk2(yy[0], yy[1]);
                    if (s < 15) {
#pragma unroll
                        for (int q = 0; q < 8; ++q) cur[q] = nxt[q];
                        vcur = vnxt;
                    }
                }
                {
                    const f32x4 p0 = *(const LAS f32x4*)(cb + 256 + cg8 * 8), p1 = *(const LAS f32x4*)(cb + 256 + cg8 * 8 + 4);
                    const f32x2 pl[4] = {(f32x2){p0[0], p0[1]}, (f32x2){p0[2], p0[3]}, (f32x2){p1[0], p1[1]}, (f32x2){p1[2], p1[3]}};
#pragma unroll
                    for (int rr = 0; rr < 2; ++rr)
#pragma unroll
                        for (int q = 0; q < 4; ++q) S[rr][q] *= pl[q];
                }
                if (ci + 1 < 64) sstore(ci + 1);
                __syncthreads();
            }
            flush(63);
            __syncthreads();
        } else {
            const int pw = wid - 4, pu = 4 * u + pw;
            const int b = pu >> 6, h = (pu >> 1) & 31, z = pu & 1, T = 256, rowbase = b * 256;
            const int rg = lane >> 2, cg = lane & 3, stt = lane >> 4, c4 = (lane & 15) * 4;
            LAS float* base = lf + 12288 + pw * (2 * 4 * 384);
            LAS unsigned* ybuf = (LAS unsigned*)(lf + 25600) + pw * (4 * 32);
            f32x2 S[4][8];
#pragma unroll
            for (int rr = 0; rr < 4; ++rr)
#pragma unroll
                for (int q = 0; q < 8; ++q) S[rr][q] = (f32x2){0.f, 0.f};
            LAS float* ptab = lf + 26688 + pw * 576;
            {
                if (lane < 16) {
                    const int hc = h * 64 + c4;
#pragma unroll
                    for (int g = 0; g < 3; ++g) { *(LAS f32x4*)(ptab + (2 * g) * 64 + c4) = ld_f4(mu + g * 2048 + hc); *(LAS f32x4*)(ptab + (2 * g + 1) * 64 + c4) = ld_f4(mu + 8576 + g * 2048 + hc); }
                    *(LAS f32x4*)(ptab + 6 * 64 + c4) = ld_f4(p.in[29] + hc); *(LAS f32x4*)(ptab + 7 * 64 + c4) = ld_f4(p.in[30] + hc); *(LAS f32x4*)(ptab + 8 * 64 + c4) = ld_f4(p.in[31] + hc);
                }
                __syncthreads();
            }
            StageRegs R;
            auto sload = [&](int it, bool prm) { (void)prm; const int step = it * 4 + stt, t = z ? T - 1 - step : step; scan_stage_load(R, C1, AZ, EZ, mu, p.in[29], p.in[30], p.in[31], rowbase + t, t, T, h, z, c4, (step & 15) == 0); };
            auto sstore = [&](int it) { scan_stage_store(R, base + ((it & 1) * 4 + stt) * 384 + c4, BN, (lane & 15) == 0, h, z, ptab + c4, (it & 3) == 3 && stt == 3, base + (it & 1) * 4 * 384 + 256 + c4); };
            sload(0, true); sstore(0);
            __syncthreads();
            for (int it = 0; it < 64; ++it) {
                if (it + 1 < 64) sload(it + 1, false);
                const LAS float* cb = base + (it & 1) * 4 * 384;
#pragma unroll 1
                for (int s = 0; s < 4; ++s) {
                    const LAS float* sb = cb + s * 384 + cg * 16;
                    f32x2 dp[8], bp[8], cp[8], ap[8];
#pragma unroll
                    for (int q = 0; q < 4; ++q) {
                        const f32x4 a4 = *(const LAS f32x4*)(sb + 192 + q * 4);
                        ap[2 * q] = (f32x2){a4[0], a4[1]}; ap[2 * q + 1] = (f32x2){a4[2], a4[3]};
                    }
                    const f32x4 vv = *(const LAS f32x4*)(cb + s * 384 + 320 + 4 * rg);
                    float yy[4], sav[4];
#pragma unroll
                    for (int rr = 0; rr < 4; ++rr) {
                        f32x2 a2 = S[rr][0] * ap[0] + S[rr][1] * ap[1];
                        f32x2 b2 = S[rr][2] * ap[2] + S[rr][3] * ap[3];
                        a2 += S[rr][4] * ap[4] + S[rr][5] * ap[5];
                        b2 += S[rr][6] * ap[6] + S[rr][7] * ap[7];
                        a2 += b2;
                        float sa = a2[0] + a2[1];
                        sa += dpp_xor1(sa); sa += dpp_xor2(sa);
                        sav[rr] = sa;
                    }
                    __builtin_amdgcn_sched_barrier(0);
#pragma unroll
                    for (int q = 0; q < 4; ++q) {
                        const f32x4 a0 = *(const LAS f32x4*)(sb + q * 4), a1 = *(const LAS f32x4*)(sb + 64 + q * 4), a2 = *(const LAS f32x4*)(sb + 128 + q * 4);
                        dp[2 * q] = (f32x2){a0[0], a0[1]}; dp[2 * q + 1] = (f32x2){a0[2], a0[3]};
                        bp[2 * q] = (f32x2){a1[0], a1[1]}; bp[2 * q + 1] = (f32x2){a1[2], a1[3]};
                        cp[2 * q] = (f32x2){a2[0], a2[1]}; cp[2 * q + 1] = (f32x2){a2[2], a2[3]};
                    }
#pragma unroll
                    for (int rr = 0; rr < 4; ++rr) {
                        const f32x2 sa2 = {sav[rr], sav[rr]}, v2 = {vv[rr], vv[rr]};
                        f32x2 y2 = {0.f, 0.f}, y3 = {0.f, 0.f};
#pragma unroll
                        for (int q = 0; q < 8; ++q) {
                            S[rr][q] = sa2 * bp[q] + (v2 * cp[q] + S[rr][q]);
                            if (q & 1) y3 += S[rr][q] * dp[q]; else y2 += S[rr][q] * dp[q];
                        }
                        y2 += y3;
                        float x = y2[0] + y2[1];
                        x += dpp_xor1(x); x += dpp_xor2(x);
                        yy[rr] = x;
                    }
                    const u32x2 yo = {pk2(yy[0], yy[1]), pk2(yy[2], yy[3])};
                    *(LAS u32x2*)(ybuf + s * 32 + rg * 2) = yo;
                }
                {
                    const int fs = lane >> 4, fr4 = (lane & 15) * 2;
                    const u32x2 yv = *(const LAS u32x2*)(ybuf + fs * 32 + fr4);
                    const int step = it * 4 + fs, t = z ? T - 1 - step : step;
                    *(u32x2*)(YZ + ((size_t)z * 8192 + rowbase + t) * 2048 + h * 64 + fr4 * 2) = yv;
                }
                if ((it & 3) == 3) {
#pragma unroll
                    for (int q = 0; q < 4; ++q) {
                        const f32x4 pv = *(const LAS f32x4*)(cb + 256 + cg * 16 + q * 4);
                        const f32x2 pa = {pv[0], pv[1]}, pb2 = {pv[2], pv[3]};
#pragma unroll
                        for (int rr = 0; rr < 4; ++rr) { S[rr][2 * q] *= pa; S[rr][2 * q + 1] *= pb2; }
                    }
                }
                if (it + 1 < 64) sstore(it + 1);
                __syncthreads();
            }
            {
                float* st = p.out + (z ? OUT_SB : OUT_SF) + (((size_t)b * 32 + h) * 64 + 4 * rg) * 64 + cg * 16;
#pragma unroll
                for (int rr = 0; rr < 4; ++rr)
#pragma unroll
                    for (int q = 0; q < 4; ++q) { const f32x4 v = {S[rr][2 * q][0], S[rr][2 * q][1], S[rr][2 * q + 1][0], S[rr][2 * q + 1][1]}; st_f4_nt(st + rr * 64 + q * 4, v); }
            }
            __syncthreads();
        }
    }
}

DI void post_phase(const Params& p, const int wv__) {
    const int tid_ = otid(), lane = tid_ & 63, wg = blockIdx.x * 8 + (tid_ >> 6), nw = gridDim.x * 8;
    const bf16_t* C1 = (const bf16_t*)(p.ws + OFF_C);
    const bf16_t* YZ = (const bf16_t*)(p.ws + OFF_YZ); const float* BN = (const float*)(p.ws + OFF_BN);
    bf16_t* Y1 = (bf16_t*)(p.ws + OFF_H);
    const float* mu = p.in[24]; const float* lnw = p.in[32]; const float* lnb = p.in[33];
    const int cb = wg & 7, c = cb * 256 + lane * 4, hd = c >> 6;
    const f32x4 mv0 = ld_f4(mu + 4096 + c), mv1 = ld_f4(mu + 8576 + 4096 + c), mg0 = ld_f4(mu + 6144 + c), mg1 = ld_f4(mu + 8576 + 6144 + c);
    const f32x4 w4 = ld_f4(lnw + c), b4 = ld_f4(lnb + c);
#pragma unroll 4
    for (int row = wg >> 3; row < 8192; row += nw >> 3) {
        int t, T; seq_pos(row, t, T);
        const bf16_t* cr = C1 + (size_t)row * 8576;
        const bool hp = t > 0, hn = t < T - 1;
        const f32x4 ya = bf4_to_f4(__builtin_nontemporal_load((const u32x2*)(YZ + (size_t)row * 2048 + c)));
        const f32x4 yb = bf4_to_f4(__builtin_nontemporal_load((const u32x2*)(YZ + ((size_t)8192 + row) * 2048 + c)));
        const u32x2 zero = {0u, 0u};
        const u32x2 vc = *(const u32x2*)(cr + 4096 + c), gc = *(const u32x2*)(cr + 6144 + c);
        const u32x2 vp = hp ? *(const u32x2*)(cr - 8576 + 4096 + c) : zero, gp = hp ? *(const u32x2*)(cr - 8576 + 6144 + c) : zero;
        const u32x2 vn = hn ? *(const u32x2*)(cr + 8576 + 4096 + c) : zero, gn = hn ? *(const u32x2*)(cr + 8576 + 6144 + c) : zero;
        const float bna = BN[(size_t)row * 32 + hd], bnb = BN[((size_t)8192 + row) * 32 + hd];
        const float ma = sum16d(ya[0] + ya[1] + ya[2] + ya[3]) * (1.f / 64.f), mb = sum16d(yb[0] + yb[1] + yb[2] + yb[3]) * (1.f / 64.f);
        const f32x4 da = ya - ma, db = yb - mb;
        const float va = sum16d(da[0] * da[0] + da[1] * da[1] + da[2] * da[2] + da[3] * da[3]) * (1.f / 64.f);
        const float vb = sum16d(db[0] * db[0] + db[1] * db[1] + db[2] * db[2] + db[3] * db[3]) * (1.f / 64.f);
        const float rsa = rsqrtf(va + 64e-5f), rsb = rsqrtf(vb + 64e-5f);
        const f32x4 v = tshift(bf4_to_f4(vc), bf4_to_f4(vp), bf4_to_f4(vn), mv0, mv1);
        const f32x4 g = tshift(bf4_to_f4(gc), bf4_to_f4(gp), bf4_to_f4(gn), mg0, mg1);
        f32x4 res = (da * rsa + db * rsb) * w4 + 2.f * b4 + (bna + bnb) * v;
#pragma unroll
        for (int j = 0; j < 4; ++j) res[j] *= g[j] * sigmoidf_(g[j]);
        st_bf4(Y1 + (size_t)row * 2048 + c, res);
    }
}

#define XB_TMO      128
#define XB_XCNT(j)  (256  + 64 * (j))
#define XB_XSUB(j)  (1280 + 64 * (j))
#define XB_XGEN(j)  (2304 + 64 * (j))
#define XB_TOP      3328
#define XB_TOPGEN   3392
#define XCD_BAR_WORDS 3456
#define XB_SPIN_CAP (1u << 18)
DI unsigned xb_ld(unsigned* p)              { return __hip_atomic_load(p, __ATOMIC_RELAXED, __HIP_MEMORY_SCOPE_AGENT); }
DI unsigned xb_add(unsigned* p, unsigned v) { return __hip_atomic_fetch_add(p, v, __ATOMIC_RELAXED, __HIP_MEMORY_SCOPE_AGENT); }
DI unsigned xb_xcc_id() { return (unsigned)__builtin_amdgcn_s_getreg((3 << 11) | 20) & 0xFu; }
#define XB_SPIN(cond, bar) do { unsigned _sp = 0; while (cond) { __builtin_amdgcn_s_sleep(1); \
    if ((++_sp & 255u) == 0u) { if (xb_ld(&(bar)[XB_TMO])) break; if (_sp > XB_SPIN_CAP) { atomicAdd(&(bar)[XB_TMO], 1u); break; } } } } while (0)
struct XcdBarrier { unsigned* bar; unsigned x; volatile LAS unsigned* st; };
DI int ltid_(int wv) { return (wv << 6) | (int)__builtin_amdgcn_mbcnt_hi(~0u, __builtin_amdgcn_mbcnt_lo(~0u, 0u)); }
DI XcdBarrier xcd_barrier_post(unsigned* bar, volatile LAS unsigned* st, const int wv__) {
    XcdBarrier b; b.bar = bar; b.x = xb_xcc_id(); b.st = st;
    if (otid() == 0) (void)xb_add(&bar[XB_XCNT(b.x)], 1u);
    return b;
}
DI void xcd_barrier_complete(unsigned* bar, unsigned x, unsigned& nloc, unsigned& nx) {
    const unsigned G = gridDim.x * gridDim.y * gridDim.z;
    unsigned sum, cnt, mine, sp = 0u;
    for (;;) {
        sum = 0u; cnt = 0u; mine = 0u;
#pragma unroll
        for (unsigned j = 0; j < 16; ++j) { const unsigned c = xb_ld(&bar[XB_XCNT(j)]); sum += c; cnt += (c > 0u) ? 1u : 0u; mine = (j == x) ? c : mine; }
        if (sum == G) break;
        __builtin_amdgcn_s_sleep(1);
        if ((++sp & 255u) == 0u) { if (xb_ld(&bar[XB_TMO])) break; if (sp > XB_SPIN_CAP) { atomicAdd(&bar[XB_TMO], 1u); break; } }
    }
    nloc = mine > 0u ? mine : 1u; nx = cnt > 0u ? cnt : 1u;
}
DI void xcd_barrier(const XcdBarrier& b, const int wv__) {
    asm volatile("s_waitcnt vmcnt(0)" ::: "memory");
    __syncthreads();
    if (otid() == 0) {
        unsigned* bar = b.bar;
        __builtin_amdgcn_s_waitcnt(0);
        unsigned nloc = b.st[0], nx = b.st[1];
        if (nloc == 0u) { xcd_barrier_complete(bar, b.x, nloc, nx); b.st[0] = nloc; b.st[1] = nx; }
        const unsigned old = xb_add(&bar[XB_XSUB(b.x)], 1u);
        const unsigned gen = old / nloc;
        if (old + 1u == (gen + 1u) * nloc) {
            __builtin_amdgcn_fence(__ATOMIC_RELEASE, "agent");
            asm volatile("s_waitcnt vmcnt(0)" ::: "memory");
            const unsigned og = xb_add(&bar[XB_TOP], 1u);
            const unsigned tg = og / nx;
            if (og + 1u == (tg + 1u) * nx) xb_add(&bar[XB_TOPGEN], 1u);
            else XB_SPIN(xb_ld(&bar[XB_TOPGEN]) == tg, bar);
            __builtin_amdgcn_fence(__ATOMIC_ACQUIRE, "agent");
            xb_add(&bar[XB_XGEN(b.x)], 1u);
            asm volatile("s_waitcnt vmcnt(0)" ::: "memory");
        } else {
            XB_SPIN(xb_ld(&bar[XB_XGEN(b.x)]) == gen, bar);
            __builtin_amdgcn_fence(__ATOMIC_ACQUIRE, "agent");
            asm volatile("s_waitcnt vmcnt(0)" ::: "memory");
        }
    }
    __syncthreads();
}

constexpr int NPHASE = 15;
#ifndef PHASE_MASK
#define PHASE_MASK 0x7fff
#endif
#ifndef PH_ORDER
#define PH_ORDER 0xEDCBA9876543210ull
#define PH_COUNT 15
#endif
#define PH_ON(n) (((PHASE_MASK) >> (n)) & 1)
__global__ void __launch_bounds__(NTHREADS) mega(KArgs ka, int ph_lo, int ph_hi) {
    cg::grid_group grid = cg::this_grid();
    const int wv__ = __builtin_amdgcn_readfirstlane((int)(threadIdx.x >> 6));
    LAS unsigned char* lds = (LAS unsigned char*)dyn_lds;
    __shared__ uint4 xb_words;
    if (otid() == 0) xb_words = make_uint4(0u, 0u, 0u, 0u);
    XcdBarrier xb; xb.bar = nullptr; xb.x = 0u; xb.st = (volatile LAS unsigned*)&xb_words;
    typedef void* vptr_t;
    const __attribute__((address_space(4))) vptr_t* kat = (const __attribute__((address_space(4))) vptr_t*)__builtin_amdgcn_kernarg_segment_ptr();
    for (int si = ph_lo; si < ph_hi; ++si) {
        const int ph = (int)((PH_ORDER >> (4 * si)) & 15ull);
        if (si == ph_lo) {
            unsigned* bar = (unsigned*)((unsigned char*)kat[35] + OFF_BAR);
            if (blockIdx.x == 0) { const int t0 = otid();
#pragma unroll 1
                for (int i = t0; i < XCD_BAR_WORDS; i += NTHREADS) bar[i] = 0u; }
            __syncthreads();
        } else if (si == ph_lo + 1) {
            grid.sync();
            xb = xcd_barrier_post((unsigned*)((unsigned char*)kat[35] + OFF_BAR), (volatile LAS unsigned*)&xb_words, wv__);
        } else xcd_barrier(xb, wv__);
        int oz = 0; asm volatile("" : "+s"(oz));
        Params p;
        p.in[0] = (const float*)kat[0 + oz];
        p.in[1] = (const float*)kat[1 + oz];
        p.in[2] = (const float*)kat[2 + oz];
        p.in[3] = (const float*)kat[3 + oz];
        p.in[4] = (const float*)kat[4 + oz];
        p.in[5] = (const float*)kat[5 + oz];
        p.in[6] = (const float*)kat[6 + oz];
        p.in[7] = (const float*)kat[7 + oz];
        p.in[8] = (const float*)kat[8 + oz];
        p.in[9] = (const float*)kat[9 + oz];
        p.in[10] = (const float*)kat[10 + oz];
        p.in[11] = (const float*)kat[11 + oz];
        p.in[12] = (const float*)kat[12 + oz];
        p.in[13] = (const float*)kat[13 + oz];
        p.in[14] = (const float*)kat[14 + oz];
        p.in[15] = (const float*)kat[15 + oz];
        p.in[16] = (const float*)kat[16 + oz];
        p.in[17] = (const float*)kat[17 + oz];
        p.in[18] = (const float*)kat[18 + oz];
        p.in[19] = (const float*)kat[19 + oz];
        p.in[20] = (const float*)kat[20 + oz];
        p.in[21] = (const float*)kat[21 + oz];
        p.in[22] = (const float*)kat[22 + oz];
        p.in[23] = (const float*)kat[23 + oz];
        p.in[24] = (const float*)kat[24 + oz];
        p.in[25] = (const float*)kat[25 + oz];
        p.in[26] = (const float*)kat[26 + oz];
        p.in[27] = (const float*)kat[27 + oz];
        p.in[28] = (const float*)kat[28 + oz];
        p.in[29] = (const float*)kat[29 + oz];
        p.in[30] = (const float*)kat[30 + oz];
        p.in[31] = (const float*)kat[31 + oz];
        p.in[32] = (const float*)kat[32 + oz];
        p.in[33] = (const float*)kat[33 + oz];
        p.out = (float*)kat[34 + oz]; p.ws = (unsigned char*)kat[35 + oz];
        unsigned char* ws = p.ws;
        float* mod = (float*)(ws + OFF_MOD);
        const f32x2* rope = (const f32x2*)(ws + OFF_ROPE);
        switch (ph) {
        case 0: if (PH_ON(0)) prep_phase(p, lds, wv__); break;
        case 1: if (PH_ON(1)) norm_mod_phase(p.in[0], p.in[1], p.in[12], mod, (bf16_t*)(ws + OFF_H), wv__); break;
        case 2: if (PH_ON(2)) {
            Epi0 e; e.QD = (bf16_t*)(ws + OFF_QD); e.KD = (bf16_t*)(ws + OFF_KD); e.VD = (bf16_t*)(ws + OFF_VD); e.CQR = (bf16_t*)(ws + OFF_CQR); e.KPE = (bf16_t*)(ws + OFF_KPE);
            e.SG = (bf16_t*)(ws + OFF_SG0); e.CKVR = (float*)(ws + OFF_CKVR); e.oak = p.out + OUT_AK; e.oav = p.out + OUT_AV; e.okpe = p.out + OUT_KPE; e.rope = rope;
            gemm_phase(lds, (const bf16_t*)(ws + OFF_H), (const bf16_t*)(ws + OFF_WT0), 8192, 6144, 2048, e, wv__);
        } break;
        case 3: if (PH_ON(3)) lat_norm_phase(p, wv__); break;
        case 4: if (PH_ON(4)) {
            EpiQ eq; eq.QB = (bf16_t*)(ws + OFF_QB); eq.rope = rope;
            gemm_phase(lds, (const bf16_t*)(ws + OFF_CQN), (const bf16_t*)(ws + OFF_WUQ), 8192, 1536, 512, eq, wv__);
            EpiBf ek; ek.O = (bf16_t*)(ws + OFF_KVB); ek.ldc = 2048; ek.ncols = 2048;
            gemm_phase(lds, (const bf16_t*)(ws + OFF_CKVA), (const bf16_t*)(ws + OFF_WUKV), 10240, 2048, 256, ek, wv__);
        } break;
        case 5: if (PH_ON(5)) attn_phase(p, lds, wv__); break;
        case 6: if (PH_ON(6)) {
            EpiOut e; e.xp = p.in[0]; e.xs = p.in[1]; e.xo = p.out + OUT_Y; e.modg = mod + 4096;
            gemm_phase(lds, (const bf16_t*)(ws + OFF_H), (const bf16_t*)(ws + OFF_WOT0), 8192, 2048, 2048, e, wv__);
        } break;
        case 7: if (PH_ON(7)) norm_mod_phase(p.out + OUT_Y, p.out + OUT_Y + (size_t)4096 * 2048, p.in[12] + 2048, mod + 5 * 6144, (bf16_t*)(ws + OFF_H), wv__); break;
        case 8: if (PH_ON(8)) {
            EpiBf e; e.O = (bf16_t*)(ws + OFF_C); e.ldc = 8576; e.ncols = 8192;
            gemm_phase(lds, (const bf16_t*)(ws + OFF_H), (const bf16_t*)(ws + OFF_WT1), 8192, 8192, 2048, e, wv__);
            EpiBf e2; e2.O = (bf16_t*)(ws + OFF_PART); e2.ldc = 2048; e2.ncols = 2048;
            gemm_phase(lds, (const bf16_t*)(ws + OFF_H), (const bf16_t*)(ws + OFF_WT1) + (size_t)8192 * 2048, 8192, 512, 512, e2, wv__, 2048, 4);
        } break;
        case 9: if (PH_ON(9)) lora_in_phase(p, wv__); break;
        case 10: if (PH_ON(10)) {
#pragma unroll 1
            for (int z = 0; z < 2; ++z) {
                EpiDecay ew; ew.O = (bf16_t*)(ws + OFF_EZ) + (size_t)z * 8192 * 2048; ew.bias = p.in[25] + z * 2048; ew.rev = z;
                gemm_phase(lds, (const bf16_t*)(ws + OFF_WDT) + (size_t)z * 8192 * 128, (const bf16_t*)(ws + OFF_W2T) + (size_t)z * 2048 * 128, 8192, 2048, 128, ew, wv__);
                EpiLora ea; ea.O = (bf16_t*)(ws + OFF_AZ) + (size_t)z * 8192 * 2048; ea.bias = p.in[27] + z * 2048; ea.mul = 1.f;
                gemm_phase(lds, (const bf16_t*)(ws + OFF_ADT) + (size_t)z * 8192 * 128, (const bf16_t*)(ws + OFF_A2T) + (size_t)z * 2048 * 128, 8192, 2048, 128, ea, wv__);
            }
        } break;
        case 11: if (PH_ON(11)) scan_phase(p, lds, wv__); break;
        case 12: if (PH_ON(12)) post_phase(p, wv__); break;
        case 13: if (PH_ON(13)) {
            EpiGate e; e.O = (bf16_t*)(ws + OFF_C); e.modg = mod + 5 * 6144 + 4096;
            gemm_phase(lds, (const bf16_t*)(ws + OFF_H), (const bf16_t*)(ws + OFF_WOT1), 8192, 2048, 2048, e, wv__);
        } break;
        case 14: if (PH_ON(14)) final_norm_phase(p.out + OUT_Y, (const bf16_t*)(ws + OFF_C), p.in[13], wv__); break;
        }
    }
}

extern "C" void kernel_launch(void* const* d_in, const int* in_sizes, int n_in, void* d_out, int out_size, void* d_ws, size_t ws_size, hipStream_t stream) {
    static int grid_blocks = 0;
    if (!grid_blocks) {
        hipFuncSetAttribute((const void*)mega, hipFuncAttributeMaxDynamicSharedMemorySize, LDS_BYTES);
        int dev = 0, cus = 0, per_cu = 0;
        hipGetDevice(&dev);
        hipDeviceGetAttribute(&cus, hipDeviceAttributeMultiprocessorCount, dev);
        hipOccupancyMaxActiveBlocksPerMultiprocessor(&per_cu, mega, NTHREADS, LDS_BYTES);
        if (per_cu < 1) per_cu = 1;
        grid_blocks = cus * per_cu;
        if (grid_blocks > 256) grid_blocks = 256;
    }
    KArgs p{};
    for (int i = 0; i < 34; ++i) p.a[i] = d_in[i];
    p.a[34] = d_out;
    p.a[35] = d_ws;
    int lo = 0, hi = PH_COUNT;
    void* args[] = {&p, &lo, &hi};
    hipError_t e = hipLaunchCooperativeKernel((const void*)mega, dim3(grid_blocks), dim3(NTHREADS), args, LDS_BYTES, stream);
    if (e != hipSuccess) fprintf(stderr, "cooperative launch failed: %s (grid %d, ws %zu need %zu)\n", hipGetErrorString(e), grid_blocks, ws_size, (size_t)WS_NEEDED);
}
```
